# Optimizing an MI355X kernel written in HIP

```python
import math
import jax, jax.numpy as jnp
from jax import lax
import numpy as np

D_MODEL = 1024
BATCH = 4
SEQ = 4096
DEPTH = 1

N_HEADS = 4
HEAD_DIM = 64
V_DIM = 2 * HEAD_DIM
ATT_QK_WIDTH = N_HEADS * 2 * HEAD_DIM
ATT_V_WIDTH = N_HEADS * V_DIM
ROPE_THETA = 10000.0
Q_BLOCK = 128
CONV_WIDTH = D_MODEL // 2
CONV_K = 3
N_BRANCHES = 2
IN_PROJ_WIDTH = 3 * ATT_QK_WIDTH + 3 * CONV_WIDTH + N_BRANCHES * D_MODEL
N_GROUPS = 4
EXPERTS_PER_GROUP = 8
N_EXPERTS = N_GROUPS * EXPERTS_PER_GROUP
TOP_K = 2
EXPERT_FF = D_MODEL // 4
EPS = 1e-6
MASK_VALUE = -1e30

kernel_name = "hybrid_diffattn_shortconv_hmoe_block"


def rms_norm(x, g):
    xf = x.astype(jnp.float32)
    y = xf * lax.rsqrt(jnp.mean(xf * xf, axis=-1, keepdims=True) + EPS)
    return (y * g.astype(jnp.float32)).astype(x.dtype)


def rope(t, positions):
    inv_freq = ROPE_THETA ** (-jnp.arange(0, HEAD_DIM, 2, dtype=jnp.float32) / HEAD_DIM)
    ang = positions.astype(jnp.float32)[..., None] * inv_freq
    cos = jnp.cos(ang)[:, :, None, None, :].astype(t.dtype)
    sin = jnp.sin(ang)[:, :, None, None, :].astype(t.dtype)
    t1, t2 = jnp.split(t, 2, axis=-1)
    return jnp.concatenate([t1 * cos - t2 * sin, t2 * cos + t1 * sin], axis=-1)


def diff_attention(q, k, v, lam):
    B, S = q.shape[0], q.shape[1]
    n_blocks = S // Q_BLOCK
    scale = HEAD_DIM ** -0.5
    qb = q.reshape(B, n_blocks, Q_BLOCK, N_HEADS, 2, HEAD_DIM).transpose(1, 0, 2, 3, 4, 5)
    k_idx = jnp.arange(S)

    def one_block(args):
        q_blk, b_idx = args
        s = jnp.einsum('bqhmd,bkhmd->bhmqk', q_blk, k).astype(jnp.float32) * scale
        q_idx = b_idx * Q_BLOCK + jnp.arange(Q_BLOCK)
        causal = k_idx[None, :] <= q_idx[:, None]
        s = jnp.where(causal, s, MASK_VALUE)
        p = jax.nn.softmax(s, axis=-1)
        a = p[:, :, 0] - lam * p[:, :, 1]
        return jnp.einsum('bhqk,bkhv->bqhv', a.astype(v.dtype), v)

    out = lax.map(one_block, (qb, jnp.arange(n_blocks)))
    return out.transpose(1, 0, 2, 3, 4).reshape(B, S, N_HEADS, V_DIM)


def causal_short_conv(u, w):
    S = u.shape[1]
    up = jnp.pad(u, ((0, 0), (CONV_K - 1, 0), (0, 0)))
    return sum(w[j] * up[:, CONV_K - 1 - j: CONV_K - 1 - j + S] for j in range(CONV_K))


def hierarchical_moe(t, w_grp, b_grp, w_exp_r, b_exp_r, w_gate, w_up, w_down):
    T = t.shape[0]
    g_prob = jax.nn.softmax((t @ w_grp + b_grp).astype(jnp.float32), axis=-1)
    g_w, g_idx = lax.top_k(g_prob, 1)
    e_logits = (t @ w_exp_r + b_exp_r).astype(jnp.float32).reshape(T, N_GROUPS, EXPERTS_PER_GROUP)
    e_in = jnp.take_along_axis(e_logits, g_idx[:, :, None], axis=1)[:, 0]
    e_top, e_idx = lax.top_k(e_in, TOP_K)
    e_w = jax.nn.softmax(e_top, axis=-1) * g_w
    flat_idx = g_idx * EXPERTS_PER_GROUP + e_idx
    combine = jnp.einsum('tk,tke->te', e_w, jax.nn.one_hot(flat_idx, N_EXPERTS, dtype=jnp.float32))
    hg = jnp.einsum('td,edf->tef', t, w_gate)
    hu = jnp.einsum('td,edf->tef', t, w_up)
    act = jax.nn.silu(hg) * hu * combine[..., None].astype(t.dtype)
    return jnp.einsum('tef,efd->td', act, w_down)


def setup_inputs(seed: int = 0) -> dict:
    key = jax.random.key(seed)
    ks = jax.random.split(key, 26)
    f32 = jnp.float32
    nrm = lambda k, shape, s: jax.random.normal(k, shape, f32) * s
    L = DEPTH
    D = D_MODEL
    offsets = jax.random.randint(ks[2], (BATCH, 1), 0, 2048, dtype=jnp.int32)
    positions = offsets + jnp.arange(SEQ, dtype=jnp.int32)[None, :]
    return {
        "x": nrm(ks[0], (BATCH, SEQ, D), 1.0),
        "c": nrm(ks[1], (BATCH, D), 1.0),
        "positions": positions,
        "w_ada": nrm(ks[3], (L, D, 6 * D), 0.5 * D ** -0.5),
        "b_ada": nrm(ks[4], (L, 6 * D), 0.01),
        "norm_mix_g": 1.0 + nrm(ks[5], (L, D), 0.01),
        "w_in": nrm(ks[6], (L, D, IN_PROJ_WIDTH), D ** -0.5),
        "lambda_q1": nrm(ks[7], (L, HEAD_DIM), 0.1),
        "lambda_k1": nrm(ks[8], (L, HEAD_DIM), 0.1),
        "lambda_q2": nrm(ks[9], (L, HEAD_DIM), 0.1),
        "lambda_k2": nrm(ks[10], (L, HEAD_DIM), 0.1),
        "subln_g": 1.0 + nrm(ks[11], (L, V_DIM), 0.01),
        "conv_w": nrm(ks[12], (L, CONV_K, CONV_WIDTH), CONV_K ** -0.5),
        "w_up_att": nrm(ks[13], (L, ATT_V_WIDTH, D), ATT_V_WIDTH ** -0.5),
        "w_up_conv": nrm(ks[14], (L, CONV_WIDTH, D), CONV_WIDTH ** -0.5),
        "w_out": nrm(ks[15], (L, D, D), D ** -0.5),
        "norm_ffn_g": 1.0 + nrm(ks[16], (L, D), 0.01),
        "w_group_router": nrm(ks[17], (L, D, N_GROUPS), D ** -0.5),
        "b_group_router": nrm(ks[18], (L, N_GROUPS), 0.01),
        "w_expert_router": nrm(ks[19], (L, D, N_EXPERTS), D ** -0.5),
        "b_expert_router": nrm(ks[20], (L, N_EXPERTS), 0.01),
        "w_gate": nrm(ks[21], (L, N_EXPERTS, D, EXPERT_FF), D ** -0.5),
        "w_up": nrm(ks[22], (L, N_EXPERTS, D, EXPERT_FF), D ** -0.5),
        "w_down": nrm(ks[23], (L, N_EXPERTS, EXPERT_FF, D), EXPERT_FF ** -0.5),
        "final_norm_g": 1.0 + nrm(ks[24], (D,), 0.01),
    }


def reference(x, c, positions, w_ada, b_ada, norm_mix_g, w_in, lambda_q1, lambda_k1,
              lambda_q2, lambda_k2, subln_g, conv_w, w_up_att, w_up_conv, w_out,
              norm_ffn_g, w_group_router, b_group_router, w_expert_router,
              b_expert_router, w_gate, w_up, w_down, final_norm_g):
    B, S, D = x.shape
    split_pts = [ATT_QK_WIDTH, 2 * ATT_QK_WIDTH, 3 * ATT_QK_WIDTH,
                 3 * ATT_QK_WIDTH + CONV_WIDTH, 3 * ATT_QK_WIDTH + 2 * CONV_WIDTH,
                 3 * ATT_QK_WIDTH + 3 * CONV_WIDTH]
    c_act = jax.nn.silu(c)
    for l in range(DEPTH):
        lambda_init = 0.8 - 0.6 * math.exp(-0.3 * l)
        mod = c_act @ w_ada[l] + b_ada[l]
        sh_m, sc_m, g_m, sh_f, sc_f, g_f = [m[:, None, :] for m in jnp.split(mod, 6, axis=-1)]

        h = rms_norm(x, norm_mix_g[l]) * (1.0 + sc_m) + sh_m
        z = h @ w_in[l]
        q, k, v, cb, cc, cu, gate_logits = jnp.split(z, split_pts, axis=-1)

        q = rope(q.reshape(B, S, N_HEADS, 2, HEAD_DIM), positions)
        k = rope(k.reshape(B, S, N_HEADS, 2, HEAD_DIM), positions)
        v = v.reshape(B, S, N_HEADS, V_DIM)
        lam = (jnp.exp(jnp.sum(lambda_q1[l].astype(jnp.float32) * lambda_k1[l].astype(jnp.float32)))
               - jnp.exp(jnp.sum(lambda_q2[l].astype(jnp.float32) * lambda_k2[l].astype(jnp.float32)))
               + lambda_init)
        att = diff_attention(q, k, v, lam)
        att = (rms_norm(att, subln_g[l]) * (1.0 - lambda_init)).reshape(B, S, ATT_V_WIDTH)

        conv = cb * causal_short_conv(cc * cu, conv_w[l])

        g_att, g_conv = jnp.split(gate_logits, N_BRANCHES, axis=-1)
        merged = jax.nn.sigmoid(g_att) * (att @ w_up_att[l]) + jax.nn.sigmoid(g_conv) * (conv @ w_up_conv[l])
        x = x + g_m * (merged @ w_out[l])

        h2 = rms_norm(x, norm_ffn_g[l]) * (1.0 + sc_f) + sh_f
        y = hierarchical_moe(h2.reshape(B * S, D), w_group_router[l], b_group_router[l],
                             w_expert_router[l], b_expert_router[l],
                             w_gate[l], w_up[l], w_down[l])
        x = x + g_f * y.reshape(B, S, D)
    return rms_norm(x, final_norm_g)
```

```cpp
#include <hip/hip_runtime.h>
#include <stdint.h>

typedef unsigned short bf16_t;
#define DEV __device__ __forceinline__

constexpr int BATCH = 4, SEQ = 4096, DM = 1024, M = BATCH * SEQ;
constexpr int NH = 4, HD = 64, VD = 128, QKW = 512, VW = 512, CW = 512, INW = 5120;
constexpr int NG = 4, EPG = 8, NE = 32, FF = 256;
constexpr float EPS = 1e-6f;
constexpr float LAMBDA_INIT = 0.2f;

constexpr size_t MiB = 1u << 20;
constexpr size_t WS_CTL = 0;
constexpr size_t WS_MOD = 1 * MiB;
constexpr size_t WS_LAM = 1 * MiB + 128 * 1024;
constexpr size_t WS_ROPE = 2 * MiB;
constexpr size_t WS_TOKE = 6 * MiB;
constexpr size_t WS_TOKW = 6 * MiB + 256 * 1024;
constexpr size_t WS_WEIGHTS = 8 * MiB;
constexpr size_t WS_H = 72 * MiB;
constexpr size_t WS_ATT = 72 * MiB, WS_CONV = 88 * MiB;
constexpr size_t WS_Q = 104 * MiB, WS_K = 120 * MiB, WS_V = 136 * MiB, WS_CB = 152 * MiB, WS_CCU = 168 * MiB;
constexpr size_t WS_GA = 184 * MiB, WS_GC = 216 * MiB;
constexpr size_t WS_MERGED = 104 * MiB;
constexpr size_t WS_H2 = 136 * MiB;
constexpr size_t WS_SSQ = 248 * MiB;

DEV float bf2f(bf16_t v) { return __uint_as_float(((unsigned)v) << 16); }
DEV bf16_t f2bf(float f) { unsigned u = __float_as_uint(f); u += 0x7fffu + ((u >> 16) & 1u); return (bf16_t)(u >> 16); }

#define GAS __attribute__((address_space(1)))
#define LAS __attribute__((address_space(3)))
typedef unsigned v4u __attribute__((ext_vector_type(4)));
typedef float f32x4 __attribute__((ext_vector_type(4)));
typedef short bf16x8 __attribute__((ext_vector_type(8)));
#define LDS_WAIT() asm volatile("s_waitcnt lgkmcnt(0)" ::: "memory")
#define VM_WAIT() asm volatile("s_waitcnt vmcnt(0)" ::: "memory")
typedef float f32x2p_t __attribute__((ext_vector_type(2))); typedef __bf16 bf16x2p_t __attribute__((ext_vector_type(2)));
DEV unsigned pk2(float lo, float hi) { f32x2p_t v = {lo, hi}; bf16x2p_t b = __builtin_convertvector(v, bf16x2p_t); return __builtin_bit_cast(unsigned, b); }

constexpr int NWAVES = 8, NTHR = 512;
constexpr int RING_BYTES = 131072;
constexpr int LDSCTL_OFF = 139264, MISC_OFF = LDSCTL_OFF + 320;
constexpr int LDS_BYTES = 147456;
constexpr size_t CTL_ZERO_BYTES = 1 * MiB;
constexpr int CW_P0C = 24640, CW_PC1 = 25600;
constexpr int CW_MODC = 24576;
constexpr int CW_BAR = 4096;
constexpr size_t WS_WT_IN = WS_WEIGHTS;
constexpr size_t WS_WT_A = WS_WEIGHTS + 10 * MiB;
constexpr size_t WS_WT_C = WS_WEIGHTS + 11 * MiB;
constexpr size_t WS_WT_O = WS_WEIGHTS + 12 * MiB;
constexpr size_t WS_WT_GU = WS_WEIGHTS + 14 * MiB;
constexpr size_t WS_WT_D = WS_WEIGHTS + 46 * MiB;
constexpr size_t WS_WT_R = WS_WEIGHTS + 62 * MiB;

#define XB_TMO      128
#define XB_XCNT(j)  (256  + 64 * (j))
#define XB_XSUB(j)  (1280 + 64 * (j))
#define XB_XGEN(j)  (2304 + 64 * (j))
#define XB_TOP      3328
#define XB_TOPGEN   3392
#define XCD_BAR_WORDS 3456
#define XB_SPIN_CAP (1u << 18)
DEV unsigned xb_ld(unsigned* p)              { return __hip_atomic_load(p, __ATOMIC_RELAXED, __HIP_MEMORY_SCOPE_AGENT); }
DEV unsigned xb_add(unsigned* p, unsigned v) { return __hip_atomic_fetch_add(p, v, __ATOMIC_RELAXED, __HIP_MEMORY_SCOPE_AGENT); }
DEV unsigned xb_xcc_id() { return (unsigned)__builtin_amdgcn_s_getreg((3 << 11) | 20) & 0xFu; }
#define XB_SPIN(cond, bar) do { unsigned _sp = 0; while (cond) { __builtin_amdgcn_s_sleep(1); \
    if ((++_sp & 255u) == 0u) { if (xb_ld(&(bar)[XB_TMO])) break; if (_sp > XB_SPIN_CAP) { atomicAdd(&(bar)[XB_TMO], 1u); break; } } } } while (0)
struct XcdBarrier { unsigned* bar; unsigned x; volatile LAS unsigned* st; };
DEV XcdBarrier xcd_barrier_post(unsigned* bar, volatile LAS unsigned* st) {
    XcdBarrier b; b.bar = bar; b.x = xb_xcc_id(); b.st = st;
    if (threadIdx.x == 0) (void)xb_add(&bar[XB_XCNT(b.x)], 1u);
    return b;
}
DEV void xcd_barrier_complete(unsigned* bar, unsigned x, unsigned& nloc, unsigned& nx) {
    const unsigned G = gridDim.x * gridDim.y * gridDim.z;
    unsigned sum, cnt, mine, sp = 0u;
    for (;;) {
        sum = 0u; cnt = 0u; mine = 0u;
#pragma unroll
        for (unsigned j = 0; j < 16; ++j) { const unsigned c = xb_ld(&bar[XB_XCNT(j)]); sum += c; cnt += (c > 0u) ? 1u : 0u; mine = (j == x) ? c : mine; }
        if (sum == G) break;
        __builtin_amdgcn_s_sleep(1);
        if ((++sp & 255u) == 0u) { if (xb_ld(&bar[XB_TMO])) break; if (sp > XB_SPIN_CAP) { atomicAdd(&bar[XB_TMO], 1u); break; } }
    }
    nloc = mine > 0u ? mine : 1u; nx = cnt > 0u ? cnt : 1u;
}
DEV void xcd_barrier(const XcdBarrier& b) {
    asm volatile("s_waitcnt vmcnt(0)" ::: "memory");
    __syncthreads();
    if (threadIdx.x == 0) {
        unsigned* bar = b.bar;
        __builtin_amdgcn_s_waitcnt(0);
        unsigned nloc = b.st[0], nx = b.st[1];
        if (nloc == 0u) { xcd_barrier_complete(bar, b.x, nloc, nx); b.st[0] = nloc; b.st[1] = nx; }
        const unsigned old = xb_add(&bar[XB_XSUB(b.x)], 1u);
        const unsigned gen = old / nloc;
        if (old + 1u == (gen + 1u) * nloc) {
            __builtin_amdgcn_fence(__ATOMIC_RELEASE, "agent");
            asm volatile("s_waitcnt vmcnt(0)" ::: "memory");
            const unsigned og = xb_add(&bar[XB_TOP], 1u);
            const unsigned tg = og / nx;
            if (og + 1u == (tg + 1u) * nx) xb_add(&bar[XB_TOPGEN], 1u);
            else XB_SPIN(xb_ld(&bar[XB_TOPGEN]) == tg, bar);
            __builtin_amdgcn_fence(__ATOMIC_ACQUIRE, "agent");
            xb_add(&bar[XB_XGEN(b.x)], 1u);
            asm volatile("s_waitcnt vmcnt(0)" ::: "memory");
        } else {
            XB_SPIN(xb_ld(&bar[XB_XGEN(b.x)]) == gen, bar);
            __builtin_amdgcn_fence(__ATOMIC_ACQUIRE, "agent");
            asm volatile("s_waitcnt vmcnt(0)" ::: "memory");
        }
    }
    __syncthreads();
}

struct Args { const void* in[25]; float* out; unsigned char* ws; int ph_lo, ph_hi, li, pad; };
struct Frame {
    LAS unsigned char* lds; volatile LAS unsigned* MISC; unsigned* ctl;
    int tid, lane, wave, vcu, G;
    unsigned char* ws; float* out;
};
DEV float wave_sum(float v) {
#pragma unroll
    for (int o = 1; o < 64; o <<= 1) v += __shfl_xor(v, o);
    return v;
}
namespace pg8 {
#define PG8_LAS __attribute__((address_space(3)))
typedef unsigned short bf16_t;
typedef short bf16x8 __attribute__((ext_vector_type(8)));
typedef float f32x4 __attribute__((ext_vector_type(4)));
typedef unsigned u32x4 __attribute__((ext_vector_type(4)));
constexpr int BM = 256, BK = 64, HALF = 128, HTB = HALF * BK * 2  , STAGE_BYTES = 8 * HTB, NXCD = 8, WGM = 8;

__host__ __device__ __forceinline__ int lds_byte(int r, int c) { const int st = (r >> 4) * 2 + (c >> 5), rr = r & 15, cc = c & 31, ob = rr * 64 + cc * 2; return st * 1024 + (ob ^ (((ob >> 9) & 1) << 5)); }
__host__ __device__ __forceinline__ void stage_rc(int b, int& R, int& C) { const int st = b / 1024, sb = b % 1024, swz = sb ^ (((sb >> 9) & 1) << 5); R = (st >> 1) * 16 + swz / 64; C = (st & 1) * 32 + (swz % 64) / 2; }
__host__ __device__ __forceinline__ int perm32(int rho) { const int n = rho >> 4, i = rho & 15; return 8 * (i >> 2) + 4 * n + (i & 3); }

struct Unit { int pm, pn; };
struct Gemm { const bf16_t* A; const bf16_t* Bt; int M, N, K; };

struct StaticOrder {
    int nM, nN, nwg, G, c;
    __host__ __device__ void init(int M, int N, int G_, int c_) { nM = M / BM; nN = N / BM; nwg = nM * nN; G = G_; c = c_; }
    __host__ __device__ bool next(int i, Unit& u) const {
        const long L = (long)i * G + c; if (L >= nwg) return false;
        int wgid = (int)L; { const int q = nwg / NXCD, r = nwg % NXCD, xcd = wgid % NXCD, off = wgid / NXCD; wgid = (xcd < r ? xcd * (q + 1) : r * (q + 1) + (xcd - r) * q) + off; }
        const int nig = WGM * nN, gid = wgid / nig, fm = gid * WGM, gsz = (nM - fm) < WGM ? (nM - fm) : WGM;
        u.pm = fm + ((wgid % nig) % gsz); u.pn = (wgid % nig) / gsz; return true;
    }
    __device__ __forceinline__ void a_ready(const Unit&) const {}
    __device__ __forceinline__ void done(const Unit&) const {}
};

typedef float f32x2c_t __attribute__((ext_vector_type(2))); typedef __bf16 bf16x2c_t __attribute__((ext_vector_type(2)));
__device__ __forceinline__ unsigned cvt_pk_bf16(float lo, float hi) { f32x2c_t v = {lo, hi}; bf16x2c_t b = __builtin_convertvector(v, bf16x2c_t); return __builtin_bit_cast(unsigned, b); }
typedef float f32x2 __attribute__((ext_vector_type(2)));


struct EpiIn {
    static constexpr bool PERM = true, AFTER_DRAIN = false, MID = false;
    bf16_t *Qb, *Kb, *Vb, *CB, *CCU, *GA, *GC; const float* ROPE; __amdgpu_buffer_rsrc_t orsrc;
    __device__ __forceinline__ void st(const int eoff, const u32x4 w) const { __builtin_amdgcn_raw_buffer_store_b128(w, orsrc, eoff * 2, 0, 16); }
    __device__ __forceinline__ void operator()(const f32x4 (&acc)[2][2][4][2], const Unit& u, int wr, int wc, int fr, int fq) const {
        const int pn = u.pn, row0 = u.pm * BM + wr * 64 + fr;
        if (pn < 4) {
            const int dst = pn < 2 ? 0 : (8 << 20); const int c0 = ((pn & 1) * 4 + wc) * 64 + 8 * fq;
#pragma unroll
            for (int ai = 0; ai < 2; ++ai) {
                f32x4 cs[4][4];
#pragma unroll
                for (int m = 0; m < 4; ++m) { const f32x4* rp = (const f32x4*)(ROPE + ((size_t)(row0 + ai * HALF + m * 16) * 32 + 8 * fq) * 2);
#pragma unroll
                    for (int q = 0; q < 4; ++q) cs[m][q] = rp[q]; }
#pragma unroll
                for (int m = 0; m < 4; ++m) { const int row = row0 + ai * HALF + m * 16;
                    const f32x4 cs0 = cs[m][0], cs1 = cs[m][1], cs2 = cs[m][2], cs3 = cs[m][3];
                    const f32x4 xa = acc[ai][0][m][0], xb = acc[ai][0][m][1], ya = acc[ai][1][m][0], yb = acc[ai][1][m][1];
                    u32x4 w1, w2;
                    w1.x = cvt_pk_bf16(xa[0] * cs0[0] - ya[0] * cs0[1], xa[1] * cs0[2] - ya[1] * cs0[3]);
                    w1.y = cvt_pk_bf16(xa[2] * cs1[0] - ya[2] * cs1[1], xa[3] * cs1[2] - ya[3] * cs1[3]);
                    w1.z = cvt_pk_bf16(xb[0] * cs2[0] - yb[0] * cs2[1], xb[1] * cs2[2] - yb[1] * cs2[3]);
                    w1.w = cvt_pk_bf16(xb[2] * cs3[0] - yb[2] * cs3[1], xb[3] * cs3[2] - yb[3] * cs3[3]);
                    w2.x = cvt_pk_bf16(ya[0] * cs0[0] + xa[0] * cs0[1], ya[1] * cs0[2] + xa[1] * cs0[3]);
                    w2.y = cvt_pk_bf16(ya[2] * cs1[0] + xa[2] * cs1[1], ya[3] * cs1[2] + xa[3] * cs1[3]);
                    w2.z = cvt_pk_bf16(yb[0] * cs2[0] + xb[0] * cs2[1], yb[1] * cs2[2] + xb[1] * cs2[3]);
                    w2.w = cvt_pk_bf16(yb[2] * cs3[0] + xb[2] * cs3[1], yb[3] * cs3[2] + xb[3] * cs3[3]);
                    st(dst + row * 512 + c0, w1); st(dst + row * 512 + c0 + 32, w2); }
            }
        } else if (pn < 8) {
            const int dst = pn < 6 ? (16 << 20) : (24 << 20); const int c0 = (pn & 1) * 256 + wc * 32 + 8 * fq;
#pragma unroll
            for (int ai = 0; ai < 2; ++ai)
#pragma unroll
                for (int m = 0; m < 4; ++m) { const int row = row0 + ai * HALF + m * 16;
#pragma unroll
                    for (int bj = 0; bj < 2; ++bj) { const f32x4 v0 = acc[ai][bj][m][0], v1 = acc[ai][bj][m][1]; u32x4 w;
                        w.x = cvt_pk_bf16(v0[0], v0[1]); w.y = cvt_pk_bf16(v0[2], v0[3]); w.z = cvt_pk_bf16(v1[0], v1[1]); w.w = cvt_pk_bf16(v1[2], v1[3]);
                        st(dst + row * 512 + c0 + bj * HALF, w); } }
        } else if (pn < 12) {
            const int c0 = (pn - 8) * 128 + wc * 32 + 8 * fq;
#pragma unroll
            for (int ai = 0; ai < 2; ++ai)
#pragma unroll
                for (int m = 0; m < 4; ++m) { const int row = row0 + ai * HALF + m * 16;
                    const f32x4 v0 = acc[ai][0][m][0] * acc[ai][1][m][0], v1 = acc[ai][0][m][1] * acc[ai][1][m][1]; u32x4 w;
                    w.x = cvt_pk_bf16(v0[0], v0[1]); w.y = cvt_pk_bf16(v0[2], v0[3]); w.z = cvt_pk_bf16(v1[0], v1[1]); w.w = cvt_pk_bf16(v1[2], v1[3]);
                    st((32 << 20) + row * 512 + c0, w); }
        } else {
            const int dst = pn < 16 ? (40 << 20) : (56 << 20); const int c0 = ((pn - 12) & 3) * 256 + wc * 32 + 8 * fq;
#pragma unroll
            for (int ai = 0; ai < 2; ++ai)
#pragma unroll
                for (int m = 0; m < 4; ++m) { const int row = row0 + ai * HALF + m * 16;
#pragma unroll
                    for (int bj = 0; bj < 2; ++bj) { f32x4 v0 = acc[ai][bj][m][0], v1 = acc[ai][bj][m][1];
#pragma unroll
                        for (int j = 0; j < 4; ++j) { v0[j] = __builtin_amdgcn_rcpf(1.f + __builtin_amdgcn_exp2f(-1.4426950408889634f * v0[j])); v1[j] = __builtin_amdgcn_rcpf(1.f + __builtin_amdgcn_exp2f(-1.4426950408889634f * v1[j])); }
                        u32x4 w; w.x = cvt_pk_bf16(v0[0], v0[1]); w.y = cvt_pk_bf16(v0[2], v0[3]); w.z = cvt_pk_bf16(v1[0], v1[1]); w.w = cvt_pk_bf16(v1[2], v1[3]);
                        st(dst + row * 1024 + c0 + bj * HALF, w); } }
        }
    }
};

struct EpiG {
    static constexpr bool PERM = true, AFTER_DRAIN = false, MID = true;
    const bf16_t* GA; const bf16_t* GC; bf16_t* O; __amdgpu_buffer_rsrc_t orsrc;
    __device__ __forceinline__ void mid(f32x4 (&acc)[2][2][4][2], const Unit& u, int wr, int wc, int fr, int fq) const {
        int base = (u.pm * BM + wr * 64 + fr) * 1024 + u.pn * BM + wc * 32 + 8 * fq; asm volatile("" : "+v"(base));
#pragma unroll
        for (int ai = 0; ai < 2; ++ai)
#pragma unroll
            for (int mh = 0; mh < 2; ++mh) {
            u32x4 ga[2][2], gc[2][2];
#pragma unroll
            for (int mm = 0; mm < 2; ++mm)
#pragma unroll
                for (int bj = 0; bj < 2; ++bj) { const int ro = base + (ai * HALF + (2 * mh + mm) * 16) * 1024 + bj * HALF; ga[mm][bj] = __builtin_nontemporal_load((const u32x4*)(GA + ro)); gc[mm][bj] = *(const u32x4*)(GC + ro); }
#pragma unroll
            for (int mm = 0; mm < 2; ++mm)
#pragma unroll
                for (int bj = 0; bj < 2; ++bj) { const u32x4 a = ga[mm][bj], c = gc[mm][bj]; const int m = 2 * mh + mm;
                    f32x4& v0 = acc[ai][bj][m][0]; f32x4& v1 = acc[ai][bj][m][1];
                    v0[0] *= __uint_as_float(a.x << 16) * __builtin_amdgcn_rcpf(__uint_as_float(c.x << 16)); v0[1] *= __uint_as_float(a.x & 0xffff0000u) * __builtin_amdgcn_rcpf(__uint_as_float(c.x & 0xffff0000u));
                    v0[2] *= __uint_as_float(a.y << 16) * __builtin_amdgcn_rcpf(__uint_as_float(c.y << 16)); v0[3] *= __uint_as_float(a.y & 0xffff0000u) * __builtin_amdgcn_rcpf(__uint_as_float(c.y & 0xffff0000u));
                    v1[0] *= __uint_as_float(a.z << 16) * __builtin_amdgcn_rcpf(__uint_as_float(c.z << 16)); v1[1] *= __uint_as_float(a.z & 0xffff0000u) * __builtin_amdgcn_rcpf(__uint_as_float(c.z & 0xffff0000u));
                    v1[2] *= __uint_as_float(a.w << 16) * __builtin_amdgcn_rcpf(__uint_as_float(c.w << 16)); v1[3] *= __uint_as_float(a.w & 0xffff0000u) * __builtin_amdgcn_rcpf(__uint_as_float(c.w & 0xffff0000u)); }
        }
    }
    __device__ __forceinline__ void operator()(const f32x4 (&acc)[2][2][4][2], const Unit& u, int wr, int wc, int fr, int fq) const {
        int base = (u.pm * BM + wr * 64 + fr) * 1024 + u.pn * BM + wc * 32 + 8 * fq; asm volatile("" : "+v"(base));
#pragma unroll
        for (int ai = 0; ai < 2; ++ai) {
            u32x4 gc[4][2];
#pragma unroll
            for (int m = 0; m < 4; ++m)
#pragma unroll
                for (int bj = 0; bj < 2; ++bj) gc[m][bj] = __builtin_nontemporal_load((const u32x4*)(GC + base + (ai * HALF + m * 16) * 1024 + bj * HALF));
#pragma unroll
            for (int m = 0; m < 4; ++m)
#pragma unroll
                for (int bj = 0; bj < 2; ++bj) { const u32x4 c = gc[m][bj]; const int ro = base + (ai * HALF + m * 16) * 1024 + bj * HALF;
                    const f32x4 v0 = acc[ai][bj][m][0], v1 = acc[ai][bj][m][1]; u32x4 w;
                    w.x = cvt_pk_bf16(v0[0] * __uint_as_float(c.x << 16), v0[1] * __uint_as_float(c.x & 0xffff0000u)); w.y = cvt_pk_bf16(v0[2] * __uint_as_float(c.y << 16), v0[3] * __uint_as_float(c.y & 0xffff0000u));
                    w.z = cvt_pk_bf16(v1[0] * __uint_as_float(c.z << 16), v1[1] * __uint_as_float(c.z & 0xffff0000u)); w.w = cvt_pk_bf16(v1[2] * __uint_as_float(c.w << 16), v1[3] * __uint_as_float(c.w & 0xffff0000u));
                    __builtin_amdgcn_raw_buffer_store_b128(w, orsrc, ro * 2, 0, 16  ); }
        }
    }
};
struct EpiX1 {
    static constexpr bool PERM = true, AFTER_DRAIN = false, MID = false;
    const float* X; const float* GM; bf16_t* X1; float* SSQ; __amdgpu_buffer_rsrc_t xrsrc;
    __device__ __forceinline__ void operator()(const f32x4 (&acc)[2][2][4][2], const Unit& u, int wr, int wc, int fr, int fq) const {
        const int row0 = u.pm * BM + wr * 64 + fr, c0 = u.pn * BM + wc * 32 + 8 * fq;
        const float* gm = GM + (u.pm >> 4) * 6144 + c0;
        f32x4 gv[2][2];
#pragma unroll
        for (int bj = 0; bj < 2; ++bj)
#pragma unroll
            for (int n = 0; n < 2; ++n) gv[bj][n] = *(const f32x4*)(gm + bj * HALF + n * 4);
#pragma unroll
        for (int ai = 0; ai < 2; ++ai)
#pragma unroll
            for (int mh = 0; mh < 2; ++mh) {
            f32x4 xv[2][2][2];
#pragma unroll
            for (int mm = 0; mm < 2; ++mm) { const size_t ro = (size_t)(row0 + ai * HALF + (2 * mh + mm) * 16) * 1024 + c0;
#pragma unroll
                for (int bj = 0; bj < 2; ++bj)
#pragma unroll
                    for (int n = 0; n < 2; ++n) xv[mm][bj][n] = __builtin_nontemporal_load((const f32x4*)(X + ro + bj * HALF + n * 4)); }
#pragma unroll
            for (int mm = 0; mm < 2; ++mm) { const int m = 2 * mh + mm; const int row = row0 + ai * HALF + m * 16; const size_t ro = (size_t)row * 1024 + c0; float ss = 0.f;
#pragma unroll
                for (int bj = 0; bj < 2; ++bj) { const f32x4 o0 = xv[mm][bj][0] + gv[bj][0] * acc[ai][bj][m][0], o1 = xv[mm][bj][1] + gv[bj][1] * acc[ai][bj][m][1];
                    ss += ((o0[0] * o0[0] + o0[1] * o0[1]) + (o0[2] * o0[2] + o0[3] * o0[3])) + ((o1[0] * o1[0] + o1[1] * o1[1]) + (o1[2] * o1[2] + o1[3] * o1[3]));
                    u32x4 w; w.x = cvt_pk_bf16(o0[0], o0[1]); w.y = cvt_pk_bf16(o0[2], o0[3]); w.z = cvt_pk_bf16(o1[0], o1[1]); w.w = cvt_pk_bf16(o1[2], o1[3]);
                    __builtin_amdgcn_raw_buffer_store_b128(w, xrsrc, (int)(ro + bj * HALF) * 2, 0, 16  ); }
                ss += __shfl_xor(ss, 16); ss += __shfl_xor(ss, 32);
                if (fq == 0) __hip_atomic_store(SSQ + (size_t)row * 16 + u.pn * 4 + wc, ss, __ATOMIC_RELAXED, __HIP_MEMORY_SCOPE_AGENT); }
        }
    }
};

template <class Epi, class Sched, bool ALIGN_EPI = false, bool SP2 = false>
__device__ __forceinline__ void gemm_phase(PG8_LAS unsigned char* lds, const Gemm g, const Sched& S, const Epi& E) {
    const int tid = threadIdx.x, wid = __builtin_amdgcn_readfirstlane(tid >> 6), lane = tid & 63, wr = wid >> 2, wc = wid & 3, fr = lane & 15, fq = lane >> 4;
    const int K = g.K, nt = K / BK;
    unsigned voffA[2], voffB[2];
#pragma unroll
    for (int i = 0; i < 2; ++i) { int R, C; stage_rc(tid * 16 + i * 8192, R, C); const int Rb = Epi::PERM ? ((R & ~31) + perm32(R & 31)) : R;
        voffA[i] = (unsigned)(R * K + C) * 2u; voffB[i] = (unsigned)(Rb * K + C) * 2u; }
    const size_t kstep = (size_t)(BK * 2);
    const size_t hstep = (size_t)HALF * K * 2;
    const size_t tstep = 2 * hstep;
    const unsigned ldsw = (unsigned)wid * 1024u;
    const int aoff = lds_byte(wr * 64 + fr, fq * 8), boff = lds_byte(wc * 32 + fr, fq * 8);
#define PG8_SA(b, h) (((b) * 2 + (h)) * HTB)
#define PG8_SB(b, h) ((4 + (b) * 2 + (h)) * HTB)
#define PG8_STAGE(bufoff, gbase, voff) do { _Pragma("unroll") for (int _i = 0; _i < 2; ++_i) \
        __builtin_amdgcn_global_load_lds((const unsigned*)((const char*)(gbase) + (voff)[_i]), (PG8_LAS unsigned*)(lds + (bufoff) + ldsw + _i * 8192), 16, 0, 0); } while (0)
#define PG8_LDA(dst, b, h) do { _Pragma("unroll") for (int m = 0; m < 4; ++m) _Pragma("unroll") for (int k = 0; k < 2; ++k) dst[m][k] = *(const PG8_LAS bf16x8*)(lds + PG8_SA(b, h) + aoff + m * 2048 + k * 1024); } while (0)
#define PG8_LDB(dst, b, h) do { _Pragma("unroll") for (int n = 0; n < 2; ++n) _Pragma("unroll") for (int k = 0; k < 2; ++k) dst[n][k] = *(const PG8_LAS bf16x8*)(lds + PG8_SB(b, h) + boff + n * 2048 + k * 1024); } while (0)
#define PG8_MMA(ai, bj, At, Bt) do { __builtin_amdgcn_s_setprio(1); _Pragma("unroll") for (int m = 0; m < 4; ++m) _Pragma("unroll") for (int n = 0; n < 2; ++n) _Pragma("unroll") for (int k = 0; k < 2; ++k) \
        acc[ai][bj][m][n] = __builtin_amdgcn_mfma_f32_16x16x32_bf16(Bt[n][k], At[m][k], acc[ai][bj][m][n], 0, 0, 0); __builtin_amdgcn_s_setprio(0); } while (0)
#define PG8_WAIT_V(n) asm volatile("s_waitcnt vmcnt(" #n ")" ::: "memory")
#define PG8_WAIT_L(n) asm volatile("s_waitcnt lgkmcnt(" #n ")" ::: "memory")
#define PG8_BAR __builtin_amdgcn_s_barrier()
#define PG8_SCHED __builtin_amdgcn_sched_barrier(0)
    Unit cur, nxt; int ui = 0;
    if (!S.next(0, cur)) return;
    f32x4 acc[2][2][4][2];
#pragma unroll
    for (int a = 0; a < 2; ++a)
#pragma unroll
        for (int b = 0; b < 2; ++b)
#pragma unroll
            for (int m = 0; m < 4; ++m)
#pragma unroll
                for (int n = 0; n < 2; ++n) acc[a][b][m][n] = (f32x4){0.f, 0.f, 0.f, 0.f};
    bf16x8 At[4][2], B0[2][2], B1[2][2];
    const char* cA = (const char*)g.A + (size_t)cur.pm * tstep; const char* cB = (const char*)g.Bt + (size_t)cur.pn * tstep;
    S.a_ready(cur);
    if constexpr (SP2) {
        PG8_STAGE(PG8_SB(0, 0), cB, voffB); PG8_STAGE(PG8_SB(0, 1), cB + hstep, voffB); PG8_STAGE(PG8_SA(0, 0), cA, voffA); PG8_STAGE(PG8_SA(0, 1), cA + hstep, voffA);
        if (wr == 1) PG8_BAR;
        PG8_WAIT_V(2); PG8_BAR;
        PG8_STAGE(PG8_SB(1, 0), cB + kstep, voffB); PG8_STAGE(PG8_SA(1, 0), cA + kstep, voffA); PG8_STAGE(PG8_SB(1, 1), cB + hstep + kstep, voffB);
        PG8_WAIT_V(6); PG8_BAR;
    } else {
        PG8_STAGE(PG8_SB(0, 0), cB, voffB); PG8_STAGE(PG8_SA(0, 0), cA, voffA); PG8_STAGE(PG8_SB(0, 1), cB + hstep, voffB); PG8_STAGE(PG8_SA(0, 1), cA + hstep, voffA);
        if (wr == 1) PG8_BAR;
        PG8_WAIT_V(4); PG8_BAR;
        PG8_STAGE(PG8_SB(1, 0), cB + kstep, voffB); PG8_STAGE(PG8_SA(1, 0), cA + kstep, voffA); PG8_STAGE(PG8_SB(1, 1), cB + hstep + kstep, voffB);
        PG8_WAIT_V(6); PG8_BAR;
    }
    for (;;) {
        const bool has_next = S.next(ui + 1, nxt);
        const char* nA = has_next ? (const char*)g.A + (size_t)nxt.pm * tstep : cA; const char* nB = has_next ? (const char*)g.Bt + (size_t)nxt.pn * tstep : cB;
        for (int t = 0; t < nt; t += 2) {
            const bool last = (t == nt - 2);
            const char* a1 = cA + (size_t)(t + 1) * kstep;
            const char* a2 = last ? nA : cA + (size_t)(t + 2) * kstep; const char* b2 = last ? nB : cB + (size_t)(t + 2) * kstep;
            const char* a3 = a2 + kstep; const char* b3 = b2 + kstep;
            if (last && has_next) S.a_ready(nxt);
            if constexpr (Epi::MID) { if (t == nt / 2) E.mid(acc, cur, wr, wc, fr, fq); }
            if constexpr (SP2) {
            PG8_LDB(B0, 0, 0); PG8_LDB(B1, 0, 1); PG8_SCHED; PG8_LDA(At, 0, 0); PG8_STAGE(PG8_SA(1, 1), a1 + hstep, voffA);
            PG8_WAIT_V(8); PG8_WAIT_L(0); PG8_BAR; PG8_MMA(0, 0, At, B0); PG8_MMA(0, 1, At, B1); PG8_BAR; PG8_SCHED;
            PG8_LDA(At, 0, 1); PG8_STAGE(PG8_SB(0, 0), b2, voffB); PG8_STAGE(PG8_SB(0, 1), b2 + hstep, voffB); PG8_STAGE(PG8_SA(0, 0), a2, voffA);
            PG8_WAIT_V(8); PG8_WAIT_L(0); PG8_BAR; PG8_MMA(1, 0, At, B0); PG8_MMA(1, 1, At, B1); PG8_BAR; PG8_SCHED;
            PG8_LDB(B0, 1, 0); PG8_LDB(B1, 1, 1); PG8_SCHED; PG8_LDA(At, 1, 0); PG8_STAGE(PG8_SA(0, 1), a2 + hstep, voffA);
            PG8_WAIT_V(8); PG8_WAIT_L(0); PG8_BAR; PG8_MMA(0, 0, At, B0); PG8_MMA(0, 1, At, B1); PG8_BAR; PG8_SCHED;
            PG8_LDA(At, 1, 1); PG8_STAGE(PG8_SB(1, 0), b3, voffB); PG8_STAGE(PG8_SB(1, 1), b3 + hstep, voffB); PG8_STAGE(PG8_SA(1, 0), a3, voffA);
            PG8_WAIT_V(8); PG8_WAIT_L(0); PG8_BAR; PG8_MMA(1, 0, At, B0); PG8_MMA(1, 1, At, B1); PG8_BAR; PG8_SCHED;
            } else {
            PG8_LDB(B0, 0, 0); PG8_SCHED; PG8_LDA(At, 0, 0); PG8_STAGE(PG8_SA(1, 1), a1 + hstep, voffA);
            PG8_WAIT_L(8); PG8_BAR; PG8_WAIT_L(0); PG8_MMA(0, 0, At, B0); PG8_BAR; PG8_SCHED;
            PG8_LDB(B1, 0, 1); PG8_STAGE(PG8_SB(0, 0), b2, voffB);
            PG8_BAR; PG8_WAIT_L(0); PG8_MMA(0, 1, At, B1); PG8_BAR;
            PG8_LDA(At, 0, 1); PG8_STAGE(PG8_SA(0, 0), a2, voffA);
            PG8_BAR; PG8_WAIT_L(0); PG8_MMA(1, 0, At, B0); PG8_BAR; PG8_SCHED;
            PG8_STAGE(PG8_SB(0, 1), b2 + hstep, voffB);
            PG8_WAIT_V(6); PG8_BAR; PG8_MMA(1, 1, At, B1); PG8_BAR;
            PG8_LDB(B0, 1, 0); PG8_SCHED; PG8_LDA(At, 1, 0); PG8_STAGE(PG8_SA(0, 1), a2 + hstep, voffA);
            PG8_WAIT_L(8); PG8_BAR; PG8_WAIT_L(0); PG8_MMA(0, 0, At, B0); PG8_BAR; PG8_SCHED;
            PG8_LDB(B1, 1, 1); PG8_STAGE(PG8_SB(1, 0), b3, voffB);
            PG8_BAR; PG8_WAIT_L(0); PG8_MMA(0, 1, At, B1); PG8_BAR;
            PG8_LDA(At, 1, 1); PG8_STAGE(PG8_SA(1, 0), a3, voffA);
            PG8_BAR; PG8_WAIT_L(0); PG8_MMA(1, 0, At, B0); PG8_BAR; PG8_SCHED;
            PG8_STAGE(PG8_SB(1, 1), b3 + hstep, voffB);
            PG8_WAIT_V(6); PG8_BAR; PG8_MMA(1, 1, At, B1); PG8_BAR;
            }
        }
        if constexpr (ALIGN_EPI) { if (wr == 0) PG8_BAR; }
        if constexpr (!Epi::AFTER_DRAIN) { E(acc, cur, wr, wc, fr, fq); S.done(cur); }
        if (!has_next) break;
#pragma unroll
        for (int a = 0; a < 2; ++a)
#pragma unroll
            for (int b = 0; b < 2; ++b)
#pragma unroll
                for (int m = 0; m < 4; ++m)
#pragma unroll
                    for (int n = 0; n < 2; ++n) acc[a][b][m][n] = (f32x4){0.f, 0.f, 0.f, 0.f};
        cur = nxt; cA = nA; cB = nB; ++ui;
        if constexpr (ALIGN_EPI) { if (wr == 1) PG8_BAR; }
    }
    PG8_WAIT_V(0);
    if constexpr (!ALIGN_EPI) { if (wr == 0) PG8_BAR; }
    PG8_BAR;
    if constexpr (Epi::AFTER_DRAIN) { E.fused(acc, cur, wr, wc, fr, fq, lds, wid, lane); S.done(cur); }
#undef PG8_SA
#undef PG8_SB
#undef PG8_STAGE
#undef PG8_LDA
#undef PG8_LDB
#undef PG8_MMA
#undef PG8_WAIT_V
#undef PG8_WAIT_L
#undef PG8_BAR
#undef PG8_SCHED
}

struct UnitX { int pm, pn; int arow, brow; const int* glist; const float* wlist; int gvalid; int e; unsigned* sync; };
__device__ __forceinline__ void moe_dep_wait(unsigned* dep, unsigned* wdc, unsigned wd_need, volatile PG8_LAS unsigned* lflag, unsigned seq, int wid, unsigned pre_d, unsigned pre_w) {
    if (wid == 0) { unsigned sp = 0; unsigned d = pre_d, w = pre_w;
        while (d < 2u || w < wd_need) { __builtin_amdgcn_s_sleep(16); if (++sp > (1u << 20)) break;
            d = __builtin_amdgcn_readfirstlane(__hip_atomic_load(dep, __ATOMIC_RELAXED, __HIP_MEMORY_SCOPE_AGENT)); w = __builtin_amdgcn_readfirstlane(__hip_atomic_load(wdc, __ATOMIC_RELAXED, __HIP_MEMORY_SCOPE_AGENT)); }
        *lflag = seq; }
    else { unsigned sp = 0; while (*lflag < seq) { __builtin_amdgcn_s_sleep(4); if (++sp > (1u << 22)) break; } }
    asm volatile("" ::: "memory");
}
template <class Epi, class Sched, bool GATHER, int MODE = 0>
__device__ __forceinline__ void gemm_phase_x(PG8_LAS unsigned char* lds, const Gemm g, const Sched& S, const Epi& E, volatile PG8_LAS unsigned* lflag = nullptr, unsigned* wdc = nullptr, unsigned wd_need = 0u) {
    const int tid = threadIdx.x, wid = __builtin_amdgcn_readfirstlane(tid >> 6), lane = tid & 63, wr = wid >> 2, wc = wid & 3, fr = lane & 15, fq = lane >> 4;
    const int K = g.K, nt = K / BK;
    unsigned vA[2][2], voffB[2]; int tokn[2][2]; int Rr[2], Cc[2];
#pragma unroll
    for (int i = 0; i < 2; ++i) { int R, C; stage_rc(tid * 16 + i * 8192, R, C); const int Rb = Epi::PERM ? ((R & ~31) + perm32(R & 31)) : R; Rr[i] = R; Cc[i] = C; voffB[i] = (unsigned)(Rb * K + C) * 2u; }
    const size_t kstep = (size_t)(BK * 2), hstep = (size_t)HALF * K * 2;
    const unsigned ldsw = (unsigned)wid * 1024u;
    const int aoff = lds_byte(wr * 64 + fr, fq * 8), boff = lds_byte(wc * 32 + fr, fq * 8);
#define PG8_SA(b, h) (((b) * 2 + (h)) * HTB)
#define PG8_SB(b, h) ((4 + (b) * 2 + (h)) * HTB)
#define PG8_STAGE(bufoff, gbase, voff) do { _Pragma("unroll") for (int _i = 0; _i < 2; ++_i) \
        __builtin_amdgcn_global_load_lds((const unsigned*)((const char*)(gbase) + (voff)[_i]), (PG8_LAS unsigned*)(lds + (bufoff) + ldsw + _i * 8192), 16, 0, 0); } while (0)
#define PG8_LDA(dst, b, h) do { _Pragma("unroll") for (int m = 0; m < 4; ++m) _Pragma("unroll") for (int k = 0; k < 2; ++k) dst[m][k] = *(const PG8_LAS bf16x8*)(lds + PG8_SA(b, h) + aoff + m * 2048 + k * 1024); } while (0)
#define PG8_LDB(dst, b, h) do { _Pragma("unroll") for (int n = 0; n < 2; ++n) _Pragma("unroll") for (int k = 0; k < 2; ++k) dst[n][k] = *(const PG8_LAS bf16x8*)(lds + PG8_SB(b, h) + boff + n * 2048 + k * 1024); } while (0)
#define PG8_MMA(ai, bj, At, Bt) do { __builtin_amdgcn_s_setprio(1); _Pragma("unroll") for (int m = 0; m < 4; ++m) _Pragma("unroll") for (int n = 0; n < 2; ++n) _Pragma("unroll") for (int k = 0; k < 2; ++k) \
        acc[ai][bj][m][n] = __builtin_amdgcn_mfma_f32_16x16x32_bf16(Bt[n][k], At[m][k], acc[ai][bj][m][n], 0, 0, 0); __builtin_amdgcn_s_setprio(0); } while (0)
#define PG8_WAIT_V(n) asm volatile("s_waitcnt vmcnt(" #n ")" ::: "memory")
#define PG8_WAIT_L(n) asm volatile("s_waitcnt lgkmcnt(" #n ")" ::: "memory")
#define PG8_BAR __builtin_amdgcn_s_barrier()
#define PG8_SCHED __builtin_amdgcn_sched_barrier(0)
#define PG8_TOK(U, r) (GATHER ? (((r) < (U).gvalid) ? (U).glist[(r)] : 0) : ((U).arow + (r)))
    UnitX cur, nxt; int ui = 0;
    if (!S.next(0, cur)) return;
    if constexpr (MODE == 2) moe_dep_wait(cur.sync, wdc, wd_need, lflag, 1u, wid, 0u, 0u);
    f32x4 acc[2][2][4][2];
#pragma unroll
    for (int a = 0; a < 2; ++a)
#pragma unroll
        for (int b = 0; b < 2; ++b)
#pragma unroll
            for (int m = 0; m < 4; ++m)
#pragma unroll
                for (int n = 0; n < 2; ++n) acc[a][b][m][n] = (f32x4){0.f, 0.f, 0.f, 0.f};
    bf16x8 At[4][2], B0[2][2], B1[2][2];
#pragma unroll
    for (int h = 0; h < 2; ++h)
#pragma unroll
        for (int i = 0; i < 2; ++i) vA[h][i] = (unsigned)(PG8_TOK(cur, h * HALF + Rr[i]) * K + Cc[i]) * 2u;
    const char* gA = (const char*)g.A; const char* cB = (const char*)g.Bt + (size_t)cur.brow * K * 2;
    PG8_STAGE(PG8_SB(0, 0), cB, voffB); PG8_STAGE(PG8_SB(0, 1), cB + hstep, voffB); PG8_STAGE(PG8_SA(0, 0), gA, vA[0]); PG8_STAGE(PG8_SA(0, 1), gA, vA[1]);
    if (wr == 1) PG8_BAR;
    PG8_WAIT_V(2); PG8_BAR;
    PG8_STAGE(PG8_SB(1, 0), cB + kstep, voffB); PG8_STAGE(PG8_SA(1, 0), gA + kstep, vA[0]); PG8_STAGE(PG8_SB(1, 1), cB + hstep + kstep, voffB);
    PG8_WAIT_V(6); PG8_BAR;
    for (;;) {
        const bool has_next = S.next(ui + 1, nxt);
        unsigned pre_d = 0u, pre_w = 0u;
        if constexpr (MODE == 2) { if (has_next && wid == 0) { pre_d = __hip_atomic_load(nxt.sync, __ATOMIC_RELAXED, __HIP_MEMORY_SCOPE_AGENT); pre_w = __hip_atomic_load(wdc, __ATOMIC_RELAXED, __HIP_MEMORY_SCOPE_AGENT); } }
        const char* nB = has_next ? (const char*)g.Bt + (size_t)nxt.brow * K * 2 : cB;
        if (has_next) {
#pragma unroll
            for (int h = 0; h < 2; ++h)
#pragma unroll
                for (int i = 0; i < 2; ++i) tokn[h][i] = PG8_TOK(nxt, h * HALF + Rr[i]);
        }
#pragma clang loop unroll(disable)
        for (int t = 0; t < nt; t += 2) {
            const bool last = (t == nt - 2);
            const char* b2 = last ? nB : cB + (size_t)(t + 2) * kstep; const char* b3 = b2 + kstep;
            const size_t ko2 = last ? (size_t)0 : (size_t)(t + 2) * kstep;
            PG8_LDB(B0, 0, 0); PG8_LDB(B1, 0, 1); PG8_SCHED; PG8_LDA(At, 0, 0); PG8_STAGE(PG8_SA(1, 1), gA + (size_t)(t + 1) * kstep, vA[1]);
            PG8_WAIT_V(8); PG8_WAIT_L(0); PG8_BAR; PG8_MMA(0, 0, At, B0); PG8_MMA(0, 1, At, B1); PG8_BAR; PG8_SCHED;
            if (last && has_next) {
                if constexpr (MODE == 2) moe_dep_wait(nxt.sync, wdc, wd_need, lflag, (unsigned)(ui + 2), wid, (unsigned)__builtin_amdgcn_readfirstlane((int)pre_d), (unsigned)__builtin_amdgcn_readfirstlane((int)pre_w));
#pragma unroll
                for (int h = 0; h < 2; ++h)
#pragma unroll
                    for (int i = 0; i < 2; ++i) vA[h][i] = (unsigned)(tokn[h][i] * K + Cc[i]) * 2u;
            }
            PG8_LDA(At, 0, 1); PG8_STAGE(PG8_SB(0, 0), b2, voffB); PG8_STAGE(PG8_SB(0, 1), b2 + hstep, voffB); PG8_STAGE(PG8_SA(0, 0), gA + ko2, vA[0]);
            PG8_WAIT_V(8); PG8_WAIT_L(0); PG8_BAR; PG8_MMA(1, 0, At, B0); PG8_MMA(1, 1, At, B1); PG8_BAR; PG8_SCHED;
            PG8_LDB(B0, 1, 0); PG8_LDB(B1, 1, 1); PG8_SCHED; PG8_LDA(At, 1, 0); PG8_STAGE(PG8_SA(0, 1), gA + ko2, vA[1]);
            PG8_WAIT_V(8); PG8_WAIT_L(0); PG8_BAR; PG8_MMA(0, 0, At, B0); PG8_MMA(0, 1, At, B1); PG8_BAR; PG8_SCHED;
            PG8_LDA(At, 1, 1); PG8_STAGE(PG8_SB(1, 0), b3, voffB); PG8_STAGE(PG8_SB(1, 1), b3 + hstep, voffB); PG8_STAGE(PG8_SA(1, 0), gA + ko2 + kstep, vA[0]);
            PG8_WAIT_V(8); PG8_WAIT_L(0); PG8_BAR; PG8_MMA(1, 0, At, B0); PG8_MMA(1, 1, At, B1); PG8_BAR; PG8_SCHED;
        }
        if (wr == 0) PG8_BAR;
        { const int l2_ = (int)__builtin_amdgcn_mbcnt_hi(~0u, __builtin_amdgcn_mbcnt_lo(~0u, 0u)); E(acc, cur, wr, wc, l2_ & 15, l2_ >> 4); }
        if constexpr (MODE == 1) {
            asm volatile("s_waitcnt vmcnt(0)" ::: "memory"); PG8_BAR;
            if (wid == 0 && __builtin_amdgcn_mbcnt_hi(~0u, __builtin_amdgcn_mbcnt_lo(~0u, 0u)) == 0u) __hip_atomic_fetch_add(cur.sync, 1u, __ATOMIC_RELAXED, __HIP_MEMORY_SCOPE_AGENT); }
        if (!has_next) break;
#pragma unroll
        for (int a = 0; a < 2; ++a)
#pragma unroll
            for (int b = 0; b < 2; ++b)
#pragma unroll
                for (int m = 0; m < 4; ++m)
#pragma unroll
                    for (int n = 0; n < 2; ++n) acc[a][b][m][n] = (f32x4){0.f, 0.f, 0.f, 0.f};
        cur = nxt; cB = nB; ++ui;
        if (wr == 1) PG8_BAR;
    }
    PG8_WAIT_V(0);
    PG8_BAR;
#undef PG8_TOK
#undef PG8_SA
#undef PG8_SB
#undef PG8_STAGE
#undef PG8_LDA
#undef PG8_LDB
#undef PG8_MMA
#undef PG8_WAIT_V
#undef PG8_WAIT_L
#undef PG8_BAR
#undef PG8_SCHED
}
struct MoeTiles { PG8_LAS int* te; PG8_LAS int* tm; PG8_LAS int* tv; int T; };
struct SchedMoeA {
    MoeTiles mt; const int* ELT; const float* ELW; int vcu, G; unsigned* DONE;
    __device__ __forceinline__ bool next(int i, UnitX& u) const {
        const int idx = i * G + vcu; if (idx >= 2 * mt.T) return false;
        const int ti = idx >> 1, nn = idx & 1, e = mt.te[ti], m = mt.tm[ti];
        u.pm = ti; u.pn = nn; u.arow = 0; u.brow = e * 512 + nn * 256; u.glist = ELT + e * M + m * 256; u.wlist = ELW + e * M + m * 256; u.gvalid = mt.tv[ti]; u.e = e; u.sync = DONE + ti * 16; return true; }
};
struct SchedMoeB {
    MoeTiles mt; int vcu, G; unsigned* DONE;
    __device__ __forceinline__ bool next(int i, UnitX& u) const {
        int nA = 2 * mt.T - G; if (nA < 0 || nA >= G - 32) nA = 0; const int nB = G - nA;
        int idx; const int base3 = 3 * nB + nA;
        if (vcu < nA) idx = i == 0 ? 2 * nB + vcu : base3 + (i - 1) * G + vcu;
        else { const int j = vcu - nA; idx = i < 2 ? i * nB + j : (i == 2 ? 2 * nB + nA + j : base3 + (i - 3) * G + vcu); }
        if (idx >= 4 * mt.T) return false;
        const int ti = idx >> 2, nn = idx & 3, e = mt.te[ti];
        u.pm = ti; u.pn = nn; u.arow = ti * 256; u.brow = e * 1024 + nn * 256; u.glist = nullptr; u.wlist = nullptr; u.gvalid = 256; u.e = e; u.sync = DONE + ti * 16; return true; }
};
struct EpiAct {
    static constexpr bool PERM = true;
    bf16_t* ACT; __amdgpu_buffer_rsrc_t rsrc;
    __device__ __forceinline__ void operator()(const f32x4 (&acc)[2][2][4][2], const UnitX& u, int wr, int wc, int fr, int fq) const {
        int base = ((u.pm * BM + wr * 64 + fr) * 256 + u.pn * 128 + wc * 32 + 8 * fq) * 2; asm volatile("" : "+v"(base));
        const int r0 = wr * 64 + fr;
#pragma unroll
        for (int ai = 0; ai < 2; ++ai)
#pragma unroll
            for (int m = 0; m < 4; ++m) { const int r = ai * HALF + m * 16 + r0; const float w = r < u.gvalid ? u.wlist[r] : 0.f;
                f32x4 v0, v1;
#pragma unroll
                for (int j = 0; j < 4; ++j) { const float g0 = acc[ai][0][m][0][j], g1 = acc[ai][0][m][1][j];
                    v0[j] = g0 * __builtin_amdgcn_rcpf(1.f + __builtin_amdgcn_exp2f(-1.4426950408889634f * g0)) * acc[ai][1][m][0][j] * w;
                    v1[j] = g1 * __builtin_amdgcn_rcpf(1.f + __builtin_amdgcn_exp2f(-1.4426950408889634f * g1)) * acc[ai][1][m][1][j] * w; }
                u32x4 o; o.x = cvt_pk_bf16(v0[0], v0[1]); o.y = cvt_pk_bf16(v0[2], v0[3]); o.z = cvt_pk_bf16(v1[0], v1[1]); o.w = cvt_pk_bf16(v1[2], v1[3]);
                __builtin_amdgcn_raw_buffer_store_b128(o, rsrc, base + (ai * HALF + m * 16) * 512, 0, 16  ); }
    }
};
struct EpiY {
    static constexpr bool PERM = true;
    bf16_t* Y; __amdgpu_buffer_rsrc_t yrsrc;
    __device__ __forceinline__ void operator()(const f32x4 (&acc)[2][2][4][2], const UnitX& u, int wr, int wc, int fr, int fq) const {
        const int c0 = u.pn * BM + wc * 32 + 8 * fq;
#pragma unroll
        for (int ai = 0; ai < 2; ++ai)
#pragma unroll
            for (int m = 0; m < 4; ++m) { const int ro = (u.pm * BM + ai * HALF + wr * 64 + m * 16 + fr) * 1024 + c0;
#pragma unroll
                for (int bj = 0; bj < 2; ++bj) { const f32x4 v0 = acc[ai][bj][m][0], v1 = acc[ai][bj][m][1]; u32x4 o;
                    o.x = cvt_pk_bf16(v0[0], v0[1]); o.y = cvt_pk_bf16(v0[2], v0[3]); o.z = cvt_pk_bf16(v1[0], v1[1]); o.w = cvt_pk_bf16(v1[2], v1[3]);
                    __builtin_amdgcn_raw_buffer_store_b128(o, yrsrc, (ro + bj * HALF) * 2, 0, 16  ); } }
    }
};
}

struct TrItem { const float* W; bf16_t* WT; int N, ldd, k0, kd0, n0, drow0; };
DEV void tr_load(const TrItem& t, f32x4 (&r)[8], int lane) {
    const float* p = t.W + (size_t)(t.k0 + (lane >> 3)) * t.N + t.n0 + (lane & 7) * 4;
#pragma unroll
    for (int i = 0; i < 8; ++i) r[i] = __builtin_nontemporal_load((const f32x4*)(p + (size_t)(8 * i) * t.N));
}
template <bool SC1 = false> DEV void tr_emit(const TrItem& t, const f32x4 (&r)[8], LAS float* scr, int lane, __amdgpu_buffer_rsrc_t wrsrc = __amdgpu_buffer_rsrc_t(), const bf16_t* wbase = nullptr) {
    { const int kq = lane >> 3, nq = (lane & 7) * 4;
#pragma unroll
      for (int i = 0; i < 8; ++i) { LAS float* d = scr + (8 * i + kq) * 33 + nq; d[0] = r[i].x; d[1] = r[i].y; d[2] = r[i].z; d[3] = r[i].w; } }
    LDS_WAIT(); asm volatile("" ::: "memory");
    const int c = lane & 7;
#pragma unroll
    for (int j = 0; j < 4; ++j) { const int n = (lane >> 3) + 8 * j; const LAS float* s = scr + (8 * c) * 33 + n;
        v4u o; o.x = pk2(s[0 * 33], s[1 * 33]); o.y = pk2(s[2 * 33], s[3 * 33]); o.z = pk2(s[4 * 33], s[5 * 33]); o.w = pk2(s[6 * 33], s[7 * 33]);
        if constexpr (SC1) __builtin_amdgcn_raw_buffer_store_b128(o, wrsrc, (int)((t.WT + (size_t)(t.drow0 + n) * t.ldd + t.kd0 + 8 * c) - wbase) * 2, 0, 16  );
        else *(GAS v4u*)(t.WT + (size_t)(t.drow0 + n) * t.ldd + t.kd0 + 8 * c) = o; }
    LDS_WAIT(); asm volatile("" ::: "memory");
}
DEV int in_row_map(int c0) {
    if (c0 < 1024) { const int sect = c0 >> 9, cc = c0 & 511, tile = cc >> 8, u = (cc & 255) >> 6, half = (cc & 63) >> 5; return sect * 512 + tile * 256 + half * 128 + u * 32; }
    if (c0 < 2048) return c0;
    if (c0 < 3072) { const int isu = c0 >= 2560, ch = c0 - (isu ? 2560 : 2048); return 2048 + (ch >> 7) * 256 + isu * 128 + (ch & 127); }
    return c0;
}
DEV void p0_prologue(Frame& F, const Args& a) {
    const float* c = (const float*)a.in[1]; const int* pos = (const int*)a.in[2]; const float* w_ada = (const float*)a.in[3]; const float* b_ada = (const float*)a.in[4];
    float* MOD = (float*)(F.ws + WS_MOD); float* ROPE = (float*)(F.ws + WS_ROPE);
    {
        LAS float* ca = (LAS float*)F.lds;
        LAS float* part = (LAS float*)(F.lds + 16384);
        for (int i = F.tid; i < 4 * DM; i += NTHR) { const float v = c[i]; ca[i] = v / (1.f + expf(-v)); }
        __syncthreads();
        for (int ch = blockIdx.x; ch < 256; ch += F.G) {
            const int col = F.tid % 24, ks = F.tid / 24;
            if (ks < 21) {
                float a0 = 0.f, a1 = 0.f, a2 = 0.f, a3 = 0.f;
                const float* wp = w_ada + (size_t)ks * 6144 + ch * 24 + col;
                for (int k = ks; k < DM; k += 21 * 13) {
                    float w[13];
#pragma unroll
                    for (int j = 0; j < 13; ++j) w[j] = (k + 21 * j < DM) ? __builtin_nontemporal_load(wp + (size_t)(k - ks + 21 * j) * 6144) : 0.f;
#pragma unroll
                    for (int j = 0; j < 13; ++j) { const int kk = (k + 21 * j < DM) ? k + 21 * j : 0; a0 += ca[kk] * w[j]; a1 += ca[DM + kk] * w[j]; a2 += ca[2 * DM + kk] * w[j]; a3 += ca[3 * DM + kk] * w[j]; }
                }
                part[(ks * 4 + 0) * 24 + col] = a0; part[(ks * 4 + 1) * 24 + col] = a1; part[(ks * 4 + 2) * 24 + col] = a2; part[(ks * 4 + 3) * 24 + col] = a3;
            }
            __syncthreads();
            if (F.tid < 96) { const int b = F.tid / 24, cc = F.tid % 24; float s = b_ada[ch * 24 + cc];
                for (int q = 0; q < 21; ++q) s += part[(q * 4 + b) * 24 + cc];
                __hip_atomic_store(MOD + b * 6144 + ch * 24 + cc, s, __ATOMIC_RELAXED, __HIP_MEMORY_SCOPE_AGENT); }
            asm volatile("s_waitcnt vmcnt(0)" ::: "memory");
            __syncthreads();
            if (F.tid == 0) __hip_atomic_fetch_add(F.ctl + CW_MODC, 1u, __ATOMIC_RELAXED, __HIP_MEMORY_SCOPE_AGENT);
        }
    }
    const int gt = F.vcu * NTHR + F.tid, NGT = F.G * NTHR;
    for (int idx = gt; idx < M * 32; idx += NGT) {
        const int row = idx >> 5, i = idx & 31;
        const float inv = exp2f(-(float)i * (13.287712379549449f / 32.f));
        float s, cs; sincosf((float)pos[row] * inv, &s, &cs);
        __hip_atomic_store((unsigned long long*)(ROPE + idx * 2), (unsigned long long)__float_as_uint(cs) | ((unsigned long long)__float_as_uint(s) << 32), __ATOMIC_RELAXED, __HIP_MEMORY_SCOPE_AGENT);
    }
    {
        const float* w_grp = (const float*)a.in[17]; const float* w_exr = (const float*)a.in[19];
        bf16_t* RH = (bf16_t*)(F.ws + WS_WT_R); bf16_t* RL = RH + 48 * DM;
        for (int idx = gt; idx < 48 * DM; idx += NGT) { const int n = idx >> 10, k = idx & 1023;
            const float w = n < 4 ? w_grp[k * 4 + n] : (n < 36 ? w_exr[k * 32 + (n - 4)] : 0.f);
            const bf16_t h = f2bf(w); __hip_atomic_store((unsigned short*)(RH + idx), (unsigned short)h, __ATOMIC_RELAXED, __HIP_MEMORY_SCOPE_AGENT); __hip_atomic_store((unsigned short*)(RL + idx), (unsigned short)f2bf(w - bf2f(h)), __ATOMIC_RELAXED, __HIP_MEMORY_SCOPE_AGENT); }
    }
    __syncthreads();
    LAS float* scr = (LAS float*)(F.lds + F.wave * 16384);
    const int gw = F.vcu * NWAVES + F.wave, NGW = F.G * NWAVES;
    constexpr int I_IN = 16 * 160, I_A = 8 * 32, I_O = 16 * 32, I_G = 32 * 16 * 8, I_D = 32 * 4 * 32;
    constexpr int NITEMS = I_IN + 2 * I_A + I_O + 2 * I_G;
    (void)I_D;
    auto decode = [&](int it) -> TrItem {
        TrItem t; int r = it;
        if (r < I_IN) { const int kb = r / 160, nb = r % 160; t.W = (const float*)a.in[6]; t.N = INW; t.WT = (bf16_t*)(F.ws + WS_WT_IN); t.ldd = DM; t.k0 = kb * 64; t.kd0 = t.k0; t.n0 = nb * 32; t.drow0 = in_row_map(nb * 32); return t; } r -= I_IN;
        if (r < I_A) { const int kb = r / 32, nb = r % 32; t.W = (const float*)a.in[13]; t.N = DM; t.WT = (bf16_t*)(F.ws + WS_WT_A); t.ldd = 1024; t.k0 = kb * 64; t.kd0 = t.k0; t.n0 = nb * 32; t.drow0 = nb * 32; return t; } r -= I_A;
        if (r < I_A) { const int kb = r / 32, nb = r % 32; t.W = (const float*)a.in[14]; t.N = DM; t.WT = (bf16_t*)(F.ws + WS_WT_A); t.ldd = 1024; t.k0 = kb * 64; t.kd0 = 512 + t.k0; t.n0 = nb * 32; t.drow0 = nb * 32; return t; } r -= I_A;
        if (r < I_O) { const int kb = r / 32, nb = r % 32; t.W = (const float*)a.in[15]; t.N = DM; t.WT = (bf16_t*)(F.ws + WS_WT_O); t.ldd = DM; t.k0 = kb * 64; t.kd0 = t.k0; t.n0 = nb * 32; t.drow0 = nb * 32; return t; } r -= I_O;
        if (r < 2 * I_G) { const int isu = r >= I_G; if (isu) r -= I_G; const int e = r / 128, q = r % 128, kb = q / 8, nb = q % 8, n0 = nb * 32;
            t.W = (const float*)a.in[isu ? 22 : 21] + (size_t)e * DM * FF; t.N = FF; t.WT = (bf16_t*)(F.ws + WS_WT_GU) + (size_t)e * 512 * DM; t.ldd = DM; t.k0 = kb * 64; t.kd0 = t.k0; t.n0 = n0; t.drow0 = (n0 >> 7) * 256 + isu * 128 + (n0 & 127); return t; } r -= 2 * I_G;
        { const int e = r / 128, q = r % 128, kb = q / 32, nb = q % 32;
          t.W = (const float*)a.in[23] + (size_t)e * FF * DM; t.N = DM; t.WT = (bf16_t*)(F.ws + WS_WT_D) + (size_t)e * DM * FF; t.ldd = FF; t.k0 = kb * 64; t.kd0 = t.k0; t.n0 = nb * 32; t.drow0 = nb * 32; return t; }
    };
    const __amdgpu_buffer_rsrc_t wrsrc = __builtin_amdgcn_make_buffer_rsrc((void*)(F.ws + WS_WEIGHTS), 0, 64 * 1024 * 1024, 0x00020000);
    if (gw < NITEMS) {
        TrItem cur = decode(gw); f32x4 rc[8]; tr_load(cur, rc, F.lane);
        for (int it = gw; it < NITEMS; it += NGW) {
            const int nx = it + NGW; TrItem nxt = cur; f32x4 rn[8];
            if (nx < NITEMS) { nxt = decode(nx); tr_load(nxt, rn, F.lane); }
            tr_emit<true>(cur, rc, scr, F.lane, wrsrc, (const bf16_t*)(F.ws + WS_WEIGHTS));
            if (nx < NITEMS) { cur = nxt;
#pragma unroll
                for (int i = 0; i < 8; ++i) rc[i] = rn[i]; }
        }
    }
    asm volatile("s_waitcnt vmcnt(0)" ::: "memory"); __syncthreads();
    if (F.tid == 0) __hip_atomic_fetch_add(F.ctl + CW_P0C, 1u, __ATOMIC_RELAXED, __HIP_MEMORY_SCOPE_AGENT);
}

DEV void p7_wdown_transposes(Frame& F, const Args& a, int worker, int nworkers, unsigned* wdc) {
    LAS float* scr = (LAS float*)(F.lds + F.wave * 16384);
    constexpr int I_D = 32 * 4 * 32;
    auto decode = [&](int r) -> TrItem { TrItem t; const int e = r / 128, q = r % 128, kb = q / 32, nb = q % 32;
        t.W = (const float*)a.in[23] + (size_t)e * FF * DM; t.N = DM; t.WT = (bf16_t*)(F.ws + WS_WT_D) + (size_t)e * DM * FF; t.ldd = FF; t.k0 = kb * 64; t.kd0 = t.k0; t.n0 = nb * 32; t.drow0 = nb * 32; return t; };
    const int gw = worker * NWAVES + F.wave, NGW = nworkers * NWAVES;
    const __amdgpu_buffer_rsrc_t wrsrc = __builtin_amdgcn_make_buffer_rsrc((void*)(F.ws + WS_WEIGHTS), 0, 64 * 1024 * 1024, 0x00020000);
    if (gw < I_D) {
        TrItem cur = decode(gw); f32x4 rc[8]; tr_load(cur, rc, F.lane);
        for (int it = gw; it < I_D; it += NGW) {
            const int nx = it + NGW; TrItem nxt = cur; f32x4 rn[8];
            if (nx < I_D) { nxt = decode(nx); tr_load(nxt, rn, F.lane); }
            tr_emit<true>(cur, rc, scr, F.lane, wrsrc, (const bf16_t*)(F.ws + WS_WEIGHTS));
            if (nx < I_D) { cur = nxt;
#pragma unroll
                for (int i = 0; i < 8; ++i) rc[i] = rn[i]; }
        }
    }
    asm volatile("s_waitcnt vmcnt(0)" ::: "memory"); __syncthreads();
    if (F.tid == 0) __hip_atomic_fetch_add(wdc, 1u, __ATOMIC_RELAXED, __HIP_MEMORY_SCOPE_AGENT);
}
DEV void p1_h(Frame& F, const Args& a) {
    { unsigned sp = 0;
      while (__builtin_amdgcn_readfirstlane(__hip_atomic_load(F.ctl + CW_MODC, __ATOMIC_RELAXED, __HIP_MEMORY_SCOPE_AGENT)) < 256u) { __builtin_amdgcn_s_sleep(8); if (++sp > (1u << 20)) break; }
      asm volatile("" ::: "memory"); }
    const float* x = (const float*)a.in[0]; const float* g = (const float*)a.in[5]; const float* MOD = (const float*)(F.ws + WS_MOD); bf16_t* Hb = (bf16_t*)(F.ws + WS_H);
    for (int ch = F.vcu; ch < M / 64; ch += F.G) {
    for (int m0 = ch * 64 + F.wave; m0 < ch * 64 + 64; m0 += 2 * NWAVES) {
        const int m1 = m0 + NWAVES;
        const GAS f32x4* xr0 = (const GAS f32x4*)(x + (size_t)m0 * DM) + F.lane; const GAS f32x4* xr1 = (const GAS f32x4*)(x + (size_t)m1 * DM) + F.lane;
        f32x4 v0[4], v1[4]; float s0 = 0.f, s1 = 0.f;
#pragma unroll
        for (int j = 0; j < 4; ++j) { v0[j] = __builtin_nontemporal_load(xr0 + 64 * j); v1[j] = __builtin_nontemporal_load(xr1 + 64 * j); }
#pragma unroll
        for (int j = 0; j < 4; ++j) { s0 += (v0[j].x * v0[j].x + v0[j].y * v0[j].y) + (v0[j].z * v0[j].z + v0[j].w * v0[j].w); s1 += (v1[j].x * v1[j].x + v1[j].y * v1[j].y) + (v1[j].z * v1[j].z + v1[j].w * v1[j].w); }
        const float r0 = rsqrtf(wave_sum(s0) * (1.f / DM) + EPS), r1 = rsqrtf(wave_sum(s1) * (1.f / DM) + EPS);
        const float* md0 = MOD + (m0 / SEQ) * 6144; const float* md1 = MOD + (m1 / SEQ) * 6144;
        GAS unsigned long long* o0 = (GAS unsigned long long*)(Hb + (size_t)m0 * DM) + F.lane; GAS unsigned long long* o1 = (GAS unsigned long long*)(Hb + (size_t)m1 * DM) + F.lane;
#pragma unroll
        for (int j = 0; j < 4; ++j) { const int k = 4 * F.lane + 256 * j; const f32x4 gg = *(const f32x4*)(g + k);
            const f32x4 h0 = v0[j] * r0 * gg * (*(const f32x4*)(md0 + 1024 + k) + 1.f) + *(const f32x4*)(md0 + k);
            const f32x4 h1 = v1[j] * r1 * gg * (*(const f32x4*)(md1 + 1024 + k) + 1.f) + *(const f32x4*)(md1 + k);
            __hip_atomic_store((unsigned long long*)(o0 + 64 * j), (unsigned long long)pk2(h0.x, h0.y) | ((unsigned long long)pk2(h0.z, h0.w) << 32), __ATOMIC_RELAXED, __HIP_MEMORY_SCOPE_AGENT);
            __hip_atomic_store((unsigned long long*)(o1 + 64 * j), (unsigned long long)pk2(h1.x, h1.y) | ((unsigned long long)pk2(h1.z, h1.w) << 32), __ATOMIC_RELAXED, __HIP_MEMORY_SCOPE_AGENT); }
    }
    asm volatile("s_waitcnt vmcnt(0)" ::: "memory"); __syncthreads();
    if (F.tid == 0) __hip_atomic_fetch_add(F.ctl + CW_PC1 + (ch >> 2) * 16, 1u, __ATOMIC_RELAXED, __HIP_MEMORY_SCOPE_AGENT);
    }
}

namespace att {
typedef short bf16x8 __attribute__((ext_vector_type(8)));
typedef short s16x4 __attribute__((ext_vector_type(4)));
typedef float f32x16 __attribute__((ext_vector_type(16)));
typedef float f32x4 __attribute__((ext_vector_type(4)));
typedef unsigned u32x4 __attribute__((ext_vector_type(4)));
constexpr int LD = 512;
constexpr int LDO = 1024;
constexpr int NW = 8, QBLK = 32, KVBLK = 64, QB = 128, NQB = SEQ / QB;
constexpr int SHM_V = KVBLK * 128 * 2, SHM_K = KVBLK * 128 * 2;
constexpr int LDS_WS = 2 * SHM_V + 2 * SHM_K, LDS_XCH = LDS_WS + NW * 64 * 4, LDS_END = LDS_XCH + 4 * 32 * 128 * 4;
constexpr float SCALE = 0.125f, THR = 8.f;
#define KSWZ(row, colB) ((row) * 256 + ((colB) ^ (((row) & 7) << 4)))
#define SBAR() __builtin_amdgcn_sched_barrier(0)
__device__ __forceinline__ int v_st(int k, int c) { const int kk = (k & ~0xC) | ((k & 4) << 1) | ((k & 8) >> 1); return ((kk >> 3) * 4 + (c >> 5)) * 512 + ((kk & 7) * 32 + (c & 31)) * 2; }
__device__ __forceinline__ int v_rd_base(int lane) { return ((lane & 3) << 3) | (((lane >> 2) & 3) << 6) | (((lane >> 4) & 1) << 5) | (((lane >> 5) & 1) << 8); }
constexpr int v_rd_off(int d0, int ks, int half) { return d0 * 512 + ks * 4096 + half * 2048; }
__device__ __forceinline__ int crow(int r, int hi) { return (r & 3) + 8 * (r >> 2) + 4 * hi; }
typedef float f32x2a_t __attribute__((ext_vector_type(2))); typedef __bf16 bf16x2a_t __attribute__((ext_vector_type(2)));
__device__ __forceinline__ unsigned cvtpk(float lo, float hi) { f32x2a_t v = {lo, hi}; bf16x2a_t b = __builtin_convertvector(v, bf16x2a_t); return __builtin_bit_cast(unsigned, b); }
__device__ __forceinline__ bf16x8 load8(const bf16_t* p) { return *reinterpret_cast<const bf16x8*>(p); }
__device__ __forceinline__ void mask_tile(f32x16& p0, f32x16& p1, int dq) {
    const float NEG = -__builtin_inff();
#pragma unroll
    for (int r = 0; r < 16; ++r) { const int c = (r & 3) + 8 * (r >> 2); if (dq - c < 0) p0[r] = NEG; if (dq - c - 32 < 0) p1[r] = NEG; }
}
__device__ __forceinline__ void partialSM(f32x16& p0, f32x16& p1, float& m_reg, float& mn, float& alpha) {
    float pmax = p0[0]; for (int r = 1; r < 16; ++r) pmax = fmaxf(pmax, p0[r]); for (int r = 0; r < 16; ++r) pmax = fmaxf(pmax, p1[r]);
    { auto rr = __builtin_amdgcn_permlane32_swap(__float_as_uint(pmax), __float_as_uint(pmax), false, false);
      pmax = fmaxf(__uint_as_float(rr[0]), __uint_as_float(rr[1])); }
    constexpr float C2 = 1.4426950408889634f * SCALE;
    if (__builtin_expect(__all((pmax - m_reg) * SCALE <= THR), 1)) { mn = m_reg; alpha = 1.f; }
    else { mn = fmaxf(m_reg, pmax); alpha = __builtin_amdgcn_exp2f((m_reg - mn) * C2); m_reg = mn; }
    const float mnL = -mn * C2;
    for (int r = 0; r < 16; ++r) p0[r] = fmaf(p0[r], C2, mnL); for (int r = 0; r < 16; ++r) p1[r] = fmaf(p1[r], C2, mnL);
    for (int r = 0; r < 16; ++r) p0[r] = __builtin_amdgcn_exp2f(p0[r]);
}
__device__ __forceinline__ void finishSM(f32x16& p0, f32x16& p1, float alpha, float& l_reg, bf16x8& pa0, bf16x8& pa1, bf16x8& pa2, bf16x8& pa3) {
    for (int r = 0; r < 16; ++r) p1[r] = __builtin_amdgcn_exp2f(p1[r]);
    float ps = 0; for (int r = 0; r < 16; ++r) ps += p0[r]; for (int r = 0; r < 16; ++r) ps += p1[r];
    { auto rr = __builtin_amdgcn_permlane32_swap(__float_as_uint(ps), __float_as_uint(ps), false, false);
      ps = __uint_as_float(rr[0]) + __uint_as_float(rr[1]); }
    l_reg = l_reg * alpha + ps;
#define PK4(P, B_, OUT) do { unsigned a0 = cvtpk(P[B_+0], P[B_+1]), a1 = cvtpk(P[B_+2], P[B_+3]);                          \
        unsigned b0 = cvtpk(P[B_+4], P[B_+5]), b1 = cvtpk(P[B_+6], P[B_+7]);                                             \
        auto r0 = __builtin_amdgcn_permlane32_swap(a0, b0, false, false); auto r1 = __builtin_amdgcn_permlane32_swap(a1, b1, false, false); \
        u32x4 w = {r0[0], r1[0], r0[1], r1[1]}; OUT = *reinterpret_cast<bf16x8*>(&w); } while (0)
    PK4(p0, 0, pa0); PK4(p0, 8, pa1); PK4(p1, 0, pa2); PK4(p1, 8, pa3);
#undef PK4
}
template <int KB>
__device__ __forceinline__ void qkt(f32x16& p0, f32x16& p1, const char* K_lds, int r32, int hi, int mp, const bf16x8* qr) {
    p0 = f32x16{}; p1 = f32x16{};
    const char* kb[4];
#pragma unroll
    for (int dd = 0; dd < 4; ++dd) kb[dd] = K_lds + KB * SHM_K + KSWZ(r32, (dd * 16 + hi * 8) * 2) + mp * 128;
    __builtin_amdgcn_s_setprio(1);
#pragma unroll
    for (int d0 = 0; d0 < 4; ++d0) { const char* a = kb[d0];
        bf16x8 b0 = *reinterpret_cast<const bf16x8*>(a);
        bf16x8 b1 = *reinterpret_cast<const bf16x8*>(a + 32 * 256);
        p0 = __builtin_amdgcn_mfma_f32_32x32x16_bf16(b0, qr[d0], p0, 0, 0, 0);
        p1 = __builtin_amdgcn_mfma_f32_32x32x16_bf16(b1, qr[d0], p1, 0, 0, 0); }
    __builtin_amdgcn_s_setprio(0);
}
template <int VB>
__device__ __forceinline__ void pv_tile(f32x16* o, int vb0, bf16x8 pa0, bf16x8 pa1, bf16x8 pa2, bf16x8 pa3) {
#define TRRD(dst, off) asm volatile("ds_read_b64_tr_b16 %0, %1 offset:%2" : "=&v"(dst) : "v"(vb0), "i"(off) : "memory")
#define PV_D0(d0) do { s16x4 l0, l1, l2, l3, h0, h1, h2, h3; constexpr int b_ = VB * SHM_V + v_rd_off(d0, 0, 0); \
        TRRD(l0, b_); TRRD(h0, b_ + 2048); TRRD(l1, b_ + 4096); TRRD(h1, b_ + 6144); TRRD(l2, b_ + 8192); TRRD(h2, b_ + 10240); TRRD(l3, b_ + 12288); TRRD(h3, b_ + 14336); \
        asm volatile("s_waitcnt lgkmcnt(0)" ::: "memory"); SBAR();   \
        o[d0] = __builtin_amdgcn_mfma_f32_32x32x16_bf16(pa0, (bf16x8){l0[0], l0[1], l0[2], l0[3], h0[0], h0[1], h0[2], h0[3]}, o[d0], 0, 0, 0);   \
        o[d0] = __builtin_amdgcn_mfma_f32_32x32x16_bf16(pa1, (bf16x8){l1[0], l1[1], l1[2], l1[3], h1[0], h1[1], h1[2], h1[3]}, o[d0], 0, 0, 0);   \
        o[d0] = __builtin_amdgcn_mfma_f32_32x32x16_bf16(pa2, (bf16x8){l2[0], l2[1], l2[2], l2[3], h2[0], h2[1], h2[2], h2[3]}, o[d0], 0, 0, 0);   \
        o[d0] = __builtin_amdgcn_mfma_f32_32x32x16_bf16(pa3, (bf16x8){l3[0], l3[1], l3[2], l3[3], h3[0], h3[1], h3[2], h3[3]}, o[d0], 0, 0, 0); } while (0)
    __builtin_amdgcn_s_setprio(1); PV_D0(0); PV_D0(1); PV_D0(2); PV_D0(3); __builtin_amdgcn_s_setprio(0);
#undef PV_D0
#undef TRRD
}
struct BlockRef { int qoff, koff, P0, ooff; };
struct Bufs { const bf16_t* Q; const bf16_t* K; const bf16_t* V; bf16_t* O; };
struct Seam { bf16x8 qr[4]; bf16x8 st_v0, st_v1, st_k0, st_k1; };
#define ROW(p, k0, rr) ((p) + (size_t)((k0) + (rr)) * LD + sc)
#define VMW() asm volatile("s_waitcnt vmcnt(0)" ::: "memory")
#define VMWN(n) asm volatile("s_waitcnt vmcnt(%0)" :: "i"(n) : "memory")
#define SLOAD_H(Kp, Vp, k0) do { S.st_v0 = load8(ROW(Vp, k0, sr)); S.st_v1 = load8(ROW(Vp, k0, 32 + sr));              \
                         S.st_k0 = load8(ROW(Kp, k0, sr)); S.st_k1 = load8(ROW(Kp, k0, 32 + sr)); } while (0)
#define SWRITE_HK(bf) do { *(bf16x8*)(K_lds + (bf) * SHM_K + kws) = S.st_k0; *(bf16x8*)(K_lds + (bf) * SHM_K + kws + 32 * 256) = S.st_k1; } while (0)
#define SWRITE_HV(bf) do { *(bf16x8*)(V_lds + (bf) * SHM_V + vst0) = S.st_v0; *(bf16x8*)(V_lds + (bf) * SHM_V + vst1) = S.st_v1; } while (0)
#define SWRITE_H(bf) do { SWRITE_HV(bf); SWRITE_HK(bf); } while (0)
__device__ __forceinline__ void attn_prime(const Bufs& B, const BlockRef& cur, char* lds, Seam& S) {
    const int tid = threadIdx.x, wid = __builtin_amdgcn_readfirstlane(tid >> 6), lane = tid & 63, r32 = lane & 31, hi = lane >> 5, wq = wid & 3, mp = wid >> 2;
    const int sr = tid >> 4, sc = (tid & 15) * 8, kws = KSWZ(sr, sc * 2); char* K_lds = lds + 2 * SHM_V;
#pragma unroll
    for (int d0 = 0; d0 < 4; ++d0) S.qr[d0] = load8(B.Q + cur.qoff + (size_t)(wq * QBLK + r32) * LD + mp * 64 + d0 * 16 + hi * 8);
    SLOAD_H(B.K + cur.koff, B.V + cur.koff, 0); VMW(); SWRITE_HK(0);
    __syncthreads();
}
__device__ __forceinline__ void attn_block(const Bufs& B, const BlockRef& cur, const BlockRef& nxt, char* lds, Seam& S, float lam, const float* __restrict__ subln_g) {
    const int tid = threadIdx.x, wid = __builtin_amdgcn_readfirstlane(tid >> 6), lane = tid & 63, r32 = lane & 31, hi = lane >> 5, wq = wid & 3, mp = wid >> 2;
    const int NT = (cur.P0 + QB - 1) / KVBLK + 1;
    const int qlo = cur.P0 + wq * QBLK, qm = qlo + r32 - 4 * hi;
    char* V_lds = lds; char* K_lds = lds + 2 * SHM_V;
    float* ws = (float*)(lds + LDS_WS) + wid * 64; float* li_l = ws, * al_l = ws + 32;
    float m_reg = -1e30f, l_reg = 0; f32x16 o[4] = {};
    const int sr = tid >> 4, sc = (tid & 15) * 8, vst0 = v_st(sr, sc), vst1 = v_st(32 + sr, sc), kws = KSWZ(sr, sc * 2);
    const int vb0 = (int)(uintptr_t)V_lds + v_rd_base(lane);
    const bf16_t* Kh = B.K + cur.koff; const bf16_t* Vh = B.V + cur.koff;
#define RESC(a) do { if (__any((a) < 1.f)) { if (hi == 0) al_l[r32] = (a); asm volatile("s_waitcnt lgkmcnt(0)" ::: "memory");              \
                     for (int d_ = 0; d_ < 4; ++d_) for (int r = 0; r < 16; ++r) o[d_][r] *= al_l[crow(r, hi)]; } } while (0)
#define KBASE(t) ((t) * KVBLK)
#define MASKT(P0_, P1_, t) do { const int kb_ = KBASE(t); if (kb_ + KVBLK - 1 > qlo) mask_tile(P0_, P1_, qm - kb_); } while (0)
    constexpr int NQL = 4;
#define SEAM_K0() do { VMWN(NQL); SWRITE_HK(0); SBAR(); } while (0)
    f32x16 pA0, pA1, pB0, pB1; float mnA, mnB, alA, alB; bf16x8 pa0, pa1, pa2, pa3;
    SWRITE_HV(0); SBAR();
    if (NT > 1) { SLOAD_H(Kh, Vh, KBASE(1)); }
    SBAR(); qkt<0>(pA0, pA1, K_lds, r32, hi, mp, S.qr);
    MASKT(pA0, pA1, 0); partialSM(pA0, pA1, m_reg, mnA, alA);
    if (NT > 1) { VMW(); SWRITE_H(1); }
    __syncthreads();
#define HALF_STEP(PX0, PX1, mnX, alX, PY0, PY1, alY, t, KB, VB, SB) do {                                                      \
        SBAR(); qkt<KB>(PX0, PX1, K_lds, r32, hi, mp, S.qr);                                                                   \
        finishSM(PY0, PY1, alY, l_reg, pa0, pa1, pa2, pa3); SBAR();                                                           \
        if ((t) + 1 < NT) { SLOAD_H(Kh, Vh, KBASE((t) + 1)); SBAR(); }                                                        \
        pv_tile<VB>(o, vb0, pa0, pa1, pa2, pa3); MASKT(PX0, PX1, (t)); partialSM(PX0, PX1, m_reg, mnX, alX);                  \
        __syncthreads();                                                                                                      \
        if ((t) + 1 < NT) { VMW(); SWRITE_H(SB); }                                                                            \
        RESC(alX); __syncthreads(); } while (0)
    for (int t = 1; t + 1 < NT; t += 2) {
        HALF_STEP(pB0, pB1, mnB, alB, pA0, pA1, alA, t, 1, 0, 0);
        HALF_STEP(pA0, pA1, mnA, alA, pB0, pB1, alB, t + 1, 0, 1, 1);
    }
    const bool even = (NT & 1) == 0;
    if (even) { SBAR(); qkt<1>(pB0, pB1, K_lds, r32, hi, mp, S.qr); SBAR(); }
    SLOAD_H(B.K + nxt.koff, B.V + nxt.koff, 0); SBAR();
#pragma unroll
    for (int d0 = 0; d0 < 4; ++d0) S.qr[d0] = load8(B.Q + nxt.qoff + (size_t)(wq * QBLK + r32) * LD + mp * 64 + d0 * 16 + hi * 8);
    SBAR();
    finishSM(pA0, pA1, alA, l_reg, pa0, pa1, pa2, pa3); SBAR();
    pv_tile<0>(o, vb0, pa0, pa1, pa2, pa3);
    if (even) { MASKT(pB0, pB1, NT - 1); partialSM(pB0, pB1, m_reg, mnB, alB); __syncthreads(); RESC(alB);
        finishSM(pB0, pB1, alB, l_reg, pa0, pa1, pa2, pa3); SBAR(); pv_tile<1>(o, vb0, pa0, pa1, pa2, pa3); }
    SBAR(); SEAM_K0();
    if (hi == 0) li_l[r32] = l_reg; asm volatile("s_waitcnt lgkmcnt(0)" ::: "memory");
    float* xch = (float*)(lds + LDS_XCH) + wq * 4096;
    if (mp == 1) {
#pragma unroll
        for (int r = 0; r < 16; ++r) { const int orow = crow(r, hi); const float rl = __builtin_amdgcn_rcpf(li_l[orow]);
#pragma unroll
            for (int d0 = 0; d0 < 4; ++d0) xch[orow * 128 + d0 * 32 + r32] = o[d0][r] * rl; }
    }
    __syncthreads();
    if (mp == 0) {
        float gv[4];
#pragma unroll
        for (int d0 = 0; d0 < 4; ++d0) gv[d0] = subln_g[d0 * 32 + r32] * (1.f - LAMBDA_INIT);
        int obase = cur.ooff + (wq * QBLK + 4 * hi) * LDO + r32; asm volatile("" : "+v"(obase));
#pragma unroll
        for (int r = 0; r < 16; ++r) { const int orow = crow(r, hi), crel = (r & 3) + 8 * (r >> 2); float d[4]; float ss = 0.f; const float rl = __builtin_amdgcn_rcpf(li_l[orow]);
#pragma unroll
            for (int d0 = 0; d0 < 4; ++d0) { d[d0] = o[d0][r] * rl - lam * xch[orow * 128 + d0 * 32 + r32]; ss += d[d0] * d[d0]; }
            ss += __shfl_xor(ss, 1); ss += __shfl_xor(ss, 2); ss += __shfl_xor(ss, 4); ss += __shfl_xor(ss, 8); ss += __shfl_xor(ss, 16);
            const float rs = rsqrtf(ss * (1.f / 128.f) + EPS);
#pragma unroll
            for (int d0 = 0; d0 < 4; ++d0) { const float v = d[d0] * rs * gv[d0]; const float vn = __shfl_xor(v, 1);
                if ((r32 & 1) == 0) __hip_atomic_store((unsigned*)(B.O + obase + crel * LDO + d0 * 32), cvtpk(v, vn), __ATOMIC_RELAXED, __HIP_MEMORY_SCOPE_AGENT); } }
    }
    __syncthreads();
#undef RESC
#undef KBASE
#undef MASKT
#undef SEAM_K0
#undef HALF_STEP
}
#undef ROW
#undef VMW
#undef VMWN
#undef SLOAD_H
#undef SWRITE_HK
#undef SWRITE_HV
#undef SWRITE_H
#undef KSWZ
#undef SBAR
}

DEV void p3_attn_conv(Frame& F, const Args& a, char* lds_generic) {
    const att::Bufs B{(const bf16_t*)(F.ws + WS_Q), (const bf16_t*)(F.ws + WS_K), (const bf16_t*)(F.ws + WS_V), (bf16_t*)(F.ws + WS_ATT)};
    float lam;
    { const float* q1 = (const float*)a.in[7]; const float* k1 = (const float*)a.in[8]; const float* q2 = (const float*)a.in[9]; const float* k2 = (const float*)a.in[10];
      const float s1 = wave_sum(q1[F.lane] * k1[F.lane]), s2 = wave_sum(q2[F.lane] * k2[F.lane]);
      lam = __uint_as_float(__builtin_amdgcn_readfirstlane(__float_as_uint(expf(s1) - expf(s2) + LAMBDA_INIT))); }
    const float* subln_g = (const float*)a.in[11];
    for (int L = F.vcu; L < 256; L += F.G) {
        const int bh = L >> 4, y = L & 15, b = bh >> 2, h = bh & 3;
        const int hb = b * SEQ * att::LD + h * 128;
        const int ob = b * SEQ * att::LDO + h * 128;
        const att::BlockRef b0{hb + y * att::QB * att::LD, hb, y * att::QB, ob + y * att::QB * att::LDO}, b1{hb + (att::NQB - 1 - y) * att::QB * att::LD, hb, (att::NQB - 1 - y) * att::QB, ob + (att::NQB - 1 - y) * att::QB * att::LDO};
        att::Seam S;
        att::attn_prime(B, b0, lds_generic, S);
        att::attn_block(B, b0, b1, lds_generic, S, lam, subln_g);
        att::attn_block(B, b1, b1, lds_generic, S, lam, subln_g);
    }
    const bf16_t* CB = (const bf16_t*)(F.ws + WS_CB); const bf16_t* CCU = (const bf16_t*)(F.ws + WS_CCU); bf16_t* CONV = (bf16_t*)(F.ws + WS_ATT);
    const float* cw = (const float*)a.in[12]; (void)CONV;
    const __amdgpu_buffer_rsrc_t crsrc = __builtin_amdgcn_make_buffer_rsrc((void*)(F.ws + WS_ATT), 0, 32 * 1024 * 1024, 0x00020000);
    const int gt = F.vcu * NTHR + F.tid, NGT = F.G * NTHR;
    const int chc = (gt & 63) * 8;
    float cwv[3][8];
#pragma unroll
    for (int j = 0; j < 3; ++j)
#pragma unroll
        for (int i = 0; i < 8; ++i) cwv[j][i] = cw[j * 512 + chc + i];
    for (int idx0 = gt; idx0 < M * 64; idx0 += 4 * NGT) {
        v4u cbv[4], u0[4], u1[4], u2[4];
#pragma unroll
        for (int p = 0; p < 4; ++p) { const int idx = idx0 + p * NGT; const int row = idx >> 6, t = row & (SEQ - 1);
            const size_t off = (size_t)row * 512 + chc;
            cbv[p] = __builtin_nontemporal_load((const v4u*)(CB + off)); u0[p] = *(const v4u*)(CCU + off);
            u1[p] = (v4u){0u, 0u, 0u, 0u}; u2[p] = (v4u){0u, 0u, 0u, 0u};
            if (t >= 1) u1[p] = *(const v4u*)(CCU + off - 512);
            if (t >= 2) u2[p] = *(const v4u*)(CCU + off - 1024); }
#pragma unroll
        for (int p = 0; p < 4; ++p) { const int idx = idx0 + p * NGT; const int row = idx >> 6;
            v4u o;
#pragma unroll
            for (int i = 0; i < 4; ++i) {
                const float y0 = cwv[0][2 * i] * __uint_as_float(u0[p][i] << 16) + cwv[1][2 * i] * __uint_as_float(u1[p][i] << 16) + cwv[2][2 * i] * __uint_as_float(u2[p][i] << 16);
                const float y1 = cwv[0][2 * i + 1] * __uint_as_float(u0[p][i] & 0xffff0000u) + cwv[1][2 * i + 1] * __uint_as_float(u1[p][i] & 0xffff0000u) + cwv[2][2 * i + 1] * __uint_as_float(u2[p][i] & 0xffff0000u);
                o[i] = pk2(__uint_as_float(cbv[p][i] << 16) * y0, __uint_as_float(cbv[p][i] & 0xffff0000u) * y1);
            }
            __builtin_amdgcn_raw_buffer_store_b128(o, crsrc, (row * 1024 + 512 + chc) * 2, 0, 16  ); }
    }
}

constexpr size_t WS_X1B = 72 * MiB;
constexpr size_t WS_ELT = 250 * MiB;
constexpr size_t WS_ELW = 252 * MiB;
constexpr size_t WS_TOKP = 254 * MiB;
constexpr size_t WS_ACT = 104 * MiB;
constexpr size_t WS_Y = 168 * MiB;
constexpr int CW_CNT = 32768;
constexpr int CW_DONE = 40960;
constexpr int CW_PC4 = 50176, CW_PC5 = 51200;
constexpr int CW_WDC = 49152;
constexpr int LDS_TAB = 131072;

DEV void p6_route(Frame& F, const Args& a, const bool wait5) {
    typedef float f32x4v __attribute__((ext_vector_type(4)));
    const bf16_t* X1 = (const bf16_t*)(F.ws + WS_X1B); const float* SSQ = (const float*)(F.ws + WS_SSQ); const float* MOD = (const float*)(F.ws + WS_MOD);
    const float* gN = (const float*)a.in[16]; const float* bg = (const float*)a.in[18]; const float* be = (const float*)a.in[20];
    const bf16_t* RH = (const bf16_t*)(F.ws + WS_WT_R); const bf16_t* RL = RH + 48 * DM;
    const __amdgpu_buffer_rsrc_t hrsrc = __builtin_amdgcn_make_buffer_rsrc((void*)(F.ws + WS_H2), 0, 32 * 1024 * 1024, 0x00020000);
    int* ELT = (int*)(F.ws + WS_ELT); float* ELW = (float*)(F.ws + WS_ELW); int* TOKP = (int*)(F.ws + WS_TOKP);
    LAS float* GS = (LAS float*)F.lds; LAS float* SH = GS + DM; LAS float* PL = SH + DM;
    LAS float* LG = PL + 8 * 64 * 48;
    LAS int* lcnt = (LAS int*)(LG + 64 * 48); LAS int* gbase = lcnt + 32;
    const int r = F.lane & 15, q = F.lane >> 4, w = F.wave;
    for (int ch = F.vcu; ch < M / 64; ch += F.G) {
        const int R0 = ch * 64, b = R0 / SEQ; const float* md = MOD + b * 6144;
        for (int k = F.tid; k < DM; k += NTHR) { GS[k] = gN[k] * (1.f + md[4096 + k]); SH[k] = md[3072 + k]; }
        if (F.tid < 32) lcnt[F.tid] = 0;
        if (wait5 && F.tid == 64) {
            unsigned sp = 0; while (__hip_atomic_load(F.ctl + CW_PC5 + (ch >> 2) * 16, __ATOMIC_RELAXED, __HIP_MEMORY_SCOPE_AGENT) < (unsigned)(DM / pg8::BM)) { __builtin_amdgcn_s_sleep(2); if (++sp > (1u << 22)) break; }
            __builtin_amdgcn_fence(__ATOMIC_ACQUIRE, "agent"); asm volatile("s_waitcnt vmcnt(0)" ::: "memory"); }
        __syncthreads();
        v4u xqa[4][4];
#pragma unroll
        for (int s = 0; s < 4; ++s)
#pragma unroll
            for (int rg = 0; rg < 4; ++rg) xqa[s][rg] = *(const v4u*)(X1 + (size_t)(R0 + rg * 16 + r) * DM + w * 128 + s * 32 + 8 * q);
        float rstd[4];
#pragma unroll
        for (int rg = 0; rg < 4; ++rg) { const f32x4v* sp = (const f32x4v*)(SSQ + (size_t)(R0 + rg * 16 + r) * 16); const f32x4v s0 = sp[0], s1 = sp[1], s2 = sp[2], s3 = sp[3];
            const float ss = ((s0[0] + s0[1]) + (s0[2] + s0[3])) + ((s1[0] + s1[1]) + (s1[2] + s1[3])) + ((s2[0] + s2[1]) + (s2[2] + s2[3])) + ((s3[0] + s3[1]) + (s3[2] + s3[3]));
            rstd[rg] = rsqrtf(ss * (1.f / DM) + EPS); }
        __builtin_amdgcn_sched_barrier(0);
        pg8::f32x4 acc[4][3];
#pragma unroll
        for (int rg = 0; rg < 4; ++rg)
#pragma unroll
            for (int n = 0; n < 3; ++n) acc[rg][n] = (pg8::f32x4){0.f, 0.f, 0.f, 0.f};
        bf16x8 bhq[2][3], blq[2][3];
#pragma unroll
        for (int n = 0; n < 3; ++n) { bhq[0][n] = *(const bf16x8*)(RH + (size_t)(n * 16 + r) * DM + w * 128 + 8 * q); blq[0][n] = *(const bf16x8*)(RL + (size_t)(n * 16 + r) * DM + w * 128 + 8 * q); }
#pragma unroll
        for (int s = 0; s < 4; ++s) {
            const int k0 = w * 128 + s * 32 + 8 * q;
            if (s + 1 < 4) {
#pragma unroll
                for (int n = 0; n < 3; ++n) { bhq[(s + 1) & 1][n] = *(const bf16x8*)(RH + (size_t)(n * 16 + r) * DM + k0 + 32); blq[(s + 1) & 1][n] = *(const bf16x8*)(RL + (size_t)(n * 16 + r) * DM + k0 + 32); }
            }
            __builtin_amdgcn_sched_barrier(0);
            bf16x8 bh[3], bl[3];
#pragma unroll
            for (int n = 0; n < 3; ++n) { bh[n] = bhq[s & 1][n]; bl[n] = blq[s & 1][n]; }
            v4u xq[4];
#pragma unroll
            for (int rg = 0; rg < 4; ++rg) xq[rg] = xqa[s][rg];
            const f32x4v ga = *(const LAS f32x4v*)(GS + k0), gb = *(const LAS f32x4v*)(GS + k0 + 4), sa = *(const LAS f32x4v*)(SH + k0), sb = *(const LAS f32x4v*)(SH + k0 + 4);
#pragma unroll
            for (int rg = 0; rg < 4; ++rg) {
                const v4u xr_ = xq[rg];
                const f32x4v xa = {__uint_as_float(xr_.x << 16), __uint_as_float(xr_.x & 0xffff0000u), __uint_as_float(xr_.y << 16), __uint_as_float(xr_.y & 0xffff0000u)}, xb = {__uint_as_float(xr_.z << 16), __uint_as_float(xr_.z & 0xffff0000u), __uint_as_float(xr_.w << 16), __uint_as_float(xr_.w & 0xffff0000u)};
                const f32x4v ha = xa * rstd[rg] * ga + sa, hb = xb * rstd[rg] * gb + sb;
                v4u hi, lo;
                hi.x = pg8::cvt_pk_bf16(ha[0], ha[1]); hi.y = pg8::cvt_pk_bf16(ha[2], ha[3]); hi.z = pg8::cvt_pk_bf16(hb[0], hb[1]); hi.w = pg8::cvt_pk_bf16(hb[2], hb[3]);
                lo.x = pg8::cvt_pk_bf16(ha[0] - __uint_as_float(hi.x << 16), ha[1] - __uint_as_float(hi.x & 0xffff0000u)); lo.y = pg8::cvt_pk_bf16(ha[2] - __uint_as_float(hi.y << 16), ha[3] - __uint_as_float(hi.y & 0xffff0000u));
                lo.z = pg8::cvt_pk_bf16(hb[0] - __uint_as_float(hi.z << 16), hb[1] - __uint_as_float(hi.z & 0xffff0000u)); lo.w = pg8::cvt_pk_bf16(hb[2] - __uint_as_float(hi.w << 16), hb[3] - __uint_as_float(hi.w & 0xffff0000u));
                __builtin_amdgcn_raw_buffer_store_b128(hi, hrsrc, ((R0 + rg * 16 + r) * DM + k0) * 2, 0, 16  );
                const bf16x8 ahi = __builtin_bit_cast(bf16x8, hi), alo = __builtin_bit_cast(bf16x8, lo);
#pragma unroll
                for (int n = 0; n < 3; ++n) {
                    acc[rg][n] = __builtin_amdgcn_mfma_f32_16x16x32_bf16(ahi, bh[n], acc[rg][n], 0, 0, 0);
                    acc[rg][n] = __builtin_amdgcn_mfma_f32_16x16x32_bf16(ahi, bl[n], acc[rg][n], 0, 0, 0);
                    acc[rg][n] = __builtin_amdgcn_mfma_f32_16x16x32_bf16(alo, bh[n], acc[rg][n], 0, 0, 0);
                }
            }
        }
#pragma unroll
        for (int rg = 0; rg < 4; ++rg)
#pragma unroll
            for (int n = 0; n < 3; ++n)
#pragma unroll
                for (int j = 0; j < 4; ++j) PL[(w * 64 + rg * 16 + 4 * q + j) * 48 + n * 16 + r] = acc[rg][n][j];
        __syncthreads();
        int rt_ = threadIdx.x; asm volatile("" : "+v"(rt_));
        for (int i = rt_; i < 64 * 48; i += NTHR) { float sacc = 0.f;
#pragma unroll
            for (int ww = 0; ww < 8; ++ww) sacc += PL[ww * 64 * 48 + i];
            LG[i] = sacc; }
        __syncthreads();
        int e0 = 0, e1 = 0, p0 = 0, p1 = 0; float w0 = 0.f, w1 = 0.f;
        if (rt_ < 64) {
            const LAS float* l0 = LG + (size_t)rt_ * 48;
            int gi = 0; float gmax = l0[0] + bg[0];
            for (int i = 1; i < 4; ++i) { const float v = l0[i] + bg[i]; if (v > gmax) { gmax = v; gi = i; } }
            float se = 0.f; for (int i = 0; i < 4; ++i) se += expf(l0[i] + bg[i] - gmax);
            const float gw = 1.f / se;
            int i0 = 0; float m0 = -1e30f; int i1 = 0; float m1 = -1e30f;
            for (int i = 0; i < 8; ++i) { const float v = l0[4 + gi * 8 + i] + be[gi * 8 + i];
                if (v > m0) { m1 = m0; i1 = i0; m0 = v; i0 = i; } else if (v > m1) { m1 = v; i1 = i; } }
            const float ex = expf(m1 - m0); w0 = gw / (1.f + ex); w1 = gw * ex / (1.f + ex);
            e0 = gi * 8 + i0; e1 = gi * 8 + i1;
            p0 = atomicAdd((int*)(lcnt + e0), 1); p1 = atomicAdd((int*)(lcnt + e1), 1);
        }
        __syncthreads();
        if (rt_ < 32) { const int c = lcnt[rt_]; gbase[rt_] = c ? (int)atomicAdd(F.ctl + CW_CNT + rt_ * 64, (unsigned)c) : 0; }
        __syncthreads();
        if (rt_ < 64) { const int tok = R0 + rt_; const int g0 = gbase[e0] + p0, g1 = gbase[e1] + p1;
            __hip_atomic_store(ELT + e0 * M + g0, tok, __ATOMIC_RELAXED, __HIP_MEMORY_SCOPE_AGENT); __hip_atomic_store(ELW + e0 * M + g0, w0, __ATOMIC_RELAXED, __HIP_MEMORY_SCOPE_AGENT);
            __hip_atomic_store(ELT + e1 * M + g1, tok, __ATOMIC_RELAXED, __HIP_MEMORY_SCOPE_AGENT); __hip_atomic_store(ELW + e1 * M + g1, w1, __ATOMIC_RELAXED, __HIP_MEMORY_SCOPE_AGENT);
            __hip_atomic_store((unsigned long long*)(TOKP + tok * 2), (unsigned long long)(unsigned)(e0 * M + g0) | ((unsigned long long)(unsigned)(e1 * M + g1) << 32), __ATOMIC_RELAXED, __HIP_MEMORY_SCOPE_AGENT); }
        __syncthreads();
    }
}
DEV pg8::MoeTiles moe_build_tiles(Frame& F) {
    pg8::MoeTiles mt; mt.te = (LAS int*)(F.lds + LDS_TAB); mt.tm = mt.te + 192; mt.tv = mt.tm + 192; LAS int* Tp = mt.tv + 192; LAS int* BASE = Tp + 4;
    LAS int* cntl = BASE + 32;
    if (F.tid < NE) cntl[F.tid] = (int)__hip_atomic_load(F.ctl + CW_CNT + F.tid * 64, __ATOMIC_RELAXED, __HIP_MEMORY_SCOPE_AGENT);
    __syncthreads();
    if (F.tid == 0) { int T = 0;
        for (int e = 0; e < NE; ++e) { const int c = cntl[e]; BASE[e] = T * 256;
            for (int m = 0; m * 256 < c; ++m) { mt.te[T] = e; mt.tm[T] = m; mt.tv[T] = (c - m * 256) < 256 ? (c - m * 256) : 256; ++T; } }
        Tp[0] = T; }
    __syncthreads();
    mt.T = Tp[0];
    return mt;
}
DEV pg8::MoeTiles moe_tiles_view(Frame& F) {
    pg8::MoeTiles mt; mt.te = (LAS int*)(F.lds + LDS_TAB); mt.tm = mt.te + 192; mt.tv = mt.tm + 192; mt.T = (mt.tv + 192)[0]; return mt;
}
DEV void p9_final(Frame& F, const Args& a) {
    const LAS int* BASE = (const LAS int*)(F.lds + LDS_TAB) + 3 * 192 + 4;
    const float* MOD = (const float*)(F.ws + WS_MOD); const float* fg = (const float*)a.in[24]; const int* TOKP = (const int*)(F.ws + WS_TOKP); const bf16_t* Y = (const bf16_t*)(F.ws + WS_Y); const bf16_t* X1 = (const bf16_t*)(F.ws + WS_X1B);
    const int gw = F.vcu * NWAVES + F.wave, NGW = F.G * NWAVES;
    f32x4 fgv[4];
#pragma unroll
    for (int j = 0; j < 4; ++j) fgv[j] = *(const f32x4*)(fg + 4 * F.lane + 256 * j);
    for (int mb = gw; mb < M; mb += 32 * NGW) {
    int slotv = 0;
    { const int row = mb + (F.lane >> 1) * NGW; if (row < M) { const int t = TOKP[row * 2 + (F.lane & 1)]; slotv = BASE[t / M] + (t % M); } }
    for (int m0 = mb, itl = 0; m0 < M && itl < 16; m0 += 2 * NGW, ++itl) {
        int mm[2] = {m0, m0 + NGW}; int sl[2][2];
#pragma unroll
        for (int p = 0; p < 2; ++p) { sl[p][0] = __shfl(slotv, itl * 4 + p * 2); sl[p][1] = __shfl(slotv, itl * 4 + p * 2 + 1); }
        unsigned long long xq[2][4], ya[2][4], yb[2][4];
#pragma unroll
        for (int p = 0; p < 2; ++p) {
            const GAS unsigned long long* xr = (const GAS unsigned long long*)(X1 + (size_t)mm[p] * DM) + F.lane;
            const GAS unsigned long long* y0 = (const GAS unsigned long long*)(Y + (size_t)sl[p][0] * DM) + F.lane; const GAS unsigned long long* y1 = (const GAS unsigned long long*)(Y + (size_t)sl[p][1] * DM) + F.lane;
#pragma unroll
            for (int j = 0; j < 4; ++j) { xq[p][j] = __builtin_nontemporal_load(xr + 64 * j); ya[p][j] = __builtin_nontemporal_load(y0 + 64 * j); yb[p][j] = __builtin_nontemporal_load(y1 + 64 * j); }
        }
#pragma unroll
        for (int p = 0; p < 2; ++p) {
            const float* gf = MOD + (mm[p] / SEQ) * 6144 + 5120; float s = 0.f; f32x4 v[4];
#pragma unroll
            for (int j = 0; j < 4; ++j) { const int k = 4 * F.lane + 256 * j; const unsigned long long a0 = ya[p][j], a1 = yb[p][j]; const f32x4 g4 = *(const f32x4*)(gf + k);
                f32x4 yy; yy.x = __uint_as_float((unsigned)a0 << 16) + __uint_as_float((unsigned)a1 << 16); yy.y = __uint_as_float((unsigned)a0 & 0xffff0000u) + __uint_as_float((unsigned)a1 & 0xffff0000u);
                yy.z = __uint_as_float((unsigned)(a0 >> 32) << 16) + __uint_as_float((unsigned)(a1 >> 32) << 16); yy.w = __uint_as_float((unsigned)(a0 >> 32) & 0xffff0000u) + __uint_as_float((unsigned)(a1 >> 32) & 0xffff0000u);
                const unsigned long long xx = xq[p][j]; f32x4 x4; x4.x = __uint_as_float((unsigned)xx << 16); x4.y = __uint_as_float((unsigned)xx & 0xffff0000u); x4.z = __uint_as_float((unsigned)(xx >> 32) << 16); x4.w = __uint_as_float((unsigned)(xx >> 32) & 0xffff0000u);
                v[j] = x4 + g4 * yy; s += (v[j].x * v[j].x + v[j].y * v[j].y) + (v[j].z * v[j].z + v[j].w * v[j].w); }
            const float rstd = rsqrtf(wave_sum(s) * (1.f / DM) + EPS);
            GAS f32x4* xw = (GAS f32x4*)(F.out + (size_t)mm[p] * DM) + F.lane;
#pragma unroll
            for (int j = 0; j < 4; ++j) __builtin_nontemporal_store(v[j] * rstd * fgv[j], xw + 64 * j);
        }
    }
    }
}

__global__ void __launch_bounds__(NTHR, 2) mk(Args args) {
    __shared__ __attribute__((aligned(16))) unsigned char lds_raw[LDS_BYTES];
    Frame F;
    F.lds = (LAS unsigned char*)lds_raw; F.MISC = (volatile LAS unsigned*)(F.lds + MISC_OFF);
    F.tid = threadIdx.x; F.lane = F.tid & 63; F.wave = __builtin_amdgcn_readfirstlane(F.tid >> 6);
    F.G = gridDim.x; { const int bx = blockIdx.x; F.vcu = (F.G % 8 == 0) ? (bx % 8) * (F.G / 8) + bx / 8 : bx; }
    F.ws = args.ws; F.out = args.out; F.ctl = (unsigned*)(args.ws + WS_CTL);
    for (int u = F.tid; u < (LDS_BYTES - LDSCTL_OFF) / 4; u += NTHR) ((LAS unsigned*)(F.lds + LDSCTL_OFF))[u] = 0u;
    __syncthreads();
    XcdBarrier bar = xcd_barrier_post(F.ctl + CW_BAR + args.li * XCD_BAR_WORDS, F.MISC + 8);
    const int lo = args.ph_lo, hi = args.ph_hi;
#define REFRESH() do { int t_ = threadIdx.x; asm volatile("" : "+v"(t_)); F.tid = t_; F.lane = t_ & 63; F.wave = __builtin_amdgcn_readfirstlane(t_ >> 6); } while (0)
#define IN(k) (lo <= (k) && (k) < hi)
#define BOTH(k) (IN(k) && IN((k) + 1))
    if (IN(0)) { REFRESH(); p0_prologue(F, args); }
    if (IN(1)) { REFRESH(); p1_h(F, args); }
    if (IN(2)) { REFRESH();
        pg8::Gemm g{(const bf16_t*)(F.ws + WS_H), (const bf16_t*)(F.ws + WS_WT_IN), M, INW, DM}; pg8::StaticOrder S; S.init(M, INW, F.G, (int)blockIdx.x);
        pg8::EpiIn E{(bf16_t*)(F.ws + WS_Q), (bf16_t*)(F.ws + WS_K), (bf16_t*)(F.ws + WS_V), (bf16_t*)(F.ws + WS_CB), (bf16_t*)(F.ws + WS_CCU), (bf16_t*)(F.ws + WS_GA), (bf16_t*)(F.ws + WS_GC), (const float*)(F.ws + WS_ROPE), __builtin_amdgcn_make_buffer_rsrc((void*)(F.ws + WS_Q), 0, 144 * 1024 * 1024, 0x00020000)};
        if (IN(1)) {
            if (F.wave == 0) {
                const unsigned* pa = F.ctl + CW_P0C; unsigned need = (unsigned)F.G; bool act = F.lane == 0;
                if (F.lane >= 1 && F.lane < 32) { pg8::Unit u; if (S.next(F.lane - 1, u)) { pa = F.ctl + CW_PC1 + u.pm * 16; need = 4u; act = true; } }
                unsigned sp = 0;
                for (;;) { const unsigned v = act ? __hip_atomic_load(pa, __ATOMIC_RELAXED, __HIP_MEMORY_SCOPE_AGENT) : need; if (__all(v >= need)) break; __builtin_amdgcn_s_sleep(2); if (++sp > (1u << 22)) break; } }
            __syncthreads(); }
        pg8::gemm_phase<pg8::EpiIn, pg8::StaticOrder, true, true>(F.lds, g, S, E);
        if (BOTH(2)) xcd_barrier(bar);
    }
    if (IN(3)) { REFRESH(); p3_attn_conv(F, args, (char*)lds_raw); if (BOTH(3)) xcd_barrier(bar); }
    if (IN(4)) { REFRESH();
        pg8::StaticOrder S; S.init(M, DM, F.G, (int)blockIdx.x);
        pg8::Gemm g{(const bf16_t*)(F.ws + WS_ATT), (const bf16_t*)(F.ws + WS_WT_A), M, DM, DM};
        pg8::EpiG E{(const bf16_t*)(F.ws + WS_GA), (const bf16_t*)(F.ws + WS_GC), (bf16_t*)(F.ws + WS_MERGED), __builtin_amdgcn_make_buffer_rsrc((void*)(F.ws + WS_MERGED), 0, M * DM * 2, 0x00020000)};
        pg8::gemm_phase<pg8::EpiG, pg8::StaticOrder, false, true>(F.lds, g, S, E);
        if (BOTH(4) && F.tid == 0) { pg8::Unit u; if (S.next(0, u)) __hip_atomic_fetch_add(F.ctl + CW_PC4 + u.pm * 16, 1u, __ATOMIC_RELAXED, __HIP_MEMORY_SCOPE_AGENT); }
    }
    if (IN(5)) { REFRESH();
        pg8::StaticOrder S; S.init(M, DM, F.G, (int)blockIdx.x);
        pg8::Gemm g{(const bf16_t*)(F.ws + WS_MERGED), (const bf16_t*)(F.ws + WS_WT_O), M, DM, DM};
        pg8::EpiX1 E{(const float*)args.in[0], (const float*)(F.ws + WS_MOD) + 2048, (bf16_t*)(F.ws + WS_X1B), (float*)(F.ws + WS_SSQ), __builtin_amdgcn_make_buffer_rsrc((void*)(F.ws + WS_X1B), 0, M * DM * 2, 0x00020000)};
        if (IN(4)) {
            if (F.tid == 0) { pg8::Unit u; if (S.next(0, u)) { unsigned sp = 0; while (__hip_atomic_load(F.ctl + CW_PC4 + u.pm * 16, __ATOMIC_RELAXED, __HIP_MEMORY_SCOPE_AGENT) < (unsigned)(DM / pg8::BM)) { __builtin_amdgcn_s_sleep(2); if (++sp > (1u << 22)) break; } } }
            __syncthreads(); }
        pg8::gemm_phase<pg8::EpiX1, pg8::StaticOrder, false, true>(F.lds, g, S, E);
        if (BOTH(5) && F.tid == 0) { pg8::Unit u; if (S.next(0, u)) __hip_atomic_fetch_add(F.ctl + CW_PC5 + u.pm * 16, 1u, __ATOMIC_RELAXED, __HIP_MEMORY_SCOPE_AGENT); }
    }
    if (IN(6)) { REFRESH(); p6_route(F, args, IN(5)); if (BOTH(6)) xcd_barrier(bar); }
    if (IN(7)) { REFRESH();
        { const pg8::MoeTiles mt = moe_build_tiles(F);
          volatile LAS unsigned* lflag = (volatile LAS unsigned*)(F.lds + LDSCTL_OFF + 512);
          if (F.tid == 0) *lflag = 0u;
          __syncthreads();
          const int nbusy = 2 * mt.T - F.G;
          const int first = nbusy > 0 ? (nbusy < F.G - 32 ? nbusy : 0) : 0;
          if (F.vcu >= first) p7_wdown_transposes(F, args, F.vcu - first, F.G - first, F.ctl + CW_WDC); }
        { REFRESH(); const pg8::MoeTiles mt = moe_tiles_view(F);
          pg8::Gemm g{(const bf16_t*)(F.ws + WS_H2), (const bf16_t*)(F.ws + WS_WT_GU), 0, 0, DM};
          pg8::SchedMoeA S{mt, (const int*)(F.ws + WS_ELT), (const float*)(F.ws + WS_ELW), F.vcu, F.G, F.ctl + CW_DONE};
          pg8::EpiAct E{(bf16_t*)(F.ws + WS_ACT), __builtin_amdgcn_make_buffer_rsrc((void*)(F.ws + WS_ACT), 0, 40960 * 256 * 2, 0x00020000)};
          pg8::gemm_phase_x<pg8::EpiAct, pg8::SchedMoeA, true, 1>(F.lds, g, S, E); }
        { REFRESH(); const pg8::MoeTiles mt = moe_tiles_view(F);
          const int nbusy = 2 * mt.T - F.G; const int first = nbusy > 0 ? (nbusy < F.G - 32 ? nbusy : 0) : 0;
          pg8::Gemm g{(const bf16_t*)(F.ws + WS_ACT), (const bf16_t*)(F.ws + WS_WT_D), 0, 0, FF};
          pg8::SchedMoeB S{mt, F.vcu, F.G, F.ctl + CW_DONE};
          pg8::EpiY E{(bf16_t*)(F.ws + WS_Y), __builtin_amdgcn_make_buffer_rsrc((void*)(F.ws + WS_Y), 0, 40960 * 1024 * 2, 0x00020000)};
          pg8::gemm_phase_x<pg8::EpiY, pg8::SchedMoeB, false, 2>(F.lds, g, S, E, (volatile LAS unsigned*)(F.lds + LDSCTL_OFF + 512), F.ctl + CW_WDC, (unsigned)(F.G - first)); }
        if (BOTH(7)) xcd_barrier(bar);
    }
    if (IN(9)) { REFRESH(); if (!IN(7)) (void)moe_build_tiles(F); p9_final(F, args); }
#undef IN
#undef BOTH
}


static int g_grid = 0;
static void mk_launch(const Args& base, int lo, int hi, int li, hipStream_t stream) {
    Args a = base; a.ph_lo = lo; a.ph_hi = hi; a.li = li; a.pad = 0;
    hipLaunchKernelGGL(mk, dim3(g_grid), dim3(NTHR), 0, stream, a);
}

extern "C" void kernel_launch(void* const* d_in, const int* in_sizes, int n_in, void* d_out, int out_size, void* d_ws, size_t ws_size, hipStream_t stream) {
    (void)in_sizes; (void)n_in; (void)out_size; (void)ws_size;
    if (g_grid == 0) {
        int dev = 0, cus = 0; (void)hipGetDevice(&dev); (void)hipDeviceGetAttribute(&cus, hipDeviceAttributeMultiprocessorCount, dev);
        g_grid = cus > 0 ? cus : 256;
    }
    (void)hipMemsetAsync((char*)d_ws + WS_CTL, 0, CTL_ZERO_BYTES, stream);
    Args base{}; for (int i = 0; i < 25; ++i) base.in[i] = d_in[i]; base.out = (float*)d_out; base.ws = (unsigned char*)d_ws;
    mk_launch(base, 0, 10, 0, stream);
}
```

```cpp
#include <hip/hip_runtime.h>
#include <stdint.h>

typedef unsigned short bf16_t;
#define DEV __device__ __forceinline__

constexpr int BATCH = 4, SEQ = 4096, DM = 1024, M = BATCH * SEQ;
constexpr int NH = 4, HD = 64, VD = 128, QKW = 512, VW = 512, CW = 512, INW = 5120;
constexpr int NG = 4, EPG = 8, NE = 32, FF = 256;
constexpr float EPS = 1e-6f;
constexpr float LAMBDA_INIT = 0.2f;

constexpr size_t MiB = 1u << 20;
constexpr size_t WS_CTL = 0;
constexpr size_t WS_MOD = 1 * MiB;
constexpr size_t WS_LAM = 1 * MiB + 128 * 1024;
constexpr size_t WS_ROPE = 2 * MiB;
constexpr size_t WS_TOKE = 6 * MiB;
constexpr size_t WS_TOKW = 6 * MiB + 256 * 1024;
constexpr size_t WS_WEIGHTS = 8 * MiB;
constexpr size_t WS_H = 72 * MiB;
constexpr size_t WS_ATT = 72 * MiB, WS_CONV = 88 * MiB;
constexpr size_t WS_Q = 104 * MiB, WS_K = 120 * MiB, WS_V = 136 * MiB, WS_CB = 152 * MiB, WS_CCU = 168 * MiB;
constexpr size_t WS_GA = 184 * MiB, WS_GC = 216 * MiB;
constexpr size_t WS_MERGED = 104 * MiB;
constexpr size_t WS_H2 = 136 * MiB;
constexpr size_t WS_SSQ = 248 * MiB;

DEV float bf2f(bf16_t v) { return __uint_as_float(((unsigned)v) << 16); }
DEV bf16_t f2bf(float f) { unsigned u = __float_as_uint(f); u += 0x7fffu + ((u >> 16) & 1u); return (bf16_t)(u >> 16); }

#define GAS __attribute__((address_space(1)))
#define LAS __attribute__((address_space(3)))
typedef unsigned v4u __attribute__((ext_vector_type(4)));
typedef float f32x4 __attribute__((ext_vector_type(4)));
typedef short bf16x8 __attribute__((ext_vector_type(8)));
#define LDS_WAIT() asm volatile("s_waitcnt lgkmcnt(0)" ::: "memory")
#define VM_WAIT() asm volatile("s_waitcnt vmcnt(0)" ::: "memory")
typedef float f32x2p_t __attribute__((ext_vector_type(2))); typedef __bf16 bf16x2p_t __attribute__((ext_vector_type(2)));
DEV unsigned pk2(float lo, float hi) { f32x2p_t v = {lo, hi}; bf16x2p_t b = __builtin_convertvector(v, bf16x2p_t); return __builtin_bit_cast(unsigned, b); }

constexpr int NWAVES = 8, NTHR = 512;
constexpr int RING_BYTES = 131072;
constexpr int LDSCTL_OFF = 139264, MISC_OFF = LDSCTL_OFF + 320;
constexpr int LDS_BYTES = 147456;
constexpr size_t CTL_ZERO_BYTES = 1 * MiB;
constexpr int CW_P0C = 24640, CW_PC1 = 25600;
constexpr int CW_MODC = 24576;
constexpr int CW_BAR = 4096;
constexpr size_t WS_WT_IN = WS_WEIGHTS;
constexpr size_t WS_WT_A = WS_WEIGHTS + 10 * MiB;
constexpr size_t WS_WT_C = WS_WEIGHTS + 11 * MiB;
constexpr size_t WS_WT_O = WS_WEIGHTS + 12 * MiB;
constexpr size_t WS_WT_GU = WS_WEIGHTS + 14 * MiB;
constexpr size_t WS_WT_D = WS_WEIGHTS + 46 * MiB;
constexpr size_t WS_WT_R = WS_WEIGHTS + 62 * MiB;

#define XB_TMO      128
#define XB_XCNT(j)  (256  + 64 * (j))
#define XB_XSUB(j)  (1280 + 64 * (j))
#define XB_XGEN(j)  (2304 + 64 * (j))
#define XB_TOP      3328
#define XB_TOPGEN   3392
#define XCD_BAR_WORDS 3456
#define XB_SPIN_CAP (1u << 18)
DEV unsigned xb_ld(unsigned* p)              { return __hip_atomic_load(p, __ATOMIC_RELAXED, __HIP_MEMORY_SCOPE_AGENT); }
DEV unsigned xb_add(unsigned* p, unsigned v) { return __hip_atomic_fetch_add(p, v, __ATOMIC_RELAXED, __HIP_MEMORY_SCOPE_AGENT); }
DEV unsigned xb_xcc_id() { return (unsigned)__builtin_amdgcn_s_getreg((3 << 11) | 20) & 0xFu; }
#define XB_SPIN(cond, bar) do { unsigned _sp = 0; while (cond) { __builtin_amdgcn_s_sleep(1); \
    if ((++_sp & 255u) == 0u) { if (xb_ld(&(bar)[XB_TMO])) break; if (_sp > XB_SPIN_CAP) { atomicAdd(&(bar)[XB_TMO], 1u); break; } } } } while (0)
struct XcdBarrier { unsigned* bar; unsigned x; volatile LAS unsigned* st; };
DEV XcdBarrier xcd_barrier_post(unsigned* bar, volatile LAS unsigned* st) {
    XcdBarrier b; b.bar = bar; b.x = xb_xcc_id(); b.st = st;
    if (threadIdx.x == 0) (void)xb_add(&bar[XB_XCNT(b.x)], 1u);
    return b;
}
DEV void xcd_barrier_complete(unsigned* bar, unsigned x, unsigned& nloc, unsigned& nx) {
    const unsigned G = gridDim.x * gridDim.y * gridDim.z;
    unsigned sum, cnt, mine, sp = 0u;
    for (;;) {
        sum = 0u; cnt = 0u; mine = 0u;
#pragma unroll
        for (unsigned j = 0; j < 16; ++j) { const unsigned c = xb_ld(&bar[XB_XCNT(j)]); sum += c; cnt += (c > 0u) ? 1u : 0u; mine = (j == x) ? c : mine; }
        if (sum == G) break;
        __builtin_amdgcn_s_sleep(1);
        if ((++sp & 255u) == 0u) { if (xb_ld(&bar[XB_TMO])) break; if (sp > XB_SPIN_CAP) { atomicAdd(&bar[XB_TMO], 1u); break; } }
    }
    nloc = mine > 0u ? mine : 1u; nx = cnt > 0u ? cnt : 1u;
}
DEV void xcd_barrier(const XcdBarrier& b) {
    asm volatile("s_waitcnt vmcnt(0)" ::: "memory");
    __syncthreads();
    if (threadIdx.x == 0) {
        unsigned* bar = b.bar;
        __builtin_amdgcn_s_waitcnt(0);
        unsigned nloc = b.st[0], nx = b.st[1];
        if (nloc == 0u) { xcd_barrier_complete(bar, b.x, nloc, nx); b.st[0] = nloc; b.st[1] = nx; }
        const unsigned old = xb_add(&bar[XB_XSUB(b.x)], 1u);
        const unsigned gen = old / nloc;
        if (old + 1u == (gen + 1u) * nloc) {
            __builtin_amdgcn_fence(__ATOMIC_RELEASE, "agent");
            asm volatile("s_waitcnt vmcnt(0)" ::: "memory");
            const unsigned og = xb_add(&bar[XB_TOP], 1u);
            const unsigned tg = og / nx;
            if (og + 1u == (tg + 1u) * nx) xb_add(&bar[XB_TOPGEN], 1u);
            else XB_SPIN(xb_ld(&bar[XB_TOPGEN]) == tg, bar);
            __builtin_amdgcn_fence(__ATOMIC_ACQUIRE, "agent");
            xb_add(&bar[XB_XGEN(b.x)], 1u);
            asm volatile("s_waitcnt vmcnt(0)" ::: "memory");
        } else {
            XB_SPIN(xb_ld(&bar[XB_XGEN(b.x)]) == gen, bar);
            __builtin_amdgcn_fence(__ATOMIC_ACQUIRE, "agent");
            asm volatile("s_waitcnt vmcnt(0)" ::: "memory");
        }
    }
    __syncthreads();
}

struct Args { const void* in[25]; float* out; unsigned char* ws; int ph_lo, ph_hi, li, pad; };
struct Frame {
    LAS unsigned char* lds; volatile LAS unsigned* MISC; unsigned* ctl;
    int tid, lane, wave, vcu, G;
    unsigned char* ws; float* out;
};
DEV float wave_sum(float v) {
#pragma unroll
    for (int o = 1; o < 64; o <<= 1) v += __shfl_xor(v, o);
    return v;
}
namespace pg8 {
#define PG8_LAS __attribute__((address_space(3)))
typedef unsigned short bf16_t;
typedef short bf16x8 __attribute__((ext_vector_type(8)));
typedef float f32x4 __attribute__((ext_vector_type(4)));
typedef unsigned u32x4 __attribute__((ext_vector_type(4)));
constexpr int BM = 256, BK = 64, HALF = 128, HTB = HALF * BK * 2  , STAGE_BYTES = 8 * HTB, NXCD = 8, WGM = 8;

__host__ __device__ __forceinline__ int lds_byte(int r, int c) { const int st = (r >> 4) * 2 + (c >> 5), rr = r & 15, cc = c & 31, ob = rr * 64 + cc * 2; return st * 1024 + (ob ^ (((ob >> 9) & 1) << 5)); }
__host__ __device__ __forceinline__ void stage_rc(int b, int& R, int& C) { const int st = b / 1024, sb = b % 1024, swz = sb ^ (((sb >> 9) & 1) << 5); R = (st >> 1) * 16 + swz / 64; C = (st & 1) * 32 + (swz % 64) / 2; }
__host__ __device__ __forceinline__ int perm32(int rho) { const int n = rho >> 4, i = rho & 15; return 8 * (i >> 2) + 4 * n + (i & 3); }

struct Unit { int pm, pn; };
struct Gemm { const bf16_t* A; const bf16_t* Bt; int M, N, K; };

struct StaticOrder {
    int nM, nN, nwg, G, c;
    __host__ __device__ void init(int M, int N, int G_, int c_) { nM = M / BM; nN = N / BM; nwg = nM * nN; G = G_; c = c_; }
    __host__ __device__ bool next(int i, Unit& u) const {
        const long L = (long)i * G + c; if (L >= nwg) return false;
        int wgid = (int)L; { const int q = nwg / NXCD, r = nwg % NXCD, xcd = wgid % NXCD, off = wgid / NXCD; wgid = (xcd < r ? xcd * (q + 1) : r * (q + 1) + (xcd - r) * q) + off; }
        const int nig = WGM * nN, gid = wgid / nig, fm = gid * WGM, gsz = (nM - fm) < WGM ? (nM - fm) : WGM;
        u.pm = fm + ((wgid % nig) % gsz); u.pn = (wgid % nig) / gsz; return true;
    }
    __device__ __forceinline__ void a_ready(const Unit&) const {}
    __device__ __forceinline__ void done(const Unit&) const {}
};

typedef float f32x2c_t __attribute__((ext_vector_type(2))); typedef __bf16 bf16x2c_t __attribute__((ext_vector_type(2)));
__device__ __forceinline__ unsigned cvt_pk_bf16(float lo, float hi) { f32x2c_t v = {lo, hi}; bf16x2c_t b = __builtin_convertvector(v, bf16x2c_t); return __builtin_bit_cast(unsigned, b); }
typedef float f32x2 __attribute__((ext_vector_type(2)));


struct EpiIn {
    static constexpr bool PERM = true, AFTER_DRAIN = false, MID = false;
    bf16_t *Qb, *Kb, *Vb, *CB, *CCU, *GA, *GC; const float* ROPE; __amdgpu_buffer_rsrc_t orsrc;
    __device__ __forceinline__ void st(const int eoff, const u32x4 w) const { __builtin_amdgcn_raw_buffer_store_b128(w, orsrc, eoff * 2, 0, 16); }
    __device__ __forceinline__ void operator()(const f32x4 (&acc)[2][2][4][2], const Unit& u, int wr, int wc, int fr, int fq) const {
        const int pn = u.pn, row0 = u.pm * BM + wr * 64 + fr;
        if (pn < 4) {
            const int dst = pn < 2 ? 0 : (8 << 20); const int c0 = ((pn & 1) * 4 + wc) * 64 + 8 * fq;
#pragma unroll
            for (int ai = 0; ai < 2; ++ai) {
                f32x4 cs[4][4];
#pragma unroll
                for (int m = 0; m < 4; ++m) { const f32x4* rp = (const f32x4*)(ROPE + ((size_t)(row0 + ai * HALF + m * 16) * 32 + 8 * fq) * 2);
#pragma unroll
                    for (int q = 0; q < 4; ++q) cs[m][q] = rp[q]; }
#pragma unroll
                for (int m = 0; m < 4; ++m) { const int row = row0 + ai * HALF + m * 16;
                    const f32x4 cs0 = cs[m][0], cs1 = cs[m][1], cs2 = cs[m][2], cs3 = cs[m][3];
                    const f32x4 xa = acc[ai][0][m][0], xb = acc[ai][0][m][1], ya = acc[ai][1][m][0], yb = acc[ai][1][m][1];
                    u32x4 w1, w2;
                    w1.x = cvt_pk_bf16(xa[0] * cs0[0] - ya[0] * cs0[1], xa[1] * cs0[2] - ya[1] * cs0[3]);
                    w1.y = cvt_pk_bf16(xa[2] * cs1[0] - ya[2] * cs1[1], xa[3] * cs1[2] - ya[3] * cs1[3]);
                    w1.z = cvt_pk_bf16(xb[0] * cs2[0] - yb[0] * cs2[1], xb[1] * cs2[2] - yb[1] * cs2[3]);
                    w1.w = cvt_pk_bf16(xb[2] * cs3[0] - yb[2] * cs3[1], xb[3] * cs3[2] - yb[3] * cs3[3]);
                    w2.x = cvt_pk_bf16(ya[0] * cs0[0] + xa[0] * cs0[1], ya[1] * cs0[2] + xa[1] * cs0[3]);
                    w2.y = cvt_pk_bf16(ya[2] * cs1[0] + xa[2] * cs1[1], ya[3] * cs1[2] + xa[3] * cs1[3]);
                    w2.z = cvt_pk_bf16(yb[0] * cs2[0] + xb[0] * cs2[1], yb[1] * cs2[2] + xb[1] * cs2[3]);
                    w2.w = cvt_pk_bf16(yb[2] * cs3[0] + xb[2] * cs3[1], yb[3] * cs3[2] + xb[3] * cs3[3]);
                    st(dst + row * 512 + c0, w1); st(dst + row * 512 + c0 + 32, w2); }
            }
        } else if (pn < 8) {
            const int dst = pn < 6 ? (16 << 20) : (24 << 20); const int c0 = (pn & 1) * 256 + wc * 32 + 8 * fq;
#pragma unroll
            for (int ai = 0; ai < 2; ++ai)
#pragma unroll
                for (int m = 0; m < 4; ++m) { const int row = row0 + ai * HALF + m * 16;
#pragma unroll
                    for (int bj = 0; bj < 2; ++bj) { const f32x4 v0 = acc[ai][bj][m][0], v1 = acc[ai][bj][m][1]; u32x4 w;
                        w.x = cvt_pk_bf16(v0[0], v0[1]); w.y = cvt_pk_bf16(v0[2], v0[3]); w.z = cvt_pk_bf16(v1[0], v1[1]); w.w = cvt_pk_bf16(v1[2], v1[3]);
                        st(dst + row * 512 + c0 + bj * HALF, w); } }
        } else if (pn < 12) {
            const int c0 = (pn - 8) * 128 + wc * 32 + 8 * fq;
#pragma unroll
            for (int ai = 0; ai < 2; ++ai)
#pragma unroll
                for (int m = 0; m < 4; ++m) { const int row = row0 + ai * HALF + m * 16;
                    const f32x4 v0 = acc[ai][0][m][0] * acc[ai][1][m][0], v1 = acc[ai][0][m][1] * acc[ai][1][m][1]; u32x4 w;
                    w.x = cvt_pk_bf16(v0[0], v0[1]); w.y = cvt_pk_bf16(v0[2], v0[3]); w.z = cvt_pk_bf16(v1[0], v1[1]); w.w = cvt_pk_bf16(v1[2], v1[3]);
                    st((32 << 20) + row * 512 + c0, w); }
        } else {
            const int dst = pn < 16 ? (40 << 20) : (56 << 20); const int c0 = ((pn - 12) & 3) * 256 + wc * 32 + 8 * fq;
#pragma unroll
            for (int ai = 0; ai < 2; ++ai)
#pragma unroll
                for (int m = 0; m < 4; ++m) { const int row = row0 + ai * HALF + m * 16;
#pragma unroll
                    for (int bj = 0; bj < 2; ++bj) { f32x4 v0 = acc[ai][bj][m][0], v1 = acc[ai][bj][m][1];
#pragma unroll
                        for (int j = 0; j < 4; ++j) { v0[j] = __builtin_amdgcn_rcpf(1.f + __builtin_amdgcn_exp2f(-1.4426950408889634f * v0[j])); v1[j] = __builtin_amdgcn_rcpf(1.f + __builtin_amdgcn_exp2f(-1.4426950408889634f * v1[j])); }
                        u32x4 w; w.x = cvt_pk_bf16(v0[0], v0[1]); w.y = cvt_pk_bf16(v0[2], v0[3]); w.z = cvt_pk_bf16(v1[0], v1[1]); w.w = cvt_pk_bf16(v1[2], v1[3]);
                        st(dst + row * 1024 + c0 + bj * HALF, w); } }
        }
    }
};

struct EpiG {
    static constexpr bool PERM = true, AFTER_DRAIN = false, MID = true;
    const bf16_t* GA; const bf16_t* GC; bf16_t* O; __amdgpu_buffer_rsrc_t orsrc;
    __device__ __forceinline__ void mid(f32x4 (&acc)[2][2][4][2], const Unit& u, int wr, int wc, int fr, int fq) const {
        int base = (u.pm * BM + wr * 64 + fr) * 1024 + u.pn * BM + wc * 32 + 8 * fq; asm volatile("" : "+v"(base));
#pragma unroll
        for (int ai = 0; ai < 2; ++ai)
#pragma unroll
            for (int mh = 0; mh < 2; ++mh) {
            u32x4 ga[2][2], gc[2][2];
#pragma unroll
            for (int mm = 0; mm < 2; ++mm)
#pragma unroll
                for (int bj = 0; bj < 2; ++bj) { const int ro = base + (ai * HALF + (2 * mh + mm) * 16) * 1024 + bj * HALF; ga[mm][bj] = __builtin_nontemporal_load((const u32x4*)(GA + ro)); gc[mm][bj] = *(const u32x4*)(GC + ro); }
#pragma unroll
            for (int mm = 0; mm < 2; ++mm)
#pragma unroll
                for (int bj = 0; bj < 2; ++bj) { const u32x4 a = ga[mm][bj], c = gc[mm][bj]; const int m = 2 * mh + mm;
                    f32x4& v0 = acc[ai][bj][m][0]; f32x4& v1 = acc[ai][bj][m][1];
                    v0[0] *= __uint_as_float(a.x << 16) * __builtin_amdgcn_rcpf(__uint_as_float(c.x << 16)); v0[1] *= __uint_as_float(a.x & 0xffff0000u) * __builtin_amdgcn_rcpf(__uint_as_float(c.x & 0xffff0000u));
                    v0[2] *= __uint_as_float(a.y << 16) * __builtin_amdgcn_rcpf(__uint_as_float(c.y << 16)); v0[3] *= __uint_as_float(a.y & 0xffff0000u) * __builtin_amdgcn_rcpf(__uint_as_float(c.y & 0xffff0000u));
                    v1[0] *= __uint_as_float(a.z << 16) * __builtin_amdgcn_rcpf(__uint_as_float(c.z << 16)); v1[1] *= __uint_as_float(a.z & 0xffff0000u) * __builtin_amdgcn_rcpf(__uint_as_float(c.z & 0xffff0000u));
                    v1[2] *= __uint_as_float(a.w << 16) * __builtin_amdgcn_rcpf(__uint_as_float(c.w << 16)); v1[3] *= __uint_as_float(a.w & 0xffff0000u) * __builtin_amdgcn_rcpf(__uint_as_float(c.w & 0xffff0000u)); }
        }
    }
    __device__ __forceinline__ void operator()(const f32x4 (&acc)[2][2][4][2], const Unit& u, int wr, int wc, int fr, int fq) const {
        int base = (u.pm * BM + wr * 64 + fr) * 1024 + u.pn * BM + wc * 32 + 8 * fq; asm volatile("" : "+v"(base));
#pragma unroll
        for (int ai = 0; ai < 2; ++ai) {
            u32x4 gc[4][2];
#pragma unroll
            for (int m = 0; m < 4; ++m)
#pragma unroll
                for (int bj = 0; bj < 2; ++bj) gc[m][bj] = __builtin_nontemporal_load((const u32x4*)(GC + base + (ai * HALF + m * 16) * 1024 + bj * HALF));
#pragma unroll
            for (int m = 0; m < 4; ++m)
#pragma unroll
                for (int bj = 0; bj < 2; ++bj) { const u32x4 c = gc[m][bj]; const int ro = base + (ai * HALF + m * 16) * 1024 + bj * HALF;
                    const f32x4 v0 = acc[ai][bj][m][0], v1 = acc[ai][bj][m][1]; u32x4 w;
                    w.x = cvt_pk_bf16(v0[0] * __uint_as_float(c.x << 16), v0[1] * __uint_as_float(c.x & 0xffff0000u)); w.y = cvt_pk_bf16(v0[2] * __uint_as_float(c.y << 16), v0[3] * __uint_as_float(c.y & 0xffff0000u));
                    w.z = cvt_pk_bf16(v1[0] * __uint_as_float(c.z << 16), v1[1] * __uint_as_float(c.z & 0xffff0000u)); w.w = cvt_pk_bf16(v1[2] * __uint_as_float(c.w << 16), v1[3] * __uint_as_float(c.w & 0xffff0000u));
                    __builtin_amdgcn_raw_buffer_store_b128(w, orsrc, ro * 2, 0, 16  ); }
        }
    }
};
struct EpiX1 {
    static constexpr bool PERM = true, AFTER_DRAIN = false, MID = false;
    const float* X; const float* GM; bf16_t* X1; float* SSQ; __amdgpu_buffer_rsrc_t xrsrc;
    __device__ __forceinline__ void operator()(const f32x4 (&acc)[2][2][4][2], const Unit& u, int wr, int wc, int fr, int fq) const {
        const int row0 = u.pm * BM + wr * 64 + fr, c0 = u.pn * BM + wc * 32 + 8 * fq;
        const float* gm = GM + (u.pm >> 4) * 6144 + c0;
        f32x4 gv[2][2];
#pragma unroll
        for (int bj = 0; bj < 2; ++bj)
#pragma unroll
            for (int n = 0; n < 2; ++n) gv[bj][n] = *(const f32x4*)(gm + bj * HALF + n * 4);
#pragma unroll
        for (int ai = 0; ai < 2; ++ai)
#pragma unroll
            for (int mh = 0; mh < 2; ++mh) {
            f32x4 xv[2][2][2];
#pragma unroll
            for (int mm = 0; mm < 2; ++mm) { const size_t ro = (size_t)(row0 + ai * HALF + (2 * mh + mm) * 16) * 1024 + c0;
#pragma unroll
                for (int bj = 0; bj < 2; ++bj)
#pragma unroll
                    for (int n = 0; n < 2; ++n) xv[mm][bj][n] = __builtin_nontemporal_load((const f32x4*)(X + ro + bj * HALF + n * 4)); }
#pragma unroll
            for (int mm = 0; mm < 2; ++mm) { const int m = 2 * mh + mm; const int row = row0 + ai * HALF + m * 16; const size_t ro = (size_t)row * 1024 + c0; float ss = 0.f;
#pragma unroll
                for (int bj = 0; bj < 2; ++bj) { const f32x4 o0 = xv[mm][bj][0] + gv[bj][0] * acc[ai][bj][m][0], o1 = xv[mm][bj][1] + gv[bj][1] * acc[ai][bj][m][1];
                    ss += ((o0[0] * o0[0] + o0[1] * o0[1]) + (o0[2] * o0[2] + o0[3] * o0[3])) + ((o1[0] * o1[0] + o1[1] * o1[1]) + (o1[2] * o1[2] + o1[3] * o1[3]));
                    u32x4 w; w.x = cvt_pk_bf16(o0[0], o0[1]); w.y = cvt_pk_bf16(o0[2], o0[3]); w.z = cvt_pk_bf16(o1[0], o1[1]); w.w = cvt_pk_bf16(o1[2], o1[3]);
                    __builtin_amdgcn_raw_buffer_store_b128(w, xrsrc, (int)(ro + bj * HALF) * 2, 0, 16  ); }
                ss += __shfl_xor(ss, 16); ss += __shfl_xor(ss, 32);
                if (fq == 0) __hip_atomic_store(SSQ + (size_t)row * 16 + u.pn * 4 + wc, ss, __ATOMIC_RELAXED, __HIP_MEMORY_SCOPE_AGENT); }
        }
    }
};

template <class Epi, class Sched, bool ALIGN_EPI = false, bool SP2 = false>
__device__ __forceinline__ void gemm_phase(PG8_LAS unsigned char* lds, const Gemm g, const Sched& S, const Epi& E) {
    const int tid = threadIdx.x, wid = __builtin_amdgcn_readfirstlane(tid >> 6), lane = tid & 63, wr = wid >> 2, wc = wid & 3, fr = lane & 15, fq = lane >> 4;
    const int K = g.K, nt = K / BK;
    unsigned voffA[2], voffB[2];
#pragma unroll
    for (int i = 0; i < 2; ++i) { int R, C; stage_rc(tid * 16 + i * 8192, R, C); const int Rb = Epi::PERM ? ((R & ~31) + perm32(R & 31)) : R;
        voffA[i] = (unsigned)(R * K + C) * 2u; voffB[i] = (unsigned)(Rb * K + C) * 2u; }
    const size_t kstep = (size_t)(BK * 2);
    const size_t hstep = (size_t)HALF * K * 2;
    const size_t tstep = 2 * hstep;
    const unsigned ldsw = (unsigned)wid * 1024u;
    const int aoff = lds_byte(wr * 64 + fr, fq * 8), boff = lds_byte(wc * 32 + fr, fq * 8);
#define PG8_SA(b, h) (((b) * 2 + (h)) * HTB)
#define PG8_SB(b, h) ((4 + (b) * 2 + (h)) * HTB)
#define PG8_STAGE(bufoff, gbase, voff) do { _Pragma("unroll") for (int _i = 0; _i < 2; ++_i) \
        __builtin_amdgcn_global_load_lds((const unsigned*)((const char*)(gbase) + (voff)[_i]), (PG8_LAS unsigned*)(lds + (bufoff) + ldsw + _i * 8192), 16, 0, 0); } while (0)
#define PG8_LDA(dst, b, h) do { _Pragma("unroll") for (int m = 0; m < 4; ++m) _Pragma("unroll") for (int k = 0; k < 2; ++k) dst[m][k] = *(const PG8_LAS bf16x8*)(lds + PG8_SA(b, h) + aoff + m * 2048 + k * 1024); } while (0)
#define PG8_LDB(dst, b, h) do { _Pragma("unroll") for (int n = 0; n < 2; ++n) _Pragma("unroll") for (int k = 0; k < 2; ++k) dst[n][k] = *(const PG8_LAS bf16x8*)(lds + PG8_SB(b, h) + boff + n * 2048 + k * 1024); } while (0)
#define PG8_MMA(ai, bj, At, Bt) do { __builtin_amdgcn_s_setprio(1); _Pragma("unroll") for (int m = 0; m < 4; ++m) _Pragma("unroll") for (int n = 0; n < 2; ++n) _Pragma("unroll") for (int k = 0; k < 2; ++k) \
        acc[ai][bj][m][n] = __builtin_amdgcn_mfma_f32_16x16x32_bf16(Bt[n][k], At[m][k], acc[ai][bj][m][n], 0, 0, 0); __builtin_amdgcn_s_setprio(0); } while (0)
#define PG8_WAIT_V(n) asm volatile("s_waitcnt vmcnt(" #n ")" ::: "memory")
#define PG8_WAIT_L(n) asm volatile("s_waitcnt lgkmcnt(" #n ")" ::: "memory")
#define PG8_BAR __builtin_amdgcn_s_barrier()
#define PG8_SCHED __builtin_amdgcn_sched_barrier(0)
    Unit cur, nxt; int ui = 0;
    if (!S.next(0, cur)) return;
    f32x4 acc[2][2][4][2];
#pragma unroll
    for (int a = 0; a < 2; ++a)
#pragma unroll
        for (int b = 0; b < 2; ++b)
#pragma unroll
            for (int m = 0; m < 4; ++m)
#pragma unroll
                for (int n = 0; n < 2; ++n) acc[a][b][m][n] = (f32x4){0.f, 0.f, 0.f, 0.f};
    bf16x8 At[4][2], B0[2][2], B1[2][2];
    const char* cA = (const char*)g.A + (size_t)cur.pm * tstep; const char* cB = (const char*)g.Bt + (size_t)cur.pn * tstep;
    S.a_ready(cur);
    if constexpr (SP2) {
        PG8_STAGE(PG8_SB(0, 0), cB, voffB); PG8_STAGE(PG8_SB(0, 1), cB + hstep, voffB); PG8_STAGE(PG8_SA(0, 0), cA, voffA); PG8_STAGE(PG8_SA(0, 1), cA + hstep, voffA);
        if (wr == 1) PG8_BAR;
        PG8_WAIT_V(2); PG8_BAR;
        PG8_STAGE(PG8_SB(1, 0), cB + kstep, voffB); PG8_STAGE(PG8_SA(1, 0), cA + kstep, voffA); PG8_STAGE(PG8_SB(1, 1), cB + hstep + kstep, voffB);
        PG8_WAIT_V(6); PG8_BAR;
    } else {
        PG8_STAGE(PG8_SB(0, 0), cB, voffB); PG8_STAGE(PG8_SA(0, 0), cA, voffA); PG8_STAGE(PG8_SB(0, 1), cB + hstep, voffB); PG8_STAGE(PG8_SA(0, 1), cA + hstep, voffA);
        if (wr == 1) PG8_BAR;
        PG8_WAIT_V(4); PG8_BAR;
        PG8_STAGE(PG8_SB(1, 0), cB + kstep, voffB); PG8_STAGE(PG8_SA(1, 0), cA + kstep, voffA); PG8_STAGE(PG8_SB(1, 1), cB + hstep + kstep, voffB);
        PG8_WAIT_V(6); PG8_BAR;
    }
    for (;;) {
        const bool has_next = S.next(ui + 1, nxt);
        const char* nA = has_next ? (const char*)g.A + (size_t)nxt.pm * tstep : cA; const char* nB = has_next ? (const char*)g.Bt + (size_t)nxt.pn * tstep : cB;
        for (int t = 0; t < nt; t += 2) {
            const bool last = (t == nt - 2);
            const char* a1 = cA + (size_t)(t + 1) * kstep;
            const char* a2 = last ? nA : cA + (size_t)(t + 2) * kstep; const char* b2 = last ? nB : cB + (size_t)(t + 2) * kstep;
            const char* a3 = a2 + kstep; const char* b3 = b2 + kstep;
            if (last && has_next) S.a_ready(nxt);
            if constexpr (Epi::MID) { if (t == nt / 2) E.mid(acc, cur, wr, wc, fr, fq); }
            if constexpr (SP2) {
            PG8_LDB(B0, 0, 0); PG8_LDB(B1, 0, 1); PG8_SCHED; PG8_LDA(At, 0, 0); PG8_STAGE(PG8_SA(1, 1), a1 + hstep, voffA);
            PG8_WAIT_V(8); PG8_WAIT_L(0); PG8_BAR; PG8_MMA(0, 0, At, B0); PG8_MMA(0, 1, At, B1); PG8_BAR; PG8_SCHED;
            PG8_LDA(At, 0, 1); PG8_STAGE(PG8_SB(0, 0), b2, voffB); PG8_STAGE(PG8_SB(0, 1), b2 + hstep, voffB); PG8_STAGE(PG8_SA(0, 0), a2, voffA);
            PG8_WAIT_V(8); PG8_WAIT_L(0); PG8_BAR; PG8_MMA(1, 0, At, B0); PG8_MMA(1, 1, At, B1); PG8_BAR; PG8_SCHED;
            PG8_LDB(B0, 1, 0); PG8_LDB(B1, 1, 1); PG8_SCHED; PG8_LDA(At, 1, 0); PG8_STAGE(PG8_SA(0, 1), a2 + hstep, voffA);
            PG8_WAIT_V(8); PG8_WAIT_L(0); PG8_BAR; PG8_MMA(0, 0, At, B0); PG8_MMA(0, 1, At, B1); PG8_BAR; PG8_SCHED;
            PG8_LDA(At, 1, 1); PG8_STAGE(PG8_SB(1, 0), b3, voffB); PG8_STAGE(PG8_SB(1, 1), b3 + hstep, voffB); PG8_STAGE(PG8_SA(1, 0), a3, voffA);
            PG8_WAIT_V(8); PG8_WAIT_L(0); PG8_BAR; PG8_MMA(1, 0, At, B0); PG8_MMA(1, 1, At, B1); PG8_BAR; PG8_SCHED;
            } else {
            PG8_LDB(B0, 0, 0); PG8_SCHED; PG8_LDA(At, 0, 0); PG8_STAGE(PG8_SA(1, 1), a1 + hstep, voffA);
            PG8_WAIT_L(8); PG8_BAR; PG8_WAIT_L(0); PG8_MMA(0, 0, At, B0); PG8_BAR; PG8_SCHED;
            PG8_LDB(B1, 0, 1); PG8_STAGE(PG8_SB(0, 0), b2, voffB);
            PG8_BAR; PG8_WAIT_L(0); PG8_MMA(0, 1, At, B1); PG8_BAR;
            PG8_LDA(At, 0, 1); PG8_STAGE(PG8_SA(0, 0), a2, voffA);
            PG8_BAR; PG8_WAIT_L(0); PG8_MMA(1, 0, At, B0); PG8_BAR; PG8_SCHED;
            PG8_STAGE(PG8_SB(0, 1), b2 + hstep, voffB);
            PG8_WAIT_V(6); PG8_BAR; PG8_MMA(1, 1, At, B1); PG8_BAR;
            PG8_LDB(B0, 1, 0); PG8_SCHED; PG8_LDA(At, 1, 0); PG8_STAGE(PG8_SA(0, 1), a2 + hstep, voffA);
            PG8_WAIT_L(8); PG8_BAR; PG8_WAIT_L(0); PG8_MMA(0, 0, At, B0); PG8_BAR; PG8_SCHED;
            PG8_LDB(B1, 1, 1); PG8_STAGE(PG8_SB(1, 0), b3, voffB);
            PG8_BAR; PG8_WAIT_L(0); PG8_MMA(0, 1, At, B1); PG8_BAR;
            PG8_LDA(At, 1, 1); PG8_STAGE(PG8_SA(1, 0), a3, voffA);
            PG8_BAR; PG8_WAIT_L(0); PG8_MMA(1, 0, At, B0); PG8_BAR; PG8_SCHED;
            PG8_STAGE(PG8_SB(1, 1), b3 + hstep, voffB);
            PG8_WAIT_V(6); PG8_BAR; PG8_MMA(1, 1, At, B1); PG8_BAR;
            }
        }
        if constexpr (ALIGN_EPI) { if (wr == 0) PG8_BAR; }
        if constexpr (!Epi::AFTER_DRAIN) { E(acc, cur, wr, wc, fr, fq); S.done(cur); }
        if (!has_next) break;
#pragma unroll
        for (int a = 0; a < 2; ++a)
#pragma unroll
            for (int b = 0; b < 2; ++b)
#pragma unroll
                for (int m = 0; m < 4; ++m)
#pragma unroll
                    for (int n = 0; n < 2; ++n) acc[a][b][m][n] = (f32x4){0.f, 0.f, 0.f, 0.f};
        cur = nxt; cA = nA; cB = nB; ++ui;
        if constexpr (ALIGN_EPI) { if (wr == 1) PG8_BAR; }
    }
    PG8_WAIT_V(0);
    if constexpr (!ALIGN_EPI) { if (wr == 0) PG8_BAR; }
    PG8_BAR;
    if constexpr (Epi::AFTER_DRAIN) { E.fused(acc, cur, wr, wc, fr, fq, lds, wid, lane); S.done(cur); }
#undef PG8_SA
#undef PG8_SB
#undef PG8_STAGE
#undef PG8_LDA
#undef PG8_LDB
#undef PG8_MMA
#undef PG8_WAIT_V
#undef PG8_WAIT_L
#undef PG8_BAR
#undef PG8_SCHED
}

struct UnitX { int pm, pn; int arow, brow; const int* glist; const float* wlist; int gvalid; int e; unsigned* sync; };
__device__ __forceinline__ void moe_dep_wait(unsigned* dep, unsigned* wdc, unsigned wd_need, volatile PG8_LAS unsigned* lflag, unsigned seq, int wid, unsigned pre_d, unsigned pre_w) {
    if (wid == 0) { unsigned sp = 0; unsigned d = pre_d, w = pre_w;
        while (d < 2u || w < wd_need) { __builtin_amdgcn_s_sleep(16); if (++sp > (1u << 20)) break;
            d = __builtin_amdgcn_readfirstlane(__hip_atomic_load(dep, __ATOMIC_RELAXED, __HIP_MEMORY_SCOPE_AGENT)); w = __builtin_amdgcn_readfirstlane(__hip_atomic_load(wdc, __ATOMIC_RELAXED, __HIP_MEMORY_SCOPE_AGENT)); }
        *lflag = seq; }
    else { unsigned sp = 0; while (*lflag < seq) { __builtin_amdgcn_s_sleep(4); if (++sp > (1u << 22)) break; } }
    asm volatile("" ::: "memory");
}
template <class Epi, class Sched, bool GATHER, int MODE = 0>
__device__ __forceinline__ void gemm_phase_x(PG8_LAS unsigned char* lds, const Gemm g, const Sched& S, const Epi& E, volatile PG8_LAS unsigned* lflag = nullptr, unsigned* wdc = nullptr, unsigned wd_need = 0u) {
    const int tid = threadIdx.x, wid = __builtin_amdgcn_readfirstlane(tid >> 6), lane = tid & 63, wr = wid >> 2, wc = wid & 3, fr = lane & 15, fq = lane >> 4;
    const int K = g.K, nt = K / BK;
    unsigned vA[2][2], voffB[2]; int tokn[2][2]; int Rr[2], Cc[2];
#pragma unroll
    for (int i = 0; i < 2; ++i) { int R, C; stage_rc(tid * 16 + i * 8192, R, C); const int Rb = Epi::PERM ? ((R & ~31) + perm32(R & 31)) : R; Rr[i] = R; Cc[i] = C; voffB[i] = (unsigned)(Rb * K + C) * 2u; }
    const size_t kstep = (size_t)(BK * 2), hstep = (size_t)HALF * K * 2;
    const unsigned ldsw = (unsigned)wid * 1024u;
    const int aoff = lds_byte(wr * 64 + fr, fq * 8), boff = lds_byte(wc * 32 + fr, fq * 8);
#define PG8_SA(b, h) (((b) * 2 + (h)) * HTB)
#define PG8_SB(b, h) ((4 + (b) * 2 + (h)) * HTB)
#define PG8_STAGE(bufoff, gbase, voff) do { _Pragma("unroll") for (int _i = 0; _i < 2; ++_i) \
        __builtin_amdgcn_global_load_lds((const unsigned*)((const char*)(gbase) + (voff)[_i]), (PG8_LAS unsigned*)(lds + (bufoff) + ldsw + _i * 8192), 16, 0, 0); } while (0)
#define PG8_LDA(dst, b, h) do { _Pragma("unroll") for (int m = 0; m < 4; ++m) _Pragma("unroll") for (int k = 0; k < 2; ++k) dst[m][k] = *(const PG8_LAS bf16x8*)(lds + PG8_SA(b, h) + aoff + m * 2048 + k * 1024); } while (0)
#define PG8_LDB(dst, b, h) do { _Pragma("unroll") for (int n = 0; n < 2; ++n) _Pragma("unroll") for (int k = 0; k < 2; ++k) dst[n][k] = *(const PG8_LAS bf16x8*)(lds + PG8_SB(b, h) + boff + n * 2048 + k * 1024); } while (0)
#define PG8_MMA(ai, bj, At, Bt) do { __builtin_amdgcn_s_setprio(1); _Pragma("unroll") for (int m = 0; m < 4; ++m) _Pragma("unroll") for (int n = 0; n < 2; ++n) _Pragma("unroll") for (int k = 0; k < 2; ++k) \
        acc[ai][bj][m][n] = __builtin_amdgcn_mfma_f32_16x16x32_bf16(Bt[n][k], At[m][k], acc[ai][bj][m][n], 0, 0, 0); __builtin_amdgcn_s_setprio(0); } while (0)
#define PG8_WAIT_V(n) asm volatile("s_waitcnt vmcnt(" #n ")" ::: "memory")
#define PG8_WAIT_L(n) asm volatile("s_waitcnt lgkmcnt(" #n ")" ::: "memory")
#define PG8_BAR __builtin_amdgcn_s_barrier()
#define PG8_SCHED __builtin_amdgcn_sched_barrier(0)
#define PG8_TOK(U, r) (GATHER ? (((r) < (U).gvalid) ? (U).glist[(r)] : 0) : ((U).arow + (r)))
    UnitX cur, nxt; int ui = 0;
    if (!S.next(0, cur)) return;
    if constexpr (MODE == 2) moe_dep_wait(cur.sync, wdc, wd_need, lflag, 1u, wid, 0u, 0u);
    f32x4 acc[2][2][4][2];
#pragma unroll
    for (int a = 0; a < 2; ++a)
#pragma unroll
        for (int b = 0; b < 2; ++b)
#pragma unroll
            for (int m = 0; m < 4; ++m)
#pragma unroll
                for (int n = 0; n < 2; ++n) acc[a][b][m][n] = (f32x4){0.f, 0.f, 0.f, 0.f};
    bf16x8 At[4][2], B0[2][2], B1[2][2];
#pragma unroll
    for (int h = 0; h < 2; ++h)
#pragma unroll
        for (int i = 0; i < 2; ++i) vA[h][i] = (unsigned)(PG8_TOK(cur, h * HALF + Rr[i]) * K + Cc[i]) * 2u;
    const char* gA = (const char*)g.A; const char* cB = (const char*)g.Bt + (size_t)cur.brow * K * 2;
    PG8_STAGE(PG8_SB(0, 0), cB, voffB); PG8_STAGE(PG8_SB(0, 1), cB + hstep, voffB); PG8_STAGE(PG8_SA(0, 0), gA, vA[0]); PG8_STAGE(PG8_SA(0, 1), gA, vA[1]);
    if (wr == 1) PG8_BAR;
    PG8_WAIT_V(2); PG8_BAR;
    PG8_STAGE(PG8_SB(1, 0), cB + kstep, voffB); PG8_STAGE(PG8_SA(1, 0), gA + kstep, vA[0]); PG8_STAGE(PG8_SB(1, 1), cB + hstep + kstep, voffB);
    PG8_WAIT_V(6); PG8_BAR;
    for (;;) {
        const bool has_next = S.next(ui + 1, nxt);
        unsigned pre_d = 0u, pre_w = 0u;
        if constexpr (MODE == 2) { if (has_next && wid == 0) { pre_d = __hip_atomic_load(nxt.sync, __ATOMIC_RELAXED, __HIP_MEMORY_SCOPE_AGENT); pre_w = __hip_atomic_load(wdc, __ATOMIC_RELAXED, __HIP_MEMORY_SCOPE_AGENT); } }
        const char* nB = has_next ? (const char*)g.Bt + (size_t)nxt.brow * K * 2 : cB;
        if (has_next) {
#pragma unroll
            for (int h = 0; h < 2; ++h)
#pragma unroll
                for (int i = 0; i < 2; ++i) tokn[h][i] = PG8_TOK(nxt, h * HALF + Rr[i]);
        }
#pragma clang loop unroll(disable)
        for (int t = 0; t < nt; t += 2) {
            const bool last = (t == nt - 2);
            const char* b2 = last ? nB : cB + (size_t)(t + 2) * kstep; const char* b3 = b2 + kstep;
            const size_t ko2 = last ? (size_t)0 : (size_t)(t + 2) * kstep;
            PG8_LDB(B0, 0, 0); PG8_LDB(B1, 0, 1); PG8_SCHED; PG8_LDA(At, 0, 0); PG8_STAGE(PG8_SA(1, 1), gA + (size_t)(t + 1) * kstep, vA[1]);
            PG8_WAIT_V(8); PG8_WAIT_L(0); PG8_BAR; PG8_MMA(0, 0, At, B0); PG8_MMA(0, 1, At, B1); PG8_BAR; PG8_SCHED;
            if (last && has_next) {
                if constexpr (MODE == 2) moe_dep_wait(nxt.sync, wdc, wd_need, lflag, (unsigned)(ui + 2), wid, (unsigned)__builtin_amdgcn_readfirstlane((int)pre_d), (unsigned)__builtin_amdgcn_readfirstlane((int)pre_w));
#pragma unroll
                for (int h = 0; h < 2; ++h)
#pragma unroll
                    for (int i = 0; i < 2; ++i) vA[h][i] = (unsigned)(tokn[h][i] * K + Cc[i]) * 2u;
            }
            PG8_LDA(At, 0, 1); PG8_STAGE(PG8_SB(0, 0), b2, voffB); PG8_STAGE(PG8_SB(0, 1), b2 + hstep, voffB); PG8_STAGE(PG8_SA(0, 0), gA + ko2, vA[0]);
            PG8_WAIT_V(8); PG8_WAIT_L(0); PG8_BAR; PG8_MMA(1, 0, At, B0); PG8_MMA(1, 1, At, B1); PG8_BAR; PG8_SCHED;
            PG8_LDB(B0, 1, 0); PG8_LDB(B1, 1, 1); PG8_SCHED; PG8_LDA(At, 1, 0); PG8_STAGE(PG8_SA(0, 1), gA + ko2, vA[1]);
            PG8_WAIT_V(8); PG8_WAIT_L(0); PG8_BAR; PG8_MMA(0, 0, At, B0); PG8_MMA(0, 1, At, B1); PG8_BAR; PG8_SCHED;
            PG8_LDA(At, 1, 1); PG8_STAGE(PG8_SB(1, 0), b3, voffB); PG8_STAGE(PG8_SB(1, 1), b3 + hstep, voffB); PG8_STAGE(PG8_SA(1, 0), gA + ko2 + kstep, vA[0]);
            PG8_WAIT_V(8); PG8_WAIT_L(0); PG8_BAR; PG8_MMA(1, 0, At, B0); PG8_MMA(1, 1, At, B1); PG8_BAR; PG8_SCHED;
        }
        if (wr == 0) PG8_BAR;
        { const int l2_ = (int)__builtin_amdgcn_mbcnt_hi(~0u, __builtin_amdgcn_mbcnt_lo(~0u, 0u)); E(acc, cur, wr, wc, l2_ & 15, l2_ >> 4); }
        if constexpr (MODE == 1) {
            asm volatile("s_waitcnt vmcnt(0)" ::: "memory"); PG8_BAR;
            if (wid == 0 && __builtin_amdgcn_mbcnt_hi(~0u, __builtin_amdgcn_mbcnt_lo(~0u, 0u)) == 0u) __hip_atomic_fetch_add(cur.sync, 1u, __ATOMIC_RELAXED, __HIP_MEMORY_SCOPE_AGENT); }
        if (!has_next) break;
#pragma unroll
        for (int a = 0; a < 2; ++a)
#pragma unroll
            for (int b = 0; b < 2; ++b)
#pragma unroll
                for (int m = 0; m < 4; ++m)
#pragma unroll
                    for (int n = 0; n < 2; ++n) acc[a][b][m][n] = (f32x4){0.f, 0.f, 0.f, 0.f};
        cur = nxt; cB = nB; ++ui;
        if (wr == 1) PG8_BAR;
    }
    PG8_WAIT_V(0);
    PG8_BAR;
#undef PG8_TOK
#undef PG8_SA
#undef PG8_SB
#undef PG8_STAGE
#undef PG8_LDA
#undef PG8_LDB
#undef PG8_MMA
#undef PG8_WAIT_V
#undef PG8_WAIT_L
#undef PG8_BAR
#undef PG8_SCHED
}
struct MoeTiles { PG8_LAS int* te; PG8_LAS int* tm; PG8_LAS int* tv; int T; };
struct SchedMoeA {
    MoeTiles mt; const int* ELT; const float* ELW; int vcu, G; unsigned* DONE;
    __device__ __forceinline__ bool next(int i, UnitX& u) const {
        const int idx = i * G + vcu; if (idx >= 2 * mt.T) return false;
        const int ti = idx >> 1, nn = idx & 1, e = mt.te[ti], m = mt.tm[ti];
        u.pm = ti; u.pn = nn; u.arow = 0; u.brow = e * 512 + nn * 256; u.glist = ELT + e * M + m * 256; u.wlist = ELW + e * M + m * 256; u.gvalid = mt.tv[ti]; u.e = e; u.sync = DONE + ti * 16; return true; }
};
struct SchedMoeB {
    MoeTiles mt; int vcu, G; unsigned* DONE;
    __device__ __forceinline__ bool next(int i, UnitX& u) const {
        int nA = 2 * mt.T - G; if (nA < 0 || nA >= G - 32) nA = 0; const int nB = G - nA;
        int idx; const int base3 = 3 * nB + nA;
        if (vcu < nA) idx = i == 0 ? 2 * nB + vcu : base3 + (i - 1) * G + vcu;
        else { const int j = vcu - nA; idx = i < 2 ? i * nB + j : (i == 2 ? 2 * nB + nA + j : base3 + (i - 3) * G + vcu); }
        if (idx >= 4 * mt.T) return false;
        const int ti = idx >> 2, nn = idx & 3, e = mt.te[ti];
        u.pm = ti; u.pn = nn; u.arow = ti * 256; u.brow = e * 1024 + nn * 256; u.glist = nullptr; u.wlist = nullptr; u.gvalid = 256; u.e = e; u.sync = DONE + ti * 16; return true; }
};
struct EpiAct {
    static constexpr bool PERM = true;
    bf16_t* ACT; __amdgpu_buffer_rsrc_t rsrc;
    __device__ __forceinline__ void operator()(const f32x4 (&acc)[2][2][4][2], const UnitX& u, int wr, int wc, int fr, int fq) const {
        int base = ((u.pm * BM + wr * 64 + fr) * 256 + u.pn * 128 + wc * 32 + 8 * fq) * 2; asm volatile("" : "+v"(base));
        const int r0 = wr * 64 + fr;
#pragma unroll
        for (int ai = 0; ai < 2; ++ai)
#pragma unroll
            for (int m = 0; m < 4; ++m) { const int r = ai * HALF + m * 16 + r0; const float w = r < u.gvalid ? u.wlist[r] : 0.f;
                f32x4 v0, v1;
#pragma unroll
                for (int j = 0; j < 4; ++j) { const float g0 = acc[ai][0][m][0][j], g1 = acc[ai][0][m][1][j];
                    v0[j] = g0 * __builtin_amdgcn_rcpf(1.f + __builtin_amdgcn_exp2f(-1.4426950408889634f * g0)) * acc[ai][1][m][0][j] * w;
                    v1[j] = g1 * __builtin_amdgcn_rcpf(1.f + __builtin_amdgcn_exp2f(-1.4426950408889634f * g1)) * acc[ai][1][m][1][j] * w; }
                u32x4 o; o.x = cvt_pk_bf16(v0[0], v0[1]); o.y = cvt_pk_bf16(v0[2], v0[3]); o.z = cvt_pk_bf16(v1[0], v1[1]); o.w = cvt_pk_bf16(v1[2], v1[3]);
                __builtin_amdgcn_raw_buffer_store_b128(o, rsrc, base + (ai * HALF + m * 16) * 512, 0, 16  ); }
    }
};
struct EpiY {
    static constexpr bool PERM = true;
    bf16_t* Y; __amdgpu_buffer_rsrc_t yrsrc;
    __device__ __forceinline__ void operator()(const f32x4 (&acc)[2][2][4][2], const UnitX& u, int wr, int wc, int fr, int fq) const {
        const int c0 = u.pn * BM + wc * 32 + 8 * fq;
#pragma unroll
        for (int ai = 0; ai < 2; ++ai)
#pragma unroll
            for (int m = 0; m < 4; ++m) { const int ro = (u.pm * BM + ai * HALF + wr * 64 + m * 16 + fr) * 1024 + c0;
#pragma unroll
                for (int bj = 0; bj < 2; ++bj) { const f32x4 v0 = acc[ai][bj][m][0], v1 = acc[ai][bj][m][1]; u32x4 o;
                    o.x = cvt_pk_bf16(v0[0], v0[1]); o.y = cvt_pk_bf16(v0[2], v0[3]); o.z = cvt_pk_bf16(v1[0], v1[1]); o.w = cvt_pk_bf16(v1[2], v1[3]);
                    __builtin_amdgcn_raw_buffer_store_b128(o, yrsrc, (ro + bj * HALF) * 2, 0, 16  ); } }
    }
};
}

struct TrItem { const float* W; bf16_t* WT; int N, ldd, k0, kd0, n0, drow0; };
DEV void tr_load(const TrItem& t, f32x4 (&r)[8], int lane) {
    const float* p = t.W + (size_t)(t.k0 + (lane >> 3)) * t.N + t.n0 + (lane & 7) * 4;
#pragma unroll
    for (int i = 0; i < 8; ++i) r[i] = __builtin_nontemporal_load((const f32x4*)(p + (size_t)(8 * i) * t.N));
}
template <bool SC1 = false> DEV void tr_emit(const TrItem& t, const f32x4 (&r)[8], LAS float* scr, int lane, __amdgpu_buffer_rsrc_t wrsrc = __amdgpu_buffer_rsrc_t(), const bf16_t* wbase = nullptr) {
    { const int kq = lane >> 3, nq = (lane & 7) * 4;
#pragma unroll
      for (int i = 0; i < 8; ++i) { LAS float* d = scr + (8 * i + kq) * 33 + nq; d[0] = r[i].x; d[1] = r[i].y; d[2] = r[i].z; d[3] = r[i].w; } }
    LDS_WAIT(); asm volatile("" ::: "memory");
    const int c = lane & 7;
#pragma unroll
    for (int j = 0; j < 4; ++j) { const int n = (lane >> 3) + 8 * j; const LAS float* s = scr + (8 * c) * 33 + n;
        v4u o; o.x = pk2(s[0 * 33], s[1 * 33]); o.y = pk2(s[2 * 33], s[3 * 33]); o.z = pk2(s[4 * 33], s[5 * 33]); o.w = pk2(s[6 * 33], s[7 * 33]);
        if constexpr (SC1) __builtin_amdgcn_raw_buffer_store_b128(o, wrsrc, (int)((t.WT + (size_t)(t.drow0 + n) * t.ldd + t.kd0 + 8 * c) - wbase) * 2, 0, 16  );
        else *(GAS v4u*)(t.WT + (size_t)(t.drow0 + n) * t.ldd + t.kd0 + 8 * c) = o; }
    LDS_WAIT(); asm volatile("" ::: "memory");
}
DEV int in_row_map(int c0) {
    if (c0 < 1024) { const int sect = c0 >> 9, cc = c0 & 511, tile = cc >> 8, u = (cc & 255) >> 6, half = (cc & 63) >> 5; return sect * 512 + tile * 256 + half * 128 + u * 32; }
    if (c0 < 2048) return c0;
    if (c0 < 3072) { const int isu = c0 >= 2560, ch = c0 - (isu ? 2560 : 2048); return 2048 + (ch >> 7) * 256 + isu * 128 + (ch & 127); }
    return c0;
}
DEV void p0_prologue(Frame& F, const Args& a) {
    const float* c = (const float*)a.in[1]; const int* pos = (const int*)a.in[2]; const float* w_ada = (const float*)a.in[3]; const float* b_ada = (const float*)a.in[4];
    float* MOD = (float*)(F.ws + WS_MOD); float* ROPE = (float*)(F.ws + WS_ROPE);
    {
        LAS float* ca = (LAS float*)F.lds;
        LAS float* part = (LAS float*)(F.lds + 16384);
        for (int i = F.tid; i < 4 * DM; i += NTHR) { const float v = c[i]; ca[i] = v / (1.f + expf(-v)); }
        __syncthreads();
        for (int ch = blockIdx.x; ch < 256; ch += F.G) {
            const int col = F.tid % 24, ks = F.tid / 24;
            if (ks < 21) {
                float a0 = 0.f, a1 = 0.f, a2 = 0.f, a3 = 0.f;
                const float* wp = w_ada + (size_t)ks * 6144 + ch * 24 + col;
                for (int k = ks; k < DM; k += 21 * 13) {
                    float w[13];
#pragma unroll
                    for (int j = 0; j < 13; ++j) w[j] = (k + 21 * j < DM) ? __builtin_nontemporal_load(wp + (size_t)(k - ks + 21 * j) * 6144) : 0.f;
#pragma unroll
                    for (int j = 0; j < 13; ++j) { const int kk = (k + 21 * j < DM) ? k + 21 * j : 0; a0 += ca[kk] * w[j]; a1 += ca[DM + kk] * w[j]; a2 += ca[2 * DM + kk] * w[j]; a3 += ca[3 * DM + kk] * w[j]; }
                }
                part[(ks * 4 + 0) * 24 + col] = a0; part[(ks * 4 + 1) * 24 + col] = a1; part[(ks * 4 + 2) * 24 + col] = a2; part[(ks * 4 + 3) * 24 + col] = a3;
            }
            __syncthreads();
            if (F.tid < 96) { const int b = F.tid / 24, cc = F.tid % 24; float s = b_ada[ch * 24 + cc];
                for (int q = 0; q < 21; ++q) s += part[(q * 4 + b) * 24 + cc];
                __hip_atomic_store(MOD + b * 6144 + ch * 24 + cc, s, __ATOMIC_RELAXED, __HIP_MEMORY_SCOPE_AGENT); }
            asm volatile("s_waitcnt vmcnt(0)" ::: "memory");
            __syncthreads();
            if (F.tid == 0) __hip_atomic_fetch_add(F.ctl + CW_MODC, 1u, __ATOMIC_RELAXED, __HIP_MEMORY_SCOPE_AGENT);
        }
    }
    const int gt = F.vcu * NTHR + F.tid, NGT = F.G * NTHR;
    for (int idx = gt; idx < M * 32; idx += NGT) {
        const int row = idx >> 5, i = idx & 31;
        const float inv = exp2f(-(float)i * (13.287712379549449f / 32.f));
        float s, cs; sincosf((float)pos[row] * inv, &s, &cs);
        __hip_atomic_store((unsigned long long*)(ROPE + idx * 2), (unsigned long long)__float_as_uint(cs) | ((unsigned long long)__float_as_uint(s) << 32), __ATOMIC_RELAXED, __HIP_MEMORY_SCOPE_AGENT);
    }
    {
        const float* w_grp = (const float*)a.in[17]; const float* w_exr = (const float*)a.in[19];
        bf16_t* RH = (bf16_t*)(F.ws + WS_WT_R); bf16_t* RL = RH + 48 * DM;
        for (int idx = gt; idx < 48 * DM; idx += NGT) { const int n = idx >> 10, k = idx & 1023;
            const float w = n < 4 ? w_grp[k * 4 + n] : (n < 36 ? w_exr[k * 32 + (n - 4)] : 0.f);
            const bf16_t h = f2bf(w); __hip_atomic_store((unsigned short*)(RH + idx), (unsigned short)h, __ATOMIC_RELAXED, __HIP_MEMORY_SCOPE_AGENT); __hip_atomic_store((unsigned short*)(RL + idx), (unsigned short)f2bf(w - bf2f(h)), __ATOMIC_RELAXED, __HIP_MEMORY_SCOPE_AGENT); }
    }
    __syncthreads();
    LAS float* scr = (LAS float*)(F.lds + F.wave * 16384);
    const int gw = F.vcu * NWAVES + F.wave, NGW = F.G * NWAVES;
    constexpr int I_IN = 16 * 160, I_A = 8 * 32, I_O = 16 * 32, I_G = 32 * 16 * 8, I_D = 32 * 4 * 32;
    constexpr int NITEMS = I_IN + 2 * I_A + I_O + 2 * I_G;
    (void)I_D;
    auto decode = [&](int it) -> TrItem {
        TrItem t; int r = it;
        if (r < I_IN) { const int kb = r / 160, nb = r % 160; t.W = (const float*)a.in[6]; t.N = INW; t.WT = (bf16_t*)(F.ws + WS_WT_IN); t.ldd = DM; t.k0 = kb * 64; t.kd0 = t.k0; t.n0 = nb * 32; t.drow0 = in_row_map(nb * 32); return t; } r -= I_IN;
        if (r < I_A) { const int kb = r / 32, nb = r % 32; t.W = (const float*)a.in[13]; t.N = DM; t.WT = (bf16_t*)(F.ws + WS_WT_A); t.ldd = 1024; t.k0 = kb * 64; t.kd0 = t.k0; t.n0 = nb * 32; t.drow0 = nb * 32; return t; } r -= I_A;
        if (r < I_A) { const int kb = r / 32, nb = r % 32; t.W = (const float*)a.in[14]; t.N = DM; t.WT = (bf16_t*)(F.ws + WS_WT_A); t.ldd = 1024; t.k0 = kb * 64; t.kd0 = 512 + t.k0; t.n0 = nb * 32; t.drow0 = nb * 32; return t; } r -= I_A;
        if (r < I_O) { const int kb = r / 32, nb = r % 32; t.W = (const float*)a.in[15]; t.N = DM; t.WT = (bf16_t*)(F.ws + WS_WT_O); t.ldd = DM; t.k0 = kb * 64; t.kd0 = t.k0; t.n0 = nb * 32; t.drow0 = nb * 32; return t; } r -= I_O;
        if (r < 2 * I_G) { const int isu = r >= I_G; if (isu) r -= I_G; const int e = r / 128, q = r % 128, kb = q / 8, nb = q % 8, n0 = nb * 32;
            t.W = (const float*)a.in[isu ? 22 : 21] + (size_t)e * DM * FF; t.N = FF; t.WT = (bf16_t*)(F.ws + WS_WT_GU) + (size_t)e * 512 * DM; t.ldd = DM; t.k0 = kb * 64; t.kd0 = t.k0; t.n0 = n0; t.drow0 = (n0 >> 7) * 256 + isu * 128 + (n0 & 127); return t; } r -= 2 * I_G;
        { const int e = r / 128, q = r % 128, kb = q / 32, nb = q % 32;
          t.W = (const float*)a.in[23] + (size_t)e * FF * DM; t.N = DM; t.WT = (bf16_t*)(F.ws + WS_WT_D) + (size_t)e * DM * FF; t.ldd = FF; t.k0 = kb * 64; t.kd0 = t.k0; t.n0 = nb * 32; t.drow0 = nb * 32; return t; }
    };
    const __amdgpu_buffer_rsrc_t wrsrc = __builtin_amdgcn_make_buffer_rsrc((void*)(F.ws + WS_WEIGHTS), 0, 64 * 1024 * 1024, 0x00020000);
    if (gw < NITEMS) {
        TrItem cur = decode(gw); f32x4 rc[8]; tr_load(cur, rc, F.lane);
        for (int it = gw; it < NITEMS; it += NGW) {
            const int nx = it + NGW; TrItem nxt = cur; f32x4 rn[8];
            if (nx < NITEMS) { nxt = decode(nx); tr_load(nxt, rn, F.lane); }
            tr_emit<true>(cur, rc, scr, F.lane, wrsrc, (const bf16_t*)(F.ws + WS_WEIGHTS));
            if (nx < NITEMS) { cur = nxt;
#pragma unroll
                for (int i = 0; i < 8; ++i) rc[i] = rn[i]; }
        }
    }
    asm volatile("s_waitcnt vmcnt(0)" ::: "memory"); __syncthreads();
    if (F.tid == 0) __hip_atomic_fetch_add(F.ctl + CW_P0C, 1u, __ATOMIC_RELAXED, __HIP_MEMORY_SCOPE_AGENT);
}

DEV void p7_wdown_transposes(Frame& F, const Args& a, int worker, int nworkers, unsigned* wdc) {
    LAS float* scr = (LAS float*)(F.lds + F.wave * 16384);
    constexpr int I_D = 32 * 4 * 32;
    auto decode = [&](int r) -> TrItem { TrItem t; const int e = r / 128, q = r % 128, kb = q / 32, nb = q % 32;
        t.W = (const float*)a.in[23] + (size_t)e * FF * DM; t.N = DM; t.WT = (bf16_t*)(F.ws + WS_WT_D) + (size_t)e * DM * FF; t.ldd = FF; t.k0 = kb * 64; t.kd0 = t.k0; t.n0 = nb * 32; t.drow0 = nb * 32; return t; };
    const int gw = worker * NWAVES + F.wave, NGW = nworkers * NWAVES;
    const __amdgpu_buffer_rsrc_t wrsrc = __builtin_amdgcn_make_buffer_rsrc((void*)(F.ws + WS_WEIGHTS), 0, 64 * 1024 * 1024, 0x00020000);
    if (gw < I_D) {
        TrItem cur = decode(gw); f32x4 rc[8]; tr_load(cur, rc, F.lane);
        for (int it = gw; it < I_D; it += NGW) {
            const int nx = it + NGW; TrItem nxt = cur; f32x4 rn[8];
            if (nx < I_D) { nxt = decode(nx); tr_load(nxt, rn, F.lane); }
            tr_emit<true>(cur, rc, scr, F.lane, wrsrc, (const bf16_t*)(F.ws + WS_WEIGHTS));
            if (nx < I_D) { cur = nxt;
#pragma unroll
                for (int i = 0; i < 8; ++i) rc[i] = rn[i]; }
        }
    }
    asm volatile("s_waitcnt vmcnt(0)" ::: "memory"); __syncthreads();
    if (F.tid == 0) __hip_atomic_fetch_add(wdc, 1u, __ATOMIC_RELAXED, __HIP_MEMORY_SCOPE_AGENT);
}
DEV void p1_h(Frame& F, const Args& a) {
    { unsigned sp = 0;
      while (__builtin_amdgcn_readfirstlane(__hip_atomic_load(F.ctl + CW_MODC, __ATOMIC_RELAXED, __HIP_MEMORY_SCOPE_AGENT)) < 256u) { __builtin_amdgcn_s_sleep(8); if (++sp > (1u << 20)) break; }
      asm volatile("" ::: "memory"); }
    const float* x = (const float*)a.in[0]; const float* g = (const float*)a.in[5]; const float* MOD = (const float*)(F.ws + WS_MOD); bf16_t* Hb = (bf16_t*)(F.ws + WS_H);
    for (int ch = F.vcu; ch < M / 64; ch += F.G) {
    for (int m0 = ch * 64 + F.wave; m0 < ch * 64 + 64; m0 += 2 * NWAVES) {
        const int m1 = m0 + NWAVES;
        const GAS f32x4* xr0 = (const GAS f32x4*)(x + (size_t)m0 * DM) + F.lane; const GAS f32x4* xr1 = (const GAS f32x4*)(x + (size_t)m1 * DM) + F.lane;
        f32x4 v0[4], v1[4]; float s0 = 0.f, s1 = 0.f;
#pragma unroll
        for (int j = 0; j < 4; ++j) { v0[j] = __builtin_nontemporal_load(xr0 + 64 * j); v1[j] = __builtin_nontemporal_load(xr1 + 64 * j); }
#pragma unroll
        for (int j = 0; j < 4; ++j) { s0 += (v0[j].x * v0[j].x + v0[j].y * v0[j].y) + (v0[j].z * v0[j].z + v0[j].w * v0[j].w); s1 += (v1[j].x * v1[j].x + v1[j].y * v1[j].y) + (v1[j].z * v1[j].z + v1[j].w * v1[j].w); }
        const float r0 = rsqrtf(wave_sum(s0) * (1.f / DM) + EPS), r1 = rsqrtf(wave_sum(s1) * (1.f / DM) + EPS);
        const float* md0 = MOD + (m0 / SEQ) * 6144; const float* md1 = MOD + (m1 / SEQ) * 6144;
        GAS unsigned long long* o0 = (GAS unsigned long long*)(Hb + (size_t)m0 * DM) + F.lane; GAS unsigned long long* o1 = (GAS unsigned long long*)(Hb + (size_t)m1 * DM) + F.lane;
#pragma unroll
        for (int j = 0; j < 4; ++j) { const int k = 4 * F.lane + 256 * j; const f32x4 gg = *(const f32x4*)(g + k);
            const f32x4 h0 = v0[j] * r0 * gg * (*(const f32x4*)(md0 + 1024 + k) + 1.f) + *(const f32x4*)(md0 + k);
            const f32x4 h1 = v1[j] * r1 * gg * (*(const f32x4*)(md1 + 1024 + k) + 1.f) + *(const f32x4*)(md1 + k);
            __hip_atomic_store((unsigned long long*)(o0 + 64 * j), (unsigned long long)pk2(h0.x, h0.y) | ((unsigned long long)pk2(h0.z, h0.w) << 32), __ATOMIC_RELAXED, __HIP_MEMORY_SCOPE_AGENT);
            __hip_atomic_store((unsigned long long*)(o1 + 64 * j), (unsigned long long)pk2(h1.x, h1.y) | ((unsigned long long)pk2(h1.z, h1.w) << 32), __ATOMIC_RELAXED, __HIP_MEMORY_SCOPE_AGENT); }
    }
    asm volatile("s_waitcnt vmcnt(0)" ::: "memory"); __syncthreads();
    if (F.tid == 0) __hip_atomic_fetch_add(F.ctl + CW_PC1 + (ch >> 2) * 16, 1u, __ATOMIC_RELAXED, __HIP_MEMORY_SCOPE_AGENT);
    }
}

namespace att {
typedef short bf16x8 __attribute__((ext_vector_type(8)));
typedef short s16x4 __attribute__((ext_vector_type(4)));
typedef float f32x16 __attribute__((ext_vector_type(16)));
typedef float f32x4 __attribute__((ext_vector_type(4)));
typedef unsigned u32x4 __attribute__((ext_vector_type(4)));
constexpr int LD = 512;
constexpr int LDO = 1024;
constexpr int NW = 8, QBLK = 32, KVBLK = 64, QB = 128, NQB = SEQ / QB;
constexpr int SHM_V = KVBLK * 128 * 2, SHM_K = KVBLK * 128 * 2;
constexpr int LDS_WS = 2 * SHM_V + 2 * SHM_K, LDS_XCH = LDS_WS + NW * 64 * 4, LDS_END = LDS_XCH + 4 * 32 * 128 * 4;
constexpr float SCALE = 0.125f, THR = 8.f;
#define KSWZ(row, colB) ((row) * 256 + ((colB) ^ (((row) & 7) << 4)))
#define SBAR() __builtin_amdgcn_sched_barrier(0)
__device__ __forceinline__ int v_st(int k, int c) { const int kk = (k & ~0xC) | ((k & 4) << 1) | ((k & 8) >> 1); return ((kk >> 3) * 4 + (c >> 5)) * 512 + ((kk & 7) * 32 + (c & 31)) * 2; }
__device__ __forceinline__ int v_rd_base(int lane) { return ((lane & 3) << 3) | (((lane >> 2) & 3) << 6) | (((lane >> 4) & 1) << 5) | (((lane >> 5) & 1) << 8); }
constexpr int v_rd_off(int d0, int ks, int half) { return d0 * 512 + ks * 4096 + half * 2048; }
__device__ __forceinline__ int crow(int r, int hi) { return (r & 3) + 8 * (r >> 2) + 4 * hi; }
typedef float f32x2a_t __attribute__((ext_vector_type(2))); typedef __bf16 bf16x2a_t __attribute__((ext_vector_type(2)));
__device__ __forceinline__ unsigned cvtpk(float lo, float hi) { f32x2a_t v = {lo, hi}; bf16x2a_t b = __builtin_convertvector(v, bf16x2a_t); return __builtin_bit_cast(unsigned, b); }
__device__ __forceinline__ bf16x8 load8(const bf16_t* p) { return *reinterpret_cast<const bf16x8*>(p); }
__device__ __forceinline__ void mask_tile(f32x16& p0, f32x16& p1, int dq) {
    const float NEG = -__builtin_inff();
#pragma unroll
    for (int r = 0; r < 16; ++r) { const int c = (r & 3) + 8 * (r >> 2); if (dq - c < 0) p0[r] = NEG; if (dq - c - 32 < 0) p1[r] = NEG; }
}
__device__ __forceinline__ void partialSM(f32x16& p0, f32x16& p1, float& m_reg, float& mn, float& alpha) {
    float pmax = p0[0]; for (int r = 1; r < 16; ++r) pmax = fmaxf(pmax, p0[r]); for (int r = 0; r < 16; ++r) pmax = fmaxf(pmax, p1[r]);
    { auto rr = __builtin_amdgcn_permlane32_swap(__float_as_uint(pmax), __float_as_uint(pmax), false, false);
      pmax = fmaxf(__uint_as_float(rr[0]), __uint_as_float(rr[1])); }
    constexpr float C2 = 1.4426950408889634f * SCALE;
    if (__builtin_expect(__all((pmax - m_reg) * SCALE <= THR), 1)) { mn = m_reg; alpha = 1.f; }
    else { mn = fmaxf(m_reg, pmax); alpha = __builtin_amdgcn_exp2f((m_reg - mn) * C2); m_reg = mn; }
    const float mnL = -mn * C2;
    for (int r = 0; r < 16; ++r) p0[r] = fmaf(p0[r], C2, mnL); for (int r = 0; r < 16; ++r) p1[r] = fmaf(p1[r], C2, mnL);
    for (int r = 0; r < 16; ++r) p0[r] = __builtin_amdgcn_exp2f(p0[r]);
}
__device__ __forceinline__ void finishSM(f32x16& p0, f32x16& p1, float alpha, float& l_reg, bf16x8& pa0, bf16x8& pa1, bf16x8& pa2, bf16x8& pa3) {
    for (int r = 0; r < 16; ++r) p1[r] = __builtin_amdgcn_exp2f(p1[r]);
    float ps = 0; for (int r = 0; r < 16; ++r) ps += p0[r]; for (int r = 0; r < 16; ++r) ps += p1[r];
    { auto rr = __builtin_amdgcn_permlane32_swap(__float_as_uint(ps), __float_as_uint(ps), false, false);
      ps = __uint_as_float(rr[0]) + __uint_as_float(rr[1]); }
    l_reg = l_reg * alpha + ps;
#define PK4(P, B_, OUT) do { unsigned a0 = cvtpk(P[B_+0], P[B_+1]), a1 = cvtpk(P[B_+2], P[B_+3]);                          \
        unsigned b0 = cvtpk(P[B_+4], P[B_+5]), b1 = cvtpk(P[B_+6], P[B_+7]);                                             \
        auto r0 = __builtin_amdgcn_permlane32_swap(a0, b0, false, false); auto r1 = __builtin_amdgcn_permlane32_swap(a1, b1, false, false); \
        u32x4 w = {r0[0], r1[0], r0[1], r1[1]}; OUT = *reinterpret_cast<bf16x8*>(&w); } while (0)
    PK4(p0, 0, pa0); PK4(p0, 8, pa1); PK4(p1, 0, pa2); PK4(p1, 8, pa3);
#undef PK4
}
template <int KB>
__device__ __forceinline__ void qkt(f32x16& p0, f32x16& p1, const char* K_lds, int r32, int hi, int mp, const bf16x8* qr) {
    p0 = f32x16{}; p1 = f32x16{};
    const char* kb[4];
#pragma unroll
    for (int dd = 0; dd < 4; ++dd) kb[dd] = K_lds + KB * SHM_K + KSWZ(r32, (dd * 16 + hi * 8) * 2) + mp * 128;

#pragma unroll
    for (int d0 = 0; d0 < 4; ++d0) { const char* a = kb[d0];
        bf16x8 b0 = *reinterpret_cast<const bf16x8*>(a);
        bf16x8 b1 = *reinterpret_cast<const bf16x8*>(a + 32 * 256);
        p0 = __builtin_amdgcn_mfma_f32_32x32x16_bf16(b0, qr[d0], p0, 0, 0, 0);
        p1 = __builtin_amdgcn_mfma_f32_32x32x16_bf16(b1, qr[d0], p1, 0, 0, 0); }

}
template <int VB>
__device__ __forceinline__ void pv_tile(f32x16* o, int vb0, bf16x8 pa0, bf16x8 pa1, bf16x8 pa2, bf16x8 pa3) {
#define TRRD(dst, off) asm volatile("ds_read_b64_tr_b16 %0, %1 offset:%2" : "=&v"(dst) : "v"(vb0), "i"(off) : "memory")
#define PV_RD(S, d0) do { constexpr int b_ = VB * SHM_V + v_rd_off(d0, 0, 0); \
        TRRD(S##l0, b_); TRRD(S##h0, b_ + 2048); TRRD(S##l1, b_ + 4096); TRRD(S##h1, b_ + 6144); TRRD(S##l2, b_ + 8192); TRRD(S##h2, b_ + 10240); TRRD(S##l3, b_ + 12288); TRRD(S##h3, b_ + 14336); } while (0)
#define PV_MM(S, d0) do { \
        o[d0] = __builtin_amdgcn_mfma_f32_32x32x16_bf16(pa0, (bf16x8){S##l0[0], S##l0[1], S##l0[2], S##l0[3], S##h0[0], S##h0[1], S##h0[2], S##h0[3]}, o[d0], 0, 0, 0);   \
        o[d0] = __builtin_amdgcn_mfma_f32_32x32x16_bf16(pa1, (bf16x8){S##l1[0], S##l1[1], S##l1[2], S##l1[3], S##h1[0], S##h1[1], S##h1[2], S##h1[3]}, o[d0], 0, 0, 0);   \
        o[d0] = __builtin_amdgcn_mfma_f32_32x32x16_bf16(pa2, (bf16x8){S##l2[0], S##l2[1], S##l2[2], S##l2[3], S##h2[0], S##h2[1], S##h2[2], S##h2[3]}, o[d0], 0, 0, 0);   \
        o[d0] = __builtin_amdgcn_mfma_f32_32x32x16_bf16(pa3, (bf16x8){S##l3[0], S##l3[1], S##l3[2], S##l3[3], S##h3[0], S##h3[1], S##h3[2], S##h3[3]}, o[d0], 0, 0, 0); } while (0)
    s16x4 al0, al1, al2, al3, ah0, ah1, ah2, ah3, bl0, bl1, bl2, bl3, bh0, bh1, bh2, bh3;

    PV_RD(a, 0);
    PV_RD(b, 1); asm volatile("s_waitcnt lgkmcnt(8)" ::: "memory"); SBAR(); PV_MM(a, 0); SBAR();
    PV_RD(a, 2); asm volatile("s_waitcnt lgkmcnt(8)" ::: "memory"); SBAR(); PV_MM(b, 1); SBAR();
    PV_RD(b, 3); asm volatile("s_waitcnt lgkmcnt(8)" ::: "memory"); SBAR(); PV_MM(a, 2); SBAR();
    asm volatile("s_waitcnt lgkmcnt(0)" ::: "memory"); SBAR(); PV_MM(b, 3);

#undef PV_MM
#undef PV_RD
#undef TRRD
}
struct BlockRef { int qoff, koff, P0, ooff; };
struct Bufs { const bf16_t* Q; const bf16_t* K; const bf16_t* V; bf16_t* O; };
struct Seam { bf16x8 qr[4]; bf16x8 st_v0, st_v1, st_k0, st_k1; };
#define ROW(p, k0, rr) ((p) + (size_t)((k0) + (rr)) * LD + sc)
#define VMW() asm volatile("s_waitcnt vmcnt(0)" ::: "memory")
#define VMWN(n) asm volatile("s_waitcnt vmcnt(%0)" :: "i"(n) : "memory")
#define SLOAD_H(Kp, Vp, k0) do { S.st_v0 = load8(ROW(Vp, k0, sr)); S.st_v1 = load8(ROW(Vp, k0, 32 + sr));              \
                         S.st_k0 = load8(ROW(Kp, k0, sr)); S.st_k1 = load8(ROW(Kp, k0, 32 + sr)); } while (0)
#define SWRITE_HK(bf) do { *(bf16x8*)(K_lds + (bf) * SHM_K + kws) = S.st_k0; *(bf16x8*)(K_lds + (bf) * SHM_K + kws + 32 * 256) = S.st_k1; } while (0)
#define SWRITE_HV(bf) do { *(bf16x8*)(V_lds + (bf) * SHM_V + vst0) = S.st_v0; *(bf16x8*)(V_lds + (bf) * SHM_V + vst1) = S.st_v1; } while (0)
#define SWRITE_H(bf) do { SWRITE_HV(bf); SWRITE_HK(bf); } while (0)
__device__ __forceinline__ void attn_prime(const Bufs& B, const BlockRef& cur, char* lds, Seam& S) {
    const int tid = threadIdx.x, wid = __builtin_amdgcn_readfirstlane(tid >> 6), lane = tid & 63, r32 = lane & 31, hi = lane >> 5, wq = wid & 3, mp = wid >> 2;
    const int sr = tid >> 4, sc = (tid & 15) * 8, kws = KSWZ(sr, sc * 2); char* K_lds = lds + 2 * SHM_V;
#pragma unroll
    for (int d0 = 0; d0 < 4; ++d0) S.qr[d0] = load8(B.Q + cur.qoff + (size_t)(wq * QBLK + r32) * LD + mp * 64 + d0 * 16 + hi * 8);
    SLOAD_H(B.K + cur.koff, B.V + cur.koff, 0); VMW(); SWRITE_HK(0);
    __syncthreads();
}
__device__ __forceinline__ void attn_block(const Bufs& B, const BlockRef& cur, const BlockRef& nxt, char* lds, LAS unsigned char* ldsl, Seam& S, float lam, const float* __restrict__ subln_g) {
    const int tid = threadIdx.x, wid = __builtin_amdgcn_readfirstlane(tid >> 6), lane = tid & 63, r32 = lane & 31, hi = lane >> 5, wq = wid & 3, mp = wid >> 2;
    const int NT = (cur.P0 + QB - 1) / KVBLK + 1;
    const int qlo = cur.P0 + wq * QBLK, qm = qlo + r32 - 4 * hi;
    char* V_lds = lds; char* K_lds = lds + 2 * SHM_V;
    float* ws = (float*)(lds + LDS_WS) + wid * 64; float* li_l = ws, * al_l = ws + 32;
    float m_reg = -1e30f, l_reg = 0; f32x16 o[4] = {};
    const int sr = tid >> 4, sc = (tid & 15) * 8, vst0 = v_st(sr, sc), vst1 = v_st(32 + sr, sc), kws = KSWZ(sr, sc * 2);
    const int vb0 = (int)(uintptr_t)V_lds + v_rd_base(lane);
    const bf16_t* Kh = B.K + cur.koff; const bf16_t* Vh = B.V + cur.koff;
    int kso0, vso0;
    { const int r0 = (wid * 2) * 4 + (lane >> 4); kso0 = r0 * LD + (((lane & 15) ^ (r0 & 7)) << 3);
      const int b0_ = (wid * 2) * 2 + (lane >> 5), kl = (lane & 31) >> 2, cl = (lane & 3) * 8;
      const int kk0 = (b0_ >> 2) * 8 + kl;
      const int k0_ = (kk0 & ~0xC) | ((kk0 & 4) << 1) | ((kk0 & 8) >> 1);
      vso0 = k0_ * LD + (b0_ & 3) * 32 + cl; }
#define DMA_K(bf, tile) do { const bf16_t* kp_ = Kh + (size_t)KBASE(tile) * LD;                                                                         \
        __builtin_amdgcn_global_load_lds((const unsigned*)(kp_ + kso0), (LAS unsigned*)(ldsl + 2 * SHM_V + (bf) * SHM_K + wid * 2048), 16, 0, 0);          \
        __builtin_amdgcn_global_load_lds((const unsigned*)(kp_ + ((kso0 ^ 32) + 4 * LD)), (LAS unsigned*)(ldsl + 2 * SHM_V + (bf) * SHM_K + wid * 2048 + 1024), 16, 0, 0); } while (0)
#define DMA_V(bf, tile) do { const bf16_t* vp_ = Vh + (size_t)KBASE(tile) * LD;                                                                         \
        __builtin_amdgcn_global_load_lds((const unsigned*)(vp_ + vso0), (LAS unsigned*)(ldsl + (bf) * SHM_V + wid * 2048), 16, 0, 0);                      \
        __builtin_amdgcn_global_load_lds((const unsigned*)(vp_ + vso0 + 64), (LAS unsigned*)(ldsl + (bf) * SHM_V + wid * 2048 + 1024), 16, 0, 0); } while (0)
#define RESC(a) do { if (__any((a) < 1.f)) { if (hi == 0) al_l[r32] = (a); asm volatile("s_waitcnt lgkmcnt(0)" ::: "memory");              \
                     for (int d_ = 0; d_ < 4; ++d_) for (int r = 0; r < 16; ++r) o[d_][r] *= al_l[crow(r, hi)]; } } while (0)
#define KBASE(t) ((t) * KVBLK)
#define MASKT(P0_, P1_, t) do { const int kb_ = KBASE(t); if (kb_ + KVBLK - 1 > qlo) mask_tile(P0_, P1_, qm - kb_); } while (0)
    constexpr int NQL = 4;
#define SEAM_K0() do { VMWN(NQL); SWRITE_HK(0); SBAR(); } while (0)
    f32x16 pA0, pA1, pB0, pB1; float mnA, mnB, alA, alB; bf16x8 pa0, pa1, pa2, pa3;
    SWRITE_HV(0); SBAR();
    if (NT > 1) { SLOAD_H(Kh, Vh, KBASE(1)); }
    SBAR(); qkt<0>(pA0, pA1, K_lds, r32, hi, mp, S.qr);
    if (mp == 0) { MASKT(pA0, pA1, 0); partialSM(pA0, pA1, m_reg, mnA, alA); }
    if (NT > 1) { VMW(); SWRITE_H(1); }
    __syncthreads();
#define HALF_STEP(PX0, PX1, mnX, alX, PY0, PY1, mnY, alY, t, KB, VB, SB) do {                                                 \
        SBAR();                                                                                                               \
        if ((t) + 1 < NT) DMA_K(SB, (t) + 1);                    \
        DMA_V(KB, (t));                                         \
          \
          \
        if (mp == 1) { MASKT(PY0, PY1, (t) - 1); partialSM(PY0, PY1, m_reg, mnY, alY); RESC(alY); }                            \
        SBAR(); qkt<KB>(PX0, PX1, K_lds, r32, hi, mp, S.qr);                                                                   \
        finishSM(PY0, PY1, alY, l_reg, pa0, pa1, pa2, pa3); SBAR();                                                           \
        pv_tile<VB>(o, vb0, pa0, pa1, pa2, pa3);                                                                               \
        if (mp == 0) { MASKT(PX0, PX1, (t)); partialSM(PX0, PX1, m_reg, mnX, alX); RESC(alX); }                               \
        VMW();                                                                    \
        __syncthreads(); } while (0)
    for (int t = 1; t + 1 < NT; t += 2) {
        HALF_STEP(pB0, pB1, mnB, alB, pA0, pA1, mnA, alA, t, 1, 0, 0);
        HALF_STEP(pA0, pA1, mnA, alA, pB0, pB1, mnB, alB, t + 1, 0, 1, 1);
    }
    const bool even = (NT & 1) == 0;
    if (mp == 1) { MASKT(pA0, pA1, even ? NT - 2 : NT - 1); partialSM(pA0, pA1, m_reg, mnA, alA); RESC(alA); }
    if (even) { DMA_V(1, NT - 1); SBAR(); qkt<1>(pB0, pB1, K_lds, r32, hi, mp, S.qr); SBAR(); }
    SLOAD_H(B.K + nxt.koff, B.V + nxt.koff, 0); SBAR();
#pragma unroll
    for (int d0 = 0; d0 < 4; ++d0) S.qr[d0] = load8(B.Q + nxt.qoff + (size_t)(wq * QBLK + r32) * LD + mp * 64 + d0 * 16 + hi * 8);
    SBAR();
    finishSM(pA0, pA1, alA, l_reg, pa0, pa1, pa2, pa3); SBAR();
    pv_tile<0>(o, vb0, pa0, pa1, pa2, pa3);
    if (even) { MASKT(pB0, pB1, NT - 1); partialSM(pB0, pB1, m_reg, mnB, alB); VMW(); __syncthreads(); RESC(alB);
        finishSM(pB0, pB1, alB, l_reg, pa0, pa1, pa2, pa3); SBAR(); pv_tile<1>(o, vb0, pa0, pa1, pa2, pa3); }
    SBAR(); SEAM_K0();
    int r32e = lane & 31, hie = lane >> 5; asm volatile("" : "+v"(r32e), "+v"(hie));
    if (hie == 0) li_l[r32e] = l_reg; asm volatile("s_waitcnt lgkmcnt(0)" ::: "memory");
    float* xch = (float*)(lds + LDS_XCH) + wq * 4096;
    if (mp == 1) {
#pragma unroll
        for (int r = 0; r < 16; ++r) { const int orow = crow(r, hie); const float rl = __builtin_amdgcn_rcpf(li_l[orow]);
#pragma unroll
            for (int d0 = 0; d0 < 4; ++d0) xch[orow * 128 + d0 * 32 + r32e] = o[d0][r] * rl; }
    }
    __syncthreads();
    if (mp == 0) {
        float gv[4];
#pragma unroll
        for (int d0 = 0; d0 < 4; ++d0) gv[d0] = subln_g[d0 * 32 + r32e] * (1.f - LAMBDA_INIT);
        int obase = cur.ooff + (wq * QBLK + 4 * hie) * LDO + r32e; asm volatile("" : "+v"(obase));
#pragma unroll
        for (int r = 0; r < 16; ++r) { const int orow = crow(r, hie), crel = (r & 3) + 8 * (r >> 2); float d[4]; float ss = 0.f; const float rl = __builtin_amdgcn_rcpf(li_l[orow]);
#pragma unroll
            for (int d0 = 0; d0 < 4; ++d0) { d[d0] = o[d0][r] * rl - lam * xch[orow * 128 + d0 * 32 + r32e]; ss += d[d0] * d[d0]; }
            ss += __shfl_xor(ss, 1); ss += __shfl_xor(ss, 2); ss += __shfl_xor(ss, 4); ss += __shfl_xor(ss, 8); ss += __shfl_xor(ss, 16);
            const float rs = rsqrtf(ss * (1.f / 128.f) + EPS);
#pragma unroll
            for (int d0 = 0; d0 < 4; ++d0) { const float v = d[d0] * rs * gv[d0]; const float vn = __shfl_xor(v, 1);
                if ((r32e & 1) == 0) __hip_atomic_store((unsigned*)(B.O + obase + crel * LDO + d0 * 32), cvtpk(v, vn), __ATOMIC_RELAXED, __HIP_MEMORY_SCOPE_AGENT); } }
    }
    __syncthreads();
#undef RESC
#undef DMA_K
#undef DMA_V
#undef KBASE
#undef MASKT
#undef SEAM_K0
#undef HALF_STEP
}
#undef ROW
#undef VMW
#undef VMWN
#undef SLOAD_H
#undef SWRITE_HK
#undef SWRITE_HV
#undef SWRITE_H
#undef KSWZ
#undef SBAR
}

DEV void p3_attn_conv(Frame& F, const Args& a, char* lds_generic) {
    const att::Bufs B{(const bf16_t*)(F.ws + WS_Q), (const bf16_t*)(F.ws + WS_K), (const bf16_t*)(F.ws + WS_V), (bf16_t*)(F.ws + WS_ATT)};
    float lam;
    { const float* q1 = (const float*)a.in[7]; const float* k1 = (const float*)a.in[8]; const float* q2 = (const float*)a.in[9]; const float* k2 = (const float*)a.in[10];
      const float s1 = wave_sum(q1[F.lane] * k1[F.lane]), s2 = wave_sum(q2[F.lane] * k2[F.lane]);
      lam = __uint_as_float(__builtin_amdgcn_readfirstlane(__float_as_uint(expf(s1) - expf(s2) + LAMBDA_INIT))); }
    const float* subln_g = (const float*)a.in[11];
    for (int L = F.vcu; L < 256; L += F.G) {
        const int bh = L >> 4, y = L & 15, b = bh >> 2, h = bh & 3;
        const int hb = b * SEQ * att::LD + h * 128;
        const int ob = b * SEQ * att::LDO + h * 128;
        const att::BlockRef b0{hb + y * att::QB * att::LD, hb, y * att::QB, ob + y * att::QB * att::LDO}, b1{hb + (att::NQB - 1 - y) * att::QB * att::LD, hb, (att::NQB - 1 - y) * att::QB, ob + (att::NQB - 1 - y) * att::QB * att::LDO};
        att::Seam S;
        att::attn_prime(B, b0, lds_generic, S);
        att::attn_block(B, b0, b1, lds_generic, F.lds, S, lam, subln_g);
        att::attn_block(B, b1, b1, lds_generic, F.lds, S, lam, subln_g);
    }
    int ctid = threadIdx.x; asm volatile("" : "+v"(ctid));
    const bf16_t* CB = (const bf16_t*)(F.ws + WS_CB); const bf16_t* CCU = (const bf16_t*)(F.ws + WS_CCU); bf16_t* CONV = (bf16_t*)(F.ws + WS_ATT);
    const float* cw = (const float*)a.in[12]; (void)CONV;
    const __amdgpu_buffer_rsrc_t crsrc = __builtin_amdgcn_make_buffer_rsrc((void*)(F.ws + WS_ATT), 0, 32 * 1024 * 1024, 0x00020000);
    const int gt = F.vcu * NTHR + ctid, NGT = F.G * NTHR;
    const int chc = (gt & 63) * 8;
    float cwv[3][8];
#pragma unroll
    for (int j = 0; j < 3; ++j)
#pragma unroll
        for (int i = 0; i < 8; ++i) cwv[j][i] = cw[j * 512 + chc + i];
    for (int idx0 = gt; idx0 < M * 64; idx0 += 4 * NGT) {
        v4u cbv[4], u0[4], u1[4], u2[4];
#pragma unroll
        for (int p = 0; p < 4; ++p) { const int idx = idx0 + p * NGT; const int row = idx >> 6, t = row & (SEQ - 1);
            const size_t off = (size_t)row * 512 + chc;
            cbv[p] = __builtin_nontemporal_load((const v4u*)(CB + off)); u0[p] = *(const v4u*)(CCU + off);
            u1[p] = (v4u){0u, 0u, 0u, 0u}; u2[p] = (v4u){0u, 0u, 0u, 0u};
            if (t >= 1) u1[p] = *(const v4u*)(CCU + off - 512);
            if (t >= 2) u2[p] = *(const v4u*)(CCU + off - 1024); }
#pragma unroll
        for (int p = 0; p < 4; ++p) { const int idx = idx0 + p * NGT; const int row = idx >> 6;
            v4u o;
#pragma unroll
            for (int i = 0; i < 4; ++i) {
                const float y0 = cwv[0][2 * i] * __uint_as_float(u0[p][i] << 16) + cwv[1][2 * i] * __uint_as_float(u1[p][i] << 16) + cwv[2][2 * i] * __uint_as_float(u2[p][i] << 16);
                const float y1 = cwv[0][2 * i + 1] * __uint_as_float(u0[p][i] & 0xffff0000u) + cwv[1][2 * i + 1] * __uint_as_float(u1[p][i] & 0xffff0000u) + cwv[2][2 * i + 1] * __uint_as_float(u2[p][i] & 0xffff0000u);
                o[i] = pk2(__uint_as_float(cbv[p][i] << 16) * y0, __uint_as_float(cbv[p][i] & 0xffff0000u) * y1);
            }
            __builtin_amdgcn_raw_buffer_store_b128(o, crsrc, (row * 1024 + 512 + chc) * 2, 0, 16  ); }
    }
}

constexpr size_t WS_X1B = 72 * MiB;
constexpr size_t WS_ELT = 250 * MiB;
constexpr size_t WS_ELW = 252 * MiB;
constexpr size_t WS_TOKP = 254 * MiB;
constexpr size_t WS_ACT = 104 * MiB;
constexpr size_t WS_Y = 168 * MiB;
constexpr int CW_CNT = 32768;
constexpr int CW_DONE = 40960;
constexpr int CW_PC4 = 50176, CW_PC5 = 51200;
constexpr int CW_WDC = 49152;
constexpr int LDS_TAB = 131072;

DEV void p6_route(Frame& F, const Args& a, const bool wait5) {
    typedef float f32x4v __attribute__((ext_vector_type(4)));
    const bf16_t* X1 = (const bf16_t*)(F.ws + WS_X1B); const float* SSQ = (const float*)(F.ws + WS_SSQ); const float* MOD = (const float*)(F.ws + WS_MOD);
    const float* gN = (const float*)a.in[16]; const float* bg = (const float*)a.in[18]; const float* be = (const float*)a.in[20];
    const bf16_t* RH = (const bf16_t*)(F.ws + WS_WT_R); const bf16_t* RL = RH + 48 * DM;
    const __amdgpu_buffer_rsrc_t hrsrc = __builtin_amdgcn_make_buffer_rsrc((void*)(F.ws + WS_H2), 0, 32 * 1024 * 1024, 0x00020000);
    int* ELT = (int*)(F.ws + WS_ELT); float* ELW = (float*)(F.ws + WS_ELW); int* TOKP = (int*)(F.ws + WS_TOKP);
    LAS float* GS = (LAS float*)F.lds; LAS float* SH = GS + DM; LAS float* PL = SH + DM;
    LAS float* LG = PL + 8 * 64 * 48;
    LAS int* lcnt = (LAS int*)(LG + 64 * 48); LAS int* gbase = lcnt + 32;
    const int r = F.lane & 15, q = F.lane >> 4, w = F.wave;
    for (int ch = F.vcu; ch < M / 64; ch += F.G) {
        const int R0 = ch * 64, b = R0 / SEQ; const float* md = MOD + b * 6144;
        for (int k = F.tid; k < DM; k += NTHR) { GS[k] = gN[k] * (1.f + md[4096 + k]); SH[k] = md[3072 + k]; }
        if (F.tid < 32) lcnt[F.tid] = 0;
        if (wait5 && F.tid == 64) {
            unsigned sp = 0; while (__hip_atomic_load(F.ctl + CW_PC5 + (ch >> 2) * 16, __ATOMIC_RELAXED, __HIP_MEMORY_SCOPE_AGENT) < (unsigned)(DM / pg8::BM)) { __builtin_amdgcn_s_sleep(2); if (++sp > (1u << 22)) break; }
            __builtin_amdgcn_fence(__ATOMIC_ACQUIRE, "agent"); asm volatile("s_waitcnt vmcnt(0)" ::: "memory"); }
        __syncthreads();
        float rstd[4];
#pragma unroll
        for (int rg = 0; rg < 4; ++rg) { const f32x4v* sp = (const f32x4v*)(SSQ + (size_t)(R0 + rg * 16 + r) * 16); const f32x4v s0 = sp[0], s1 = sp[1], s2 = sp[2], s3 = sp[3];
            const float ss = ((s0[0] + s0[1]) + (s0[2] + s0[3])) + ((s1[0] + s1[1]) + (s1[2] + s1[3])) + ((s2[0] + s2[1]) + (s2[2] + s2[3])) + ((s3[0] + s3[1]) + (s3[2] + s3[3]));
            rstd[rg] = rsqrtf(ss * (1.f / DM) + EPS); }
        pg8::f32x4 acc[4][3];
#pragma unroll
        for (int rg = 0; rg < 4; ++rg)
#pragma unroll
            for (int n = 0; n < 3; ++n) acc[rg][n] = (pg8::f32x4){0.f, 0.f, 0.f, 0.f};
#pragma unroll
        for (int s = 0; s < 4; ++s) {
            const int k0 = w * 128 + s * 32 + 8 * q;
            bf16x8 bh[3], bl[3];
#pragma unroll
            for (int n = 0; n < 3; ++n) { bh[n] = *(const bf16x8*)(RH + (size_t)(n * 16 + r) * DM + k0); bl[n] = *(const bf16x8*)(RL + (size_t)(n * 16 + r) * DM + k0); }
            v4u xq[4];
#pragma unroll
            for (int rg = 0; rg < 4; ++rg) xq[rg] = *(const v4u*)(X1 + (size_t)(R0 + rg * 16 + r) * DM + k0);
            const f32x4v ga = *(const LAS f32x4v*)(GS + k0), gb = *(const LAS f32x4v*)(GS + k0 + 4), sa = *(const LAS f32x4v*)(SH + k0), sb = *(const LAS f32x4v*)(SH + k0 + 4);
#pragma unroll
            for (int rg = 0; rg < 4; ++rg) {
                const v4u xr_ = xq[rg];
                const f32x4v xa = {__uint_as_float(xr_.x << 16), __uint_as_float(xr_.x & 0xffff0000u), __uint_as_float(xr_.y << 16), __uint_as_float(xr_.y & 0xffff0000u)}, xb = {__uint_as_float(xr_.z << 16), __uint_as_float(xr_.z & 0xffff0000u), __uint_as_float(xr_.w << 16), __uint_as_float(xr_.w & 0xffff0000u)};
                const f32x4v ha = xa * rstd[rg] * ga + sa, hb = xb * rstd[rg] * gb + sb;
                v4u hi, lo;
                hi.x = pg8::cvt_pk_bf16(ha[0], ha[1]); hi.y = pg8::cvt_pk_bf16(ha[2], ha[3]); hi.z = pg8::cvt_pk_bf16(hb[0], hb[1]); hi.w = pg8::cvt_pk_bf16(hb[2], hb[3]);
                lo.x = pg8::cvt_pk_bf16(ha[0] - __uint_as_float(hi.x << 16), ha[1] - __uint_as_float(hi.x & 0xffff0000u)); lo.y = pg8::cvt_pk_bf16(ha[2] - __uint_as_float(hi.y << 16), ha[3] - __uint_as_float(hi.y & 0xffff0000u));
                lo.z = pg8::cvt_pk_bf16(hb[0] - __uint_as_float(hi.z << 16), hb[1] - __uint_as_float(hi.z & 0xffff0000u)); lo.w = pg8::cvt_pk_bf16(hb[2] - __uint_as_float(hi.w << 16), hb[3] - __uint_as_float(hi.w & 0xffff0000u));
                __builtin_amdgcn_raw_buffer_store_b128(hi, hrsrc, ((R0 + rg * 16 + r) * DM + k0) * 2, 0, 16  );
                const bf16x8 ahi = __builtin_bit_cast(bf16x8, hi), alo = __builtin_bit_cast(bf16x8, lo);
#pragma unroll
                for (int n = 0; n < 3; ++n) {
                    acc[rg][n] = __builtin_amdgcn_mfma_f32_16x16x32_bf16(ahi, bh[n], acc[rg][n], 0, 0, 0);
                    acc[rg][n] = __builtin_amdgcn_mfma_f32_16x16x32_bf16(ahi, bl[n], acc[rg][n], 0, 0, 0);
                    acc[rg][n] = __builtin_amdgcn_mfma_f32_16x16x32_bf16(alo, bh[n], acc[rg][n], 0, 0, 0);
                }
            }
        }
#pragma unroll
        for (int rg = 0; rg < 4; ++rg)
#pragma unroll
            for (int n = 0; n < 3; ++n)
#pragma unroll
                for (int j = 0; j < 4; ++j) PL[(w * 64 + rg * 16 + 4 * q + j) * 48 + n * 16 + r] = acc[rg][n][j];
        __syncthreads();
        for (int i = F.tid; i < 64 * 48; i += NTHR) { float sacc = 0.f;
#pragma unroll
            for (int ww = 0; ww < 8; ++ww) sacc += PL[ww * 64 * 48 + i];
            LG[i] = sacc; }
        __syncthreads();
        int e0 = 0, e1 = 0, p0 = 0, p1 = 0; float w0 = 0.f, w1 = 0.f;
        if (F.tid < 64) {
            const LAS float* l0 = LG + (size_t)F.tid * 48;
            int gi = 0; float gmax = l0[0] + bg[0];
            for (int i = 1; i < 4; ++i) { const float v = l0[i] + bg[i]; if (v > gmax) { gmax = v; gi = i; } }
            float se = 0.f; for (int i = 0; i < 4; ++i) se += expf(l0[i] + bg[i] - gmax);
            const float gw = 1.f / se;
            int i0 = 0; float m0 = -1e30f; int i1 = 0; float m1 = -1e30f;
            for (int i = 0; i < 8; ++i) { const float v = l0[4 + gi * 8 + i] + be[gi * 8 + i];
                if (v > m0) { m1 = m0; i1 = i0; m0 = v; i0 = i; } else if (v > m1) { m1 = v; i1 = i; } }
            const float ex = expf(m1 - m0); w0 = gw / (1.f + ex); w1 = gw * ex / (1.f + ex);
            e0 = gi * 8 + i0; e1 = gi * 8 + i1;
            p0 = atomicAdd((int*)(lcnt + e0), 1); p1 = atomicAdd((int*)(lcnt + e1), 1);
        }
        __syncthreads();
        if (F.tid < 32) { const int c = lcnt[F.tid]; gbase[F.tid] = c ? (int)atomicAdd(F.ctl + CW_CNT + F.tid * 64, (unsigned)c) : 0; }
        __syncthreads();
        if (F.tid < 64) { const int tok = R0 + F.tid; const int g0 = gbase[e0] + p0, g1 = gbase[e1] + p1;
            __hip_atomic_store(ELT + e0 * M + g0, tok, __ATOMIC_RELAXED, __HIP_MEMORY_SCOPE_AGENT); __hip_atomic_store(ELW + e0 * M + g0, w0, __ATOMIC_RELAXED, __HIP_MEMORY_SCOPE_AGENT);
            __hip_atomic_store(ELT + e1 * M + g1, tok, __ATOMIC_RELAXED, __HIP_MEMORY_SCOPE_AGENT); __hip_atomic_store(ELW + e1 * M + g1, w1, __ATOMIC_RELAXED, __HIP_MEMORY_SCOPE_AGENT);
            __hip_atomic_store((unsigned long long*)(TOKP + tok * 2), (unsigned long long)(unsigned)(e0 * M + g0) | ((unsigned long long)(unsigned)(e1 * M + g1) << 32), __ATOMIC_RELAXED, __HIP_MEMORY_SCOPE_AGENT); }
        __syncthreads();
    }
}
DEV pg8::MoeTiles moe_build_tiles(Frame& F) {
    pg8::MoeTiles mt; mt.te = (LAS int*)(F.lds + LDS_TAB); mt.tm = mt.te + 192; mt.tv = mt.tm + 192; LAS int* Tp = mt.tv + 192; LAS int* BASE = Tp + 4;
    LAS int* cntl = BASE + 32;
    if (F.tid < NE) cntl[F.tid] = (int)__hip_atomic_load(F.ctl + CW_CNT + F.tid * 64, __ATOMIC_RELAXED, __HIP_MEMORY_SCOPE_AGENT);
    __syncthreads();
    if (F.tid == 0) { int T = 0;
        for (int e = 0; e < NE; ++e) { const int c = cntl[e]; BASE[e] = T * 256;
            for (int m = 0; m * 256 < c; ++m) { mt.te[T] = e; mt.tm[T] = m; mt.tv[T] = (c - m * 256) < 256 ? (c - m * 256) : 256; ++T; } }
        Tp[0] = T; }
    __syncthreads();
    mt.T = Tp[0];
    return mt;
}
DEV pg8::MoeTiles moe_tiles_view(Frame& F) {
    pg8::MoeTiles mt; mt.te = (LAS int*)(F.lds + LDS_TAB); mt.tm = mt.te + 192; mt.tv = mt.tm + 192; mt.T = (mt.tv + 192)[0]; return mt;
}
DEV void p9_final(Frame& F, const Args& a) {
    const LAS int* BASE = (const LAS int*)(F.lds + LDS_TAB) + 3 * 192 + 4;
    const float* MOD = (const float*)(F.ws + WS_MOD); const float* fg = (const float*)a.in[24]; const int* TOKP = (const int*)(F.ws + WS_TOKP); const bf16_t* Y = (const bf16_t*)(F.ws + WS_Y); const bf16_t* X1 = (const bf16_t*)(F.ws + WS_X1B);
    const int gw = F.vcu * NWAVES + F.wave, NGW = F.G * NWAVES;
    f32x4 fgv[4];
#pragma unroll
    for (int j = 0; j < 4; ++j) fgv[j] = *(const f32x4*)(fg + 4 * F.lane + 256 * j);
    for (int mb = gw; mb < M; mb += 32 * NGW) {
    int slotv = 0;
    { const int row = mb + (F.lane >> 1) * NGW; if (row < M) { const int t = TOKP[row * 2 + (F.lane & 1)]; slotv = BASE[t / M] + (t % M); } }
    for (int m0 = mb, itl = 0; m0 < M && itl < 16; m0 += 2 * NGW, ++itl) {
        int mm[2] = {m0, m0 + NGW}; int sl[2][2];
#pragma unroll
        for (int p = 0; p < 2; ++p) { sl[p][0] = __shfl(slotv, itl * 4 + p * 2); sl[p][1] = __shfl(slotv, itl * 4 + p * 2 + 1); }
        unsigned long long xq[2][4], ya[2][4], yb[2][4];
#pragma unroll
        for (int p = 0; p < 2; ++p) {
            const GAS unsigned long long* xr = (const GAS unsigned long long*)(X1 + (size_t)mm[p] * DM) + F.lane;
            const GAS unsigned long long* y0 = (const GAS unsigned long long*)(Y + (size_t)sl[p][0] * DM) + F.lane; const GAS unsigned long long* y1 = (const GAS unsigned long long*)(Y + (size_t)sl[p][1] * DM) + F.lane;
#pragma unroll
            for (int j = 0; j < 4; ++j) { xq[p][j] = __builtin_nontemporal_load(xr + 64 * j); ya[p][j] = __builtin_nontemporal_load(y0 + 64 * j); yb[p][j] = __builtin_nontemporal_load(y1 + 64 * j); }
        }
#pragma unroll
        for (int p = 0; p < 2; ++p) {
            const float* gf = MOD + (mm[p] / SEQ) * 6144 + 5120; float s = 0.f; f32x4 v[4];
#pragma unroll
            for (int j = 0; j < 4; ++j) { const int k = 4 * F.lane + 256 * j; const unsigned long long a0 = ya[p][j], a1 = yb[p][j]; const f32x4 g4 = *(const f32x4*)(gf + k);
                f32x4 yy; yy.x = __uint_as_float((unsigned)a0 << 16) + __uint_as_float((unsigned)a1 << 16); yy.y = __uint_as_float((unsigned)a0 & 0xffff0000u) + __uint_as_float((unsigned)a1 & 0xffff0000u);
                yy.z = __uint_as_float((unsigned)(a0 >> 32) << 16) + __uint_as_float((unsigned)(a1 >> 32) << 16); yy.w = __uint_as_float((unsigned)(a0 >> 32) & 0xffff0000u) + __uint_as_float((unsigned)(a1 >> 32) & 0xffff0000u);
                const unsigned long long xx = xq[p][j]; f32x4 x4; x4.x = __uint_as_float((unsigned)xx << 16); x4.y = __uint_as_float((unsigned)xx & 0xffff0000u); x4.z = __uint_as_float((unsigned)(xx >> 32) << 16); x4.w = __uint_as_float((unsigned)(xx >> 32) & 0xffff0000u);
                v[j] = x4 + g4 * yy; s += (v[j].x * v[j].x + v[j].y * v[j].y) + (v[j].z * v[j].z + v[j].w * v[j].w); }
            const float rstd = rsqrtf(wave_sum(s) * (1.f / DM) + EPS);
            GAS f32x4* xw = (GAS f32x4*)(F.out + (size_t)mm[p] * DM) + F.lane;
#pragma unroll
            for (int j = 0; j < 4; ++j) __builtin_nontemporal_store(v[j] * rstd * fgv[j], xw + 64 * j);
        }
    }
    }
}

__global__ void __launch_bounds__(NTHR, 2) mk(Args args) {
    __shared__ __attribute__((aligned(16))) unsigned char lds_raw[LDS_BYTES];
    Frame F;
    F.lds = (LAS unsigned char*)lds_raw; F.MISC = (volatile LAS unsigned*)(F.lds + MISC_OFF);
    F.tid = threadIdx.x; F.lane = F.tid & 63; F.wave = __builtin_amdgcn_readfirstlane(F.tid >> 6);
    F.G = gridDim.x; { const int bx = blockIdx.x; F.vcu = (F.G % 8 == 0) ? (bx % 8) * (F.G / 8) + bx / 8 : bx; }
    F.ws = args.ws; F.out = args.out; F.ctl = (unsigned*)(args.ws + WS_CTL);
    for (int u = F.tid; u < (LDS_BYTES - LDSCTL_OFF) / 4; u += NTHR) ((LAS unsigned*)(F.lds + LDSCTL_OFF))[u] = 0u;
    __syncthreads();
    XcdBarrier bar = xcd_barrier_post(F.ctl + CW_BAR + args.li * XCD_BAR_WORDS, F.MISC + 8);
    const int lo = args.ph_lo, hi = args.ph_hi;
#define REFRESH() do { int t_ = threadIdx.x; asm volatile("" : "+v"(t_)); F.tid = t_; F.lane = t_ & 63; F.wave = __builtin_amdgcn_readfirstlane(t_ >> 6); } while (0)
#define IN(k) (lo <= (k) && (k) < hi)
#define BOTH(k) (IN(k) && IN((k) + 1))
    if (IN(0)) { REFRESH(); p0_prologue(F, args); }
    if (IN(1)) { REFRESH(); p1_h(F, args); }
    if (IN(2)) { REFRESH();
        pg8::Gemm g{(const bf16_t*)(F.ws + WS_H), (const bf16_t*)(F.ws + WS_WT_IN), M, INW, DM}; pg8::StaticOrder S; S.init(M, INW, F.G, (int)blockIdx.x);
        pg8::EpiIn E{(bf16_t*)(F.ws + WS_Q), (bf16_t*)(F.ws + WS_K), (bf16_t*)(F.ws + WS_V), (bf16_t*)(F.ws + WS_CB), (bf16_t*)(F.ws + WS_CCU), (bf16_t*)(F.ws + WS_GA), (bf16_t*)(F.ws + WS_GC), (const float*)(F.ws + WS_ROPE), __builtin_amdgcn_make_buffer_rsrc((void*)(F.ws + WS_Q), 0, 144 * 1024 * 1024, 0x00020000)};
        if (IN(1)) {
            if (F.wave == 0) {
                const unsigned* pa = F.ctl + CW_P0C; unsigned need = (unsigned)F.G; bool act = F.lane == 0;
                if (F.lane >= 1 && F.lane < 32) { pg8::Unit u; if (S.next(F.lane - 1, u)) { pa = F.ctl + CW_PC1 + u.pm * 16; need = 4u; act = true; } }
                unsigned sp = 0;
                for (;;) { const unsigned v = act ? __hip_atomic_load(pa, __ATOMIC_RELAXED, __HIP_MEMORY_SCOPE_AGENT) : need; if (__all(v >= need)) break; __builtin_amdgcn_s_sleep(2); if (++sp > (1u << 22)) break; } }
            __syncthreads(); }
        pg8::gemm_phase<pg8::EpiIn, pg8::StaticOrder, true, true>(F.lds, g, S, E);
        if (BOTH(2)) xcd_barrier(bar);
    }
    if (IN(3)) { REFRESH(); p3_attn_conv(F, args, (char*)lds_raw); if (BOTH(3)) xcd_barrier(bar); }
    if (IN(4)) { REFRESH();
        pg8::StaticOrder S; S.init(M, DM, F.G, (int)blockIdx.x);
        pg8::Gemm g{(const bf16_t*)(F.ws + WS_ATT), (const bf16_t*)(F.ws + WS_WT_A), M, DM, DM};
        pg8::EpiG E{(const bf16_t*)(F.ws + WS_GA), (const bf16_t*)(F.ws + WS_GC), (bf16_t*)(F.ws + WS_MERGED), __builtin_amdgcn_make_buffer_rsrc((void*)(F.ws + WS_MERGED), 0, M * DM * 2, 0x00020000)};
        pg8::gemm_phase<pg8::EpiG, pg8::StaticOrder, false, true>(F.lds, g, S, E);
        if (BOTH(4) && F.tid == 0) { pg8::Unit u; if (S.next(0, u)) __hip_atomic_fetch_add(F.ctl + CW_PC4 + u.pm * 16, 1u, __ATOMIC_RELAXED, __HIP_MEMORY_SCOPE_AGENT); }
    }
    if (IN(5)) { REFRESH();
        pg8::StaticOrder S; S.init(M, DM, F.G, (int)blockIdx.x);
        pg8::Gemm g{(const bf16_t*)(F.ws + WS_MERGED), (const bf16_t*)(F.ws + WS_WT_O), M, DM, DM};
        pg8::EpiX1 E{(const float*)args.in[0], (const float*)(F.ws + WS_MOD) + 2048, (bf16_t*)(F.ws + WS_X1B), (float*)(F.ws + WS_SSQ), __builtin_amdgcn_make_buffer_rsrc((void*)(F.ws + WS_X1B), 0, M * DM * 2, 0x00020000)};
        if (IN(4)) {
            if (F.tid == 0) { pg8::Unit u; if (S.next(0, u)) { unsigned sp = 0; while (__hip_atomic_load(F.ctl + CW_PC4 + u.pm * 16, __ATOMIC_RELAXED, __HIP_MEMORY_SCOPE_AGENT) < (unsigned)(DM / pg8::BM)) { __builtin_amdgcn_s_sleep(2); if (++sp > (1u << 22)) break; } } }
            __syncthreads(); }
        pg8::gemm_phase<pg8::EpiX1, pg8::StaticOrder, false, true>(F.lds, g, S, E);
        if (BOTH(5) && F.tid == 0) { pg8::Unit u; if (S.next(0, u)) __hip_atomic_fetch_add(F.ctl + CW_PC5 + u.pm * 16, 1u, __ATOMIC_RELAXED, __HIP_MEMORY_SCOPE_AGENT); }
    }
    if (IN(6)) { REFRESH(); p6_route(F, args, IN(5)); if (BOTH(6)) xcd_barrier(bar); }
    if (IN(7)) { REFRESH();
        { const pg8::MoeTiles mt = moe_build_tiles(F);
          volatile LAS unsigned* lflag = (volatile LAS unsigned*)(F.lds + LDSCTL_OFF + 512);
          if (F.tid == 0) *lflag = 0u;
          __syncthreads();
          const int nbusy = 2 * mt.T - F.G;
          const int first = nbusy > 0 ? (nbusy < F.G - 32 ? nbusy : 0) : 0;
          if (F.vcu >= first) p7_wdown_transposes(F, args, F.vcu - first, F.G - first, F.ctl + CW_WDC); }
        { REFRESH(); const pg8::MoeTiles mt = moe_tiles_view(F);
          pg8::Gemm g{(const bf16_t*)(F.ws + WS_H2), (const bf16_t*)(F.ws + WS_WT_GU), 0, 0, DM};
          pg8::SchedMoeA S{mt, (const int*)(F.ws + WS_ELT), (const float*)(F.ws + WS_ELW), F.vcu, F.G, F.ctl + CW_DONE};
          pg8::EpiAct E{(bf16_t*)(F.ws + WS_ACT), __builtin_amdgcn_make_buffer_rsrc((void*)(F.ws + WS_ACT), 0, 40960 * 256 * 2, 0x00020000)};
          pg8::gemm_phase_x<pg8::EpiAct, pg8::SchedMoeA, true, 1>(F.lds, g, S, E); }
        { REFRESH(); const pg8::MoeTiles mt = moe_tiles_view(F);
          const int nbusy = 2 * mt.T - F.G; const int first = nbusy > 0 ? (nbusy < F.G - 32 ? nbusy : 0) : 0;
          pg8::Gemm g{(const bf16_t*)(F.ws + WS_ACT), (const bf16_t*)(F.ws + WS_WT_D), 0, 0, FF};
          pg8::SchedMoeB S{mt, F.vcu, F.G, F.ctl + CW_DONE};
          pg8::EpiY E{(bf16_t*)(F.ws + WS_Y), __builtin_amdgcn_make_buffer_rsrc((void*)(F.ws + WS_Y), 0, 40960 * 1024 * 2, 0x00020000)};
          pg8::gemm_phase_x<pg8::EpiY, pg8::SchedMoeB, false, 2>(F.lds, g, S, E, (volatile LAS unsigned*)(F.lds + LDSCTL_OFF + 512), F.ctl + CW_WDC, (unsigned)(F.G - first)); }
        if (BOTH(7)) xcd_barrier(bar);
    }
    if (IN(9)) { REFRESH(); if (!IN(7)) (void)moe_build_tiles(F); p9_final(F, args); }
#undef IN
#undef BOTH
}


static int g_grid = 0;
static void mk_launch(const Args& base, int lo, int hi, int li, hipStream_t stream) {
    Args a = base; a.ph_lo = lo; a.ph_hi = hi; a.li = li; a.pad = 0;
    hipLaunchKernelGGL(mk, dim3(g_grid), dim3(NTHR), 0, stream, a);
}

extern "C" void kernel_launch(void* const* d_in, const int* in_sizes, int n_in, void* d_out, int out_size, void* d_ws, size_t ws_size, hipStream_t stream) {
    (void)in_sizes; (void)n_in; (void)out_size; (void)ws_size;
    if (g_grid == 0) {
        int dev = 0, cus = 0; (void)hipGetDevice(&dev); (void)hipDeviceGetAttribute(&cus, hipDeviceAttributeMultiprocessorCount, dev);
        g_grid = cus > 0 ? cus : 256;
    }
    (void)hipMemsetAsync((char*)d_ws + WS_CTL, 0, CTL_ZERO_BYTES, stream);
    Args base{}; for (int i = 0; i < 25; ++i) base.in[i] = d_in[i]; base.out = (float*)d_out; base.ws = (unsigned char*)d_ws;
    mk_launch(base, 0, 10, 0, stream);
}
```

```cpp
#include <hip/hip_runtime.h>
#include <stdint.h>

typedef unsigned short bf16_t;
#define DEV __device__ __forceinline__

constexpr int BATCH = 4, SEQ = 4096, DM = 1024, M = BATCH * SEQ;
constexpr int NH = 4, HD = 64, VD = 128, QKW = 512, VW = 512, CW = 512, INW = 5120;
constexpr int NG = 4, EPG = 8, NE = 32, FF = 256;
constexpr float EPS = 1e-6f;
constexpr float LAMBDA_INIT = 0.2f;

constexpr size_t MiB = 1u << 20;
constexpr size_t WS_CTL = 0;
constexpr size_t WS_MOD = 1 * MiB;
constexpr size_t WS_LAM = 1 * MiB + 128 * 1024;
constexpr size_t WS_ROPE = 2 * MiB;
constexpr size_t WS_TOKE = 6 * MiB;
constexpr size_t WS_TOKW = 6 * MiB + 256 * 1024;
constexpr size_t WS_WEIGHTS = 8 * MiB;
constexpr size_t WS_H = 72 * MiB;
constexpr size_t WS_ATT = 72 * MiB, WS_CONV = 88 * MiB;
constexpr size_t WS_Q = 104 * MiB, WS_K = 120 * MiB, WS_V = 136 * MiB, WS_CB = 152 * MiB, WS_CCU = 168 * MiB;
constexpr size_t WS_GA = 184 * MiB, WS_GC = 216 * MiB;
constexpr size_t WS_MERGED = 104 * MiB;
constexpr size_t WS_H2 = 136 * MiB;
constexpr size_t WS_SSQ = 248 * MiB;

DEV float bf2f(bf16_t v) { return __uint_as_float(((unsigned)v) << 16); }
DEV bf16_t f2bf(float f) { unsigned u = __float_as_uint(f); u += 0x7fffu + ((u >> 16) & 1u); return (bf16_t)(u >> 16); }

#define GAS __attribute__((address_space(1)))
#define LAS __attribute__((address_space(3)))
typedef unsigned v4u __attribute__((ext_vector_type(4)));
typedef float f32x4 __attribute__((ext_vector_type(4)));
typedef short bf16x8 __attribute__((ext_vector_type(8)));
#define LDS_WAIT() asm volatile("s_waitcnt lgkmcnt(0)" ::: "memory")
#define VM_WAIT() asm volatile("s_waitcnt vmcnt(0)" ::: "memory")
typedef float f32x2p_t __attribute__((ext_vector_type(2))); typedef __bf16 bf16x2p_t __attribute__((ext_vector_type(2)));
DEV unsigned pk2(float lo, float hi) { f32x2p_t v = {lo, hi}; bf16x2p_t b = __builtin_convertvector(v, bf16x2p_t); return __builtin_bit_cast(unsigned, b); }

constexpr int NWAVES = 8, NTHR = 512;
constexpr int RING_BYTES = 131072;
constexpr int LDSCTL_OFF = 139264, MISC_OFF = LDSCTL_OFF + 320;
constexpr int LDS_BYTES = 147456;
constexpr size_t CTL_ZERO_BYTES = 1 * MiB;
constexpr int CW_P0C = 24640, CW_PC1 = 25600;
constexpr int CW_MODC = 24576;
constexpr int CW_BAR = 4096;
constexpr size_t WS_WT_IN = WS_WEIGHTS;
constexpr size_t WS_WT_A = WS_WEIGHTS + 10 * MiB;
constexpr size_t WS_WT_C = WS_WEIGHTS + 11 * MiB;
constexpr size_t WS_WT_O = WS_WEIGHTS + 12 * MiB;
constexpr size_t WS_WT_GU = WS_WEIGHTS + 14 * MiB;
constexpr size_t WS_WT_D = WS_WEIGHTS + 46 * MiB;
constexpr size_t WS_WT_R = WS_WEIGHTS + 62 * MiB;

#define XB_TMO      128
#define XB_XCNT(j)  (256  + 64 * (j))
#define XB_XSUB(j)  (1280 + 64 * (j))
#define XB_XGEN(j)  (2304 + 64 * (j))
#define XB_TOP      3328
#define XB_TOPGEN   3392
#define XCD_BAR_WORDS 3456
#define XB_SPIN_CAP (1u << 18)
DEV unsigned xb_ld(unsigned* p)              { return __hip_atomic_load(p, __ATOMIC_RELAXED, __HIP_MEMORY_SCOPE_AGENT); }
DEV unsigned xb_add(unsigned* p, unsigned v) { return __hip_atomic_fetch_add(p, v, __ATOMIC_RELAXED, __HIP_MEMORY_SCOPE_AGENT); }
DEV unsigned xb_xcc_id() { return (unsigned)__builtin_amdgcn_s_getreg((3 << 11) | 20) & 0xFu; }
#define XB_SPIN(cond, bar) do { unsigned _sp = 0; while (cond) { __builtin_amdgcn_s_sleep(1); \
    if ((++_sp & 255u) == 0u) { if (xb_ld(&(bar)[XB_TMO])) break; if (_sp > XB_SPIN_CAP) { atomicAdd(&(bar)[XB_TMO], 1u); break; } } } } while (0)
struct XcdBarrier { unsigned* bar; unsigned x; volatile LAS unsigned* st; };
DEV XcdBarrier xcd_barrier_post(unsigned* bar, volatile LAS unsigned* st) {
    XcdBarrier b; b.bar = bar; b.x = xb_xcc_id(); b.st = st;
    if (threadIdx.x == 0) (void)xb_add(&bar[XB_XCNT(b.x)], 1u);
    return b;
}
DEV void xcd_barrier_complete(unsigned* bar, unsigned x, unsigned& nloc, unsigned& nx) {
    const unsigned G = gridDim.x * gridDim.y * gridDim.z;
    unsigned sum, cnt, mine, sp = 0u;
    for (;;) {
        sum = 0u; cnt = 0u; mine = 0u;
#pragma unroll
        for (unsigned j = 0; j < 16; ++j) { const unsigned c = xb_ld(&bar[XB_XCNT(j)]); sum += c; cnt += (c > 0u) ? 1u : 0u; mine = (j == x) ? c : mine; }
        if (sum == G) break;
        __builtin_amdgcn_s_sleep(1);
        if ((++sp & 255u) == 0u) { if (xb_ld(&bar[XB_TMO])) break; if (sp > XB_SPIN_CAP) { atomicAdd(&bar[XB_TMO], 1u); break; } }
    }
    nloc = mine > 0u ? mine : 1u; nx = cnt > 0u ? cnt : 1u;
}
DEV void xcd_barrier(const XcdBarrier& b) {
    asm volatile("s_waitcnt vmcnt(0)" ::: "memory");
    __syncthreads();
    if (threadIdx.x == 0) {
        unsigned* bar = b.bar;
        __builtin_amdgcn_s_waitcnt(0);
        unsigned nloc = b.st[0], nx = b.st[1];
        if (nloc == 0u) { xcd_barrier_complete(bar, b.x, nloc, nx); b.st[0] = nloc; b.st[1] = nx; }
        const unsigned old = xb_add(&bar[XB_XSUB(b.x)], 1u);
        const unsigned gen = old / nloc;
        if (old + 1u == (gen + 1u) * nloc) {
            __builtin_amdgcn_fence(__ATOMIC_RELEASE, "agent");
            asm volatile("s_waitcnt vmcnt(0)" ::: "memory");
            const unsigned og = xb_add(&bar[XB_TOP], 1u);
            const unsigned tg = og / nx;
            if (og + 1u == (tg + 1u) * nx) xb_add(&bar[XB_TOPGEN], 1u);
            else XB_SPIN(xb_ld(&bar[XB_TOPGEN]) == tg, bar);
            __builtin_amdgcn_fence(__ATOMIC_ACQUIRE, "agent");
            xb_add(&bar[XB_XGEN(b.x)], 1u);
            asm volatile("s_waitcnt vmcnt(0)" ::: "memory");
        } else {
            XB_SPIN(xb_ld(&bar[XB_XGEN(b.x)]) == gen, bar);
            __builtin_amdgcn_fence(__ATOMIC_ACQUIRE, "agent");
            asm volatile("s_waitcnt vmcnt(0)" ::: "memory");
        }
    }
    __syncthreads();
}

struct Args { const void* in[25]; float* out; unsigned char* ws; int ph_lo, ph_hi, li, pad; };
struct Frame {
    LAS unsigned char* lds; volatile LAS unsigned* MISC; unsigned* ctl;
    int tid, lane, wave, vcu, G;
    unsigned char* ws; float* out;
};
DEV float wave_sum(float v) {
    v += __int_as_float(__builtin_amdgcn_update_dpp(0, __float_as_int(v), 0xB1, 0xF, 0xF, true));
    v += __int_as_float(__builtin_amdgcn_update_dpp(0, __float_as_int(v), 0x4E, 0xF, 0xF, true));
    v += __int_as_float(__builtin_amdgcn_update_dpp(0, __float_as_int(v), 0x141, 0xF, 0xF, true));
    v += __int_as_float(__builtin_amdgcn_update_dpp(0, __float_as_int(v), 0x140, 0xF, 0xF, true));
    v += __shfl_xor(v, 16);
    { auto rr = __builtin_amdgcn_permlane32_swap(__float_as_uint(v), __float_as_uint(v), false, false); v = __uint_as_float(rr[0]) + __uint_as_float(rr[1]); }
    return v;
}
namespace pg8 {
#define PG8_LAS __attribute__((address_space(3)))
typedef unsigned short bf16_t;
typedef short bf16x8 __attribute__((ext_vector_type(8)));
typedef float f32x4 __attribute__((ext_vector_type(4)));
typedef unsigned u32x4 __attribute__((ext_vector_type(4)));
constexpr int BM = 256, BK = 64, HALF = 128, HTB = HALF * BK * 2  , STAGE_BYTES = 8 * HTB, NXCD = 8, WGM = 8;

__host__ __device__ __forceinline__ int lds_byte(int r, int c) { const int st = (r >> 4) * 2 + (c >> 5), rr = r & 15, cc = c & 31, ob = rr * 64 + cc * 2; return st * 1024 + (ob ^ (((ob >> 9) & 1) << 5)); }
__host__ __device__ __forceinline__ void stage_rc(int b, int& R, int& C) { const int st = b / 1024, sb = b % 1024, swz = sb ^ (((sb >> 9) & 1) << 5); R = (st >> 1) * 16 + swz / 64; C = (st & 1) * 32 + (swz % 64) / 2; }
__host__ __device__ __forceinline__ int perm32(int rho) { const int n = rho >> 4, i = rho & 15; return 8 * (i >> 2) + 4 * n + (i & 3); }

struct Unit { int pm, pn; };
struct Gemm { const bf16_t* A; const bf16_t* Bt; int M, N, K; };

struct StaticOrder {
    int nM, nN, nwg, G, c;
    __host__ __device__ void init(int M, int N, int G_, int c_) { nM = M / BM; nN = N / BM; nwg = nM * nN; G = G_; c = c_; }
    __host__ __device__ bool next(int i, Unit& u) const {
        const long L = (long)i * G + c; if (L >= nwg) return false;
        int wgid = (int)L; { const int q = nwg / NXCD, r = nwg % NXCD, xcd = wgid % NXCD, off = wgid / NXCD; wgid = (xcd < r ? xcd * (q + 1) : r * (q + 1) + (xcd - r) * q) + off; }
        const int nig = WGM * nN, gid = wgid / nig, fm = gid * WGM, gsz = (nM - fm) < WGM ? (nM - fm) : WGM;
        u.pm = fm + ((wgid % nig) % gsz); u.pn = (wgid % nig) / gsz; return true;
    }
    __device__ __forceinline__ void a_ready(const Unit&) const {}
    __device__ __forceinline__ void done(const Unit&) const {}
};

typedef float f32x2c_t __attribute__((ext_vector_type(2))); typedef __bf16 bf16x2c_t __attribute__((ext_vector_type(2)));
__device__ __forceinline__ unsigned cvt_pk_bf16(float lo, float hi) { f32x2c_t v = {lo, hi}; bf16x2c_t b = __builtin_convertvector(v, bf16x2c_t); return __builtin_bit_cast(unsigned, b); }
typedef float f32x2 __attribute__((ext_vector_type(2)));


struct EpiIn {
    static constexpr bool PERM = true, AFTER_DRAIN = false, MID = false;
    bf16_t *Qb, *Kb, *Vb, *CB, *CCU, *GA, *GC; const float* ROPE; __amdgpu_buffer_rsrc_t orsrc;
    __device__ __forceinline__ void st(const int eoff, const u32x4 w) const { __builtin_amdgcn_raw_buffer_store_b128(w, orsrc, eoff * 2, 0, 16); }
    __device__ __forceinline__ void operator()(const f32x4 (&acc)[2][2][4][2], const Unit& u, int wr, int wc, int fr, int fq) const {
        const int pn = u.pn, row0 = u.pm * BM + wr * 64 + fr;
        if (pn < 4) {
            const int dst = pn < 2 ? 0 : (8 << 20); const int c0 = ((pn & 1) * 4 + wc) * 64 + 8 * fq;
#pragma unroll
            for (int ai = 0; ai < 2; ++ai) {
                f32x4 cs[4][4];
#pragma unroll
                for (int m = 0; m < 4; ++m) { const f32x4* rp = (const f32x4*)(ROPE + ((size_t)(row0 + ai * HALF + m * 16) * 32 + 8 * fq) * 2);
#pragma unroll
                    for (int q = 0; q < 4; ++q) cs[m][q] = rp[q]; }
#pragma unroll
                for (int m = 0; m < 4; ++m) { const int row = row0 + ai * HALF + m * 16;
                    const f32x4 cs0 = cs[m][0], cs1 = cs[m][1], cs2 = cs[m][2], cs3 = cs[m][3];
                    const f32x4 xa = acc[ai][0][m][0], xb = acc[ai][0][m][1], ya = acc[ai][1][m][0], yb = acc[ai][1][m][1];
                    u32x4 w1, w2;
                    w1.x = cvt_pk_bf16(xa[0] * cs0[0] - ya[0] * cs0[1], xa[1] * cs0[2] - ya[1] * cs0[3]);
                    w1.y = cvt_pk_bf16(xa[2] * cs1[0] - ya[2] * cs1[1], xa[3] * cs1[2] - ya[3] * cs1[3]);
                    w1.z = cvt_pk_bf16(xb[0] * cs2[0] - yb[0] * cs2[1], xb[1] * cs2[2] - yb[1] * cs2[3]);
                    w1.w = cvt_pk_bf16(xb[2] * cs3[0] - yb[2] * cs3[1], xb[3] * cs3[2] - yb[3] * cs3[3]);
                    w2.x = cvt_pk_bf16(ya[0] * cs0[0] + xa[0] * cs0[1], ya[1] * cs0[2] + xa[1] * cs0[3]);
                    w2.y = cvt_pk_bf16(ya[2] * cs1[0] + xa[2] * cs1[1], ya[3] * cs1[2] + xa[3] * cs1[3]);
                    w2.z = cvt_pk_bf16(yb[0] * cs2[0] + xb[0] * cs2[1], yb[1] * cs2[2] + xb[1] * cs2[3]);
                    w2.w = cvt_pk_bf16(yb[2] * cs3[0] + xb[2] * cs3[1], yb[3] * cs3[2] + xb[3] * cs3[3]);
                    st(dst + row * 512 + c0, w1); st(dst + row * 512 + c0 + 32, w2); }
            }
        } else if (pn < 8) {
            const int dst = pn < 6 ? (16 << 20) : (24 << 20); const int c0 = (pn & 1) * 256 + wc * 32 + 8 * fq;
#pragma unroll
            for (int ai = 0; ai < 2; ++ai)
#pragma unroll
                for (int m = 0; m < 4; ++m) { const int row = row0 + ai * HALF + m * 16;
#pragma unroll
                    for (int bj = 0; bj < 2; ++bj) { const f32x4 v0 = acc[ai][bj][m][0], v1 = acc[ai][bj][m][1]; u32x4 w;
                        w.x = cvt_pk_bf16(v0[0], v0[1]); w.y = cvt_pk_bf16(v0[2], v0[3]); w.z = cvt_pk_bf16(v1[0], v1[1]); w.w = cvt_pk_bf16(v1[2], v1[3]);
                        st(dst + row * 512 + c0 + bj * HALF, w); } }
        } else if (pn < 12) {
            const int c0 = (pn - 8) * 128 + wc * 32 + 8 * fq;
#pragma unroll
            for (int ai = 0; ai < 2; ++ai)
#pragma unroll
                for (int m = 0; m < 4; ++m) { const int row = row0 + ai * HALF + m * 16;
                    const f32x4 v0 = acc[ai][0][m][0] * acc[ai][1][m][0], v1 = acc[ai][0][m][1] * acc[ai][1][m][1]; u32x4 w;
                    w.x = cvt_pk_bf16(v0[0], v0[1]); w.y = cvt_pk_bf16(v0[2], v0[3]); w.z = cvt_pk_bf16(v1[0], v1[1]); w.w = cvt_pk_bf16(v1[2], v1[3]);
                    st((32 << 20) + row * 512 + c0, w); }
        } else {
            const int dst = pn < 16 ? (40 << 20) : (56 << 20); const int c0 = ((pn - 12) & 3) * 256 + wc * 32 + 8 * fq;
#pragma unroll
            for (int ai = 0; ai < 2; ++ai)
#pragma unroll
                for (int m = 0; m < 4; ++m) { const int row = row0 + ai * HALF + m * 16;
#pragma unroll
                    for (int bj = 0; bj < 2; ++bj) { f32x4 v0 = acc[ai][bj][m][0], v1 = acc[ai][bj][m][1];
#pragma unroll
                        for (int j = 0; j < 4; ++j) { v0[j] = __builtin_amdgcn_rcpf(1.f + __builtin_amdgcn_exp2f(-1.4426950408889634f * v0[j])); v1[j] = __builtin_amdgcn_rcpf(1.f + __builtin_amdgcn_exp2f(-1.4426950408889634f * v1[j])); }
                        u32x4 w; w.x = cvt_pk_bf16(v0[0], v0[1]); w.y = cvt_pk_bf16(v0[2], v0[3]); w.z = cvt_pk_bf16(v1[0], v1[1]); w.w = cvt_pk_bf16(v1[2], v1[3]);
                        st(dst + row * 1024 + c0 + bj * HALF, w); } }
        }
    }
};

struct EpiG {
    static constexpr bool PERM = true, AFTER_DRAIN = false, MID = true;
    const bf16_t* GA; const bf16_t* GC; bf16_t* O; __amdgpu_buffer_rsrc_t orsrc;
    __device__ __forceinline__ void mid(f32x4 (&acc)[2][2][4][2], const Unit& u, int wr, int wc, int fr, int fq) const {
        int base = (u.pm * BM + wr * 64 + fr) * 1024 + u.pn * BM + wc * 32 + 8 * fq; asm volatile("" : "+v"(base));
#pragma unroll
        for (int ai = 0; ai < 2; ++ai)
#pragma unroll
            for (int mh = 0; mh < 2; ++mh) {
            u32x4 ga[2][2], gc[2][2];
#pragma unroll
            for (int mm = 0; mm < 2; ++mm)
#pragma unroll
                for (int bj = 0; bj < 2; ++bj) { const int ro = base + (ai * HALF + (2 * mh + mm) * 16) * 1024 + bj * HALF; ga[mm][bj] = __builtin_nontemporal_load((const u32x4*)(GA + ro)); gc[mm][bj] = *(const u32x4*)(GC + ro); }
#pragma unroll
            for (int mm = 0; mm < 2; ++mm)
#pragma unroll
                for (int bj = 0; bj < 2; ++bj) { const u32x4 a = ga[mm][bj], c = gc[mm][bj]; const int m = 2 * mh + mm;
                    f32x4& v0 = acc[ai][bj][m][0]; f32x4& v1 = acc[ai][bj][m][1];
                    v0[0] *= __uint_as_float(a.x << 16) * __builtin_amdgcn_rcpf(__uint_as_float(c.x << 16)); v0[1] *= __uint_as_float(a.x & 0xffff0000u) * __builtin_amdgcn_rcpf(__uint_as_float(c.x & 0xffff0000u));
                    v0[2] *= __uint_as_float(a.y << 16) * __builtin_amdgcn_rcpf(__uint_as_float(c.y << 16)); v0[3] *= __uint_as_float(a.y & 0xffff0000u) * __builtin_amdgcn_rcpf(__uint_as_float(c.y & 0xffff0000u));
                    v1[0] *= __uint_as_float(a.z << 16) * __builtin_amdgcn_rcpf(__uint_as_float(c.z << 16)); v1[1] *= __uint_as_float(a.z & 0xffff0000u) * __builtin_amdgcn_rcpf(__uint_as_float(c.z & 0xffff0000u));
                    v1[2] *= __uint_as_float(a.w << 16) * __builtin_amdgcn_rcpf(__uint_as_float(c.w << 16)); v1[3] *= __uint_as_float(a.w & 0xffff0000u) * __builtin_amdgcn_rcpf(__uint_as_float(c.w & 0xffff0000u)); }
        }
    }
    __device__ __forceinline__ void operator()(const f32x4 (&acc)[2][2][4][2], const Unit& u, int wr, int wc, int fr, int fq) const {
        int base = (u.pm * BM + wr * 64 + fr) * 1024 + u.pn * BM + wc * 32 + 8 * fq; asm volatile("" : "+v"(base));
#pragma unroll
        for (int ai = 0; ai < 2; ++ai) {
            u32x4 gc[4][2];
#pragma unroll
            for (int m = 0; m < 4; ++m)
#pragma unroll
                for (int bj = 0; bj < 2; ++bj) gc[m][bj] = __builtin_nontemporal_load((const u32x4*)(GC + base + (ai * HALF + m * 16) * 1024 + bj * HALF));
#pragma unroll
            for (int m = 0; m < 4; ++m)
#pragma unroll
                for (int bj = 0; bj < 2; ++bj) { const u32x4 c = gc[m][bj]; const int ro = base + (ai * HALF + m * 16) * 1024 + bj * HALF;
                    const f32x4 v0 = acc[ai][bj][m][0], v1 = acc[ai][bj][m][1]; u32x4 w;
                    w.x = cvt_pk_bf16(v0[0] * __uint_as_float(c.x << 16), v0[1] * __uint_as_float(c.x & 0xffff0000u)); w.y = cvt_pk_bf16(v0[2] * __uint_as_float(c.y << 16), v0[3] * __uint_as_float(c.y & 0xffff0000u));
                    w.z = cvt_pk_bf16(v1[0] * __uint_as_float(c.z << 16), v1[1] * __uint_as_float(c.z & 0xffff0000u)); w.w = cvt_pk_bf16(v1[2] * __uint_as_float(c.w << 16), v1[3] * __uint_as_float(c.w & 0xffff0000u));
                    __builtin_amdgcn_raw_buffer_store_b128(w, orsrc, ro * 2, 0, 16  ); }
        }
    }
};
struct EpiX1 {
    static constexpr bool PERM = true, AFTER_DRAIN = false, MID = false;
    const float* X; const float* GM; bf16_t* X1; float* SSQ; __amdgpu_buffer_rsrc_t xrsrc;
    __device__ __forceinline__ void operator()(const f32x4 (&acc)[2][2][4][2], const Unit& u, int wr, int wc, int fr, int fq) const {
        const int row0 = u.pm * BM + wr * 64 + fr, c0 = u.pn * BM + wc * 32 + 8 * fq;
        const float* gm = GM + (u.pm >> 4) * 6144 + c0;
        f32x4 gv[2][2];
#pragma unroll
        for (int bj = 0; bj < 2; ++bj)
#pragma unroll
            for (int n = 0; n < 2; ++n) gv[bj][n] = *(const f32x4*)(gm + bj * HALF + n * 4);
#pragma unroll
        for (int ai = 0; ai < 2; ++ai)
#pragma unroll
            for (int mh = 0; mh < 2; ++mh) {
            f32x4 xv[2][2][2];
#pragma unroll
            for (int mm = 0; mm < 2; ++mm) { const size_t ro = (size_t)(row0 + ai * HALF + (2 * mh + mm) * 16) * 1024 + c0;
#pragma unroll
                for (int bj = 0; bj < 2; ++bj)
#pragma unroll
                    for (int n = 0; n < 2; ++n) xv[mm][bj][n] = __builtin_nontemporal_load((const f32x4*)(X + ro + bj * HALF + n * 4)); }
#pragma unroll
            for (int mm = 0; mm < 2; ++mm) { const int m = 2 * mh + mm; const int row = row0 + ai * HALF + m * 16; const size_t ro = (size_t)row * 1024 + c0; float ss = 0.f;
#pragma unroll
                for (int bj = 0; bj < 2; ++bj) { const f32x4 o0 = xv[mm][bj][0] + gv[bj][0] * acc[ai][bj][m][0], o1 = xv[mm][bj][1] + gv[bj][1] * acc[ai][bj][m][1];
                    ss += ((o0[0] * o0[0] + o0[1] * o0[1]) + (o0[2] * o0[2] + o0[3] * o0[3])) + ((o1[0] * o1[0] + o1[1] * o1[1]) + (o1[2] * o1[2] + o1[3] * o1[3]));
                    u32x4 w; w.x = cvt_pk_bf16(o0[0], o0[1]); w.y = cvt_pk_bf16(o0[2], o0[3]); w.z = cvt_pk_bf16(o1[0], o1[1]); w.w = cvt_pk_bf16(o1[2], o1[3]);
                    __builtin_amdgcn_raw_buffer_store_b128(w, xrsrc, (int)(ro + bj * HALF) * 2, 0, 16  ); }
                ss += __shfl_xor(ss, 16); { auto rr_ = __builtin_amdgcn_permlane32_swap(__float_as_uint(ss), __float_as_uint(ss), false, false); ss = __uint_as_float(rr_[0]) + __uint_as_float(rr_[1]); }
                if (fq == 0) __hip_atomic_store(SSQ + (size_t)row * 16 + u.pn * 4 + wc, ss, __ATOMIC_RELAXED, __HIP_MEMORY_SCOPE_AGENT); }
        }
    }
};

template <class Epi, class Sched, bool ALIGN_EPI = false, bool SP2 = false>
__device__ __forceinline__ void gemm_phase(PG8_LAS unsigned char* lds, const Gemm g, const Sched& S, const Epi& E) {
    const int tid = threadIdx.x, wid = __builtin_amdgcn_readfirstlane(tid >> 6), lane = tid & 63, wr = wid >> 2, wc = wid & 3, fr = lane & 15, fq = lane >> 4;
    const int K = g.K, nt = K / BK;
    unsigned voffA[2], voffB[2];
#pragma unroll
    for (int i = 0; i < 2; ++i) { int R, C; stage_rc(tid * 16 + i * 8192, R, C); const int Rb = Epi::PERM ? ((R & ~31) + perm32(R & 31)) : R;
        voffA[i] = (unsigned)(R * K + C) * 2u; voffB[i] = (unsigned)(Rb * K + C) * 2u; }
    const size_t kstep = (size_t)(BK * 2);
    const size_t hstep = (size_t)HALF * K * 2;
    const size_t tstep = 2 * hstep;
    const unsigned ldsw = (unsigned)wid * 1024u;
    const int aoff = lds_byte(wr * 64 + fr, fq * 8), boff = lds_byte(wc * 32 + fr, fq * 8);
#define PG8_SA(b, h) (((b) * 2 + (h)) * HTB)
#define PG8_SB(b, h) ((4 + (b) * 2 + (h)) * HTB)
#define PG8_STAGE(bufoff, gbase, voff) do { _Pragma("unroll") for (int _i = 0; _i < 2; ++_i) \
        __builtin_amdgcn_global_load_lds((const unsigned*)((const char*)(gbase) + (voff)[_i]), (PG8_LAS unsigned*)(lds + (bufoff) + ldsw + _i * 8192), 16, 0, 0); } while (0)
#define PG8_LDA(dst, b, h) do { _Pragma("unroll") for (int m = 0; m < 4; ++m) _Pragma("unroll") for (int k = 0; k < 2; ++k) dst[m][k] = *(const PG8_LAS bf16x8*)(lds + PG8_SA(b, h) + aoff + m * 2048 + k * 1024); } while (0)
#define PG8_LDB(dst, b, h) do { _Pragma("unroll") for (int n = 0; n < 2; ++n) _Pragma("unroll") for (int k = 0; k < 2; ++k) dst[n][k] = *(const PG8_LAS bf16x8*)(lds + PG8_SB(b, h) + boff + n * 2048 + k * 1024); } while (0)
#define PG8_MMA(ai, bj, At, Bt) do { __builtin_amdgcn_s_setprio(1); _Pragma("unroll") for (int m = 0; m < 4; ++m) _Pragma("unroll") for (int n = 0; n < 2; ++n) _Pragma("unroll") for (int k = 0; k < 2; ++k) \
        acc[ai][bj][m][n] = __builtin_amdgcn_mfma_f32_16x16x32_bf16(Bt[n][k], At[m][k], acc[ai][bj][m][n], 0, 0, 0); __builtin_amdgcn_s_setprio(0); } while (0)
#define PG8_WAIT_V(n) asm volatile("s_waitcnt vmcnt(" #n ")" ::: "memory")
#define PG8_WAIT_L(n) asm volatile("s_waitcnt lgkmcnt(" #n ")" ::: "memory")
#define PG8_BAR __builtin_amdgcn_s_barrier()
#define PG8_SCHED __builtin_amdgcn_sched_barrier(0)
    Unit cur, nxt; int ui = 0;
    if (!S.next(0, cur)) return;
    f32x4 acc[2][2][4][2];
#pragma unroll
    for (int a = 0; a < 2; ++a)
#pragma unroll
        for (int b = 0; b < 2; ++b)
#pragma unroll
            for (int m = 0; m < 4; ++m)
#pragma unroll
                for (int n = 0; n < 2; ++n) acc[a][b][m][n] = (f32x4){0.f, 0.f, 0.f, 0.f};
    bf16x8 At[4][2], B0[2][2], B1[2][2];
    const char* cA = (const char*)g.A + (size_t)cur.pm * tstep; const char* cB = (const char*)g.Bt + (size_t)cur.pn * tstep;
    S.a_ready(cur);
    if constexpr (SP2) {
        PG8_STAGE(PG8_SB(0, 0), cB, voffB); PG8_STAGE(PG8_SB(0, 1), cB + hstep, voffB); PG8_STAGE(PG8_SA(0, 0), cA, voffA); PG8_STAGE(PG8_SA(0, 1), cA + hstep, voffA);
        if (wr == 1) PG8_BAR;
        PG8_WAIT_V(2); PG8_BAR;
        PG8_STAGE(PG8_SB(1, 0), cB + kstep, voffB); PG8_STAGE(PG8_SA(1, 0), cA + kstep, voffA); PG8_STAGE(PG8_SB(1, 1), cB + hstep + kstep, voffB);
        PG8_WAIT_V(6); PG8_BAR;
    } else {
        PG8_STAGE(PG8_SB(0, 0), cB, voffB); PG8_STAGE(PG8_SA(0, 0), cA, voffA); PG8_STAGE(PG8_SB(0, 1), cB + hstep, voffB); PG8_STAGE(PG8_SA(0, 1), cA + hstep, voffA);
        if (wr == 1) PG8_BAR;
        PG8_WAIT_V(4); PG8_BAR;
        PG8_STAGE(PG8_SB(1, 0), cB + kstep, voffB); PG8_STAGE(PG8_SA(1, 0), cA + kstep, voffA); PG8_STAGE(PG8_SB(1, 1), cB + hstep + kstep, voffB);
        PG8_WAIT_V(6); PG8_BAR;
    }
    for (;;) {
        const bool has_next = S.next(ui + 1, nxt);
        const char* nA = has_next ? (const char*)g.A + (size_t)nxt.pm * tstep : cA; const char* nB = has_next ? (const char*)g.Bt + (size_t)nxt.pn * tstep : cB;
        for (int t = 0; t < nt; t += 2) {
            const bool last = (t == nt - 2);
            const char* a1 = cA + (size_t)(t + 1) * kstep;
            const char* a2 = last ? nA : cA + (size_t)(t + 2) * kstep; const char* b2 = last ? nB : cB + (size_t)(t + 2) * kstep;
            const char* a3 = a2 + kstep; const char* b3 = b2 + kstep;
            if (last && has_next) S.a_ready(nxt);
            if constexpr (Epi::MID) { if (t == nt / 2) E.mid(acc, cur, wr, wc, fr, fq); }
            if constexpr (SP2) {
            PG8_LDB(B0, 0, 0); PG8_LDB(B1, 0, 1); PG8_SCHED; PG8_LDA(At, 0, 0); PG8_STAGE(PG8_SA(1, 1), a1 + hstep, voffA);
            PG8_WAIT_V(8); PG8_WAIT_L(0); PG8_BAR; PG8_MMA(0, 0, At, B0); PG8_MMA(0, 1, At, B1); PG8_BAR; PG8_SCHED;
            PG8_LDA(At, 0, 1); PG8_STAGE(PG8_SB(0, 0), b2, voffB); PG8_STAGE(PG8_SB(0, 1), b2 + hstep, voffB); PG8_STAGE(PG8_SA(0, 0), a2, voffA);
            PG8_WAIT_V(8); PG8_WAIT_L(0); PG8_BAR; PG8_MMA(1, 0, At, B0); PG8_MMA(1, 1, At, B1); PG8_BAR; PG8_SCHED;
            PG8_LDB(B0, 1, 0); PG8_LDB(B1, 1, 1); PG8_SCHED; PG8_LDA(At, 1, 0); PG8_STAGE(PG8_SA(0, 1), a2 + hstep, voffA);
            PG8_WAIT_V(8); PG8_WAIT_L(0); PG8_BAR; PG8_MMA(0, 0, At, B0); PG8_MMA(0, 1, At, B1); PG8_BAR; PG8_SCHED;
            PG8_LDA(At, 1, 1); PG8_STAGE(PG8_SB(1, 0), b3, voffB); PG8_STAGE(PG8_SB(1, 1), b3 + hstep, voffB); PG8_STAGE(PG8_SA(1, 0), a3, voffA);
            PG8_WAIT_V(8); PG8_WAIT_L(0); PG8_BAR; PG8_MMA(1, 0, At, B0); PG8_MMA(1, 1, At, B1); PG8_BAR; PG8_SCHED;
            } else {
            PG8_LDB(B0, 0, 0); PG8_SCHED; PG8_LDA(At, 0, 0); PG8_STAGE(PG8_SA(1, 1), a1 + hstep, voffA);
            PG8_WAIT_L(8); PG8_BAR; PG8_WAIT_L(0); PG8_MMA(0, 0, At, B0); PG8_BAR; PG8_SCHED;
            PG8_LDB(B1, 0, 1); PG8_STAGE(PG8_SB(0, 0), b2, voffB);
            PG8_BAR; PG8_WAIT_L(0); PG8_MMA(0, 1, At, B1); PG8_BAR;
            PG8_LDA(At, 0, 1); PG8_STAGE(PG8_SA(0, 0), a2, voffA);
            PG8_BAR; PG8_WAIT_L(0); PG8_MMA(1, 0, At, B0); PG8_BAR; PG8_SCHED;
            PG8_STAGE(PG8_SB(0, 1), b2 + hstep, voffB);
            PG8_WAIT_V(6); PG8_BAR; PG8_MMA(1, 1, At, B1); PG8_BAR;
            PG8_LDB(B0, 1, 0); PG8_SCHED; PG8_LDA(At, 1, 0); PG8_STAGE(PG8_SA(0, 1), a2 + hstep, voffA);
            PG8_WAIT_L(8); PG8_BAR; PG8_WAIT_L(0); PG8_MMA(0, 0, At, B0); PG8_BAR; PG8_SCHED;
            PG8_LDB(B1, 1, 1); PG8_STAGE(PG8_SB(1, 0), b3, voffB);
            PG8_BAR; PG8_WAIT_L(0); PG8_MMA(0, 1, At, B1); PG8_BAR;
            PG8_LDA(At, 1, 1); PG8_STAGE(PG8_SA(1, 0), a3, voffA);
            PG8_BAR; PG8_WAIT_L(0); PG8_MMA(1, 0, At, B0); PG8_BAR; PG8_SCHED;
            PG8_STAGE(PG8_SB(1, 1), b3 + hstep, voffB);
            PG8_WAIT_V(6); PG8_BAR; PG8_MMA(1, 1, At, B1); PG8_BAR;
            }
        }
        if constexpr (ALIGN_EPI) { if (wr == 0) PG8_BAR; }
        if constexpr (!Epi::AFTER_DRAIN) { E(acc, cur, wr, wc, fr, fq); S.done(cur); }
        if (!has_next) break;
#pragma unroll
        for (int a = 0; a < 2; ++a)
#pragma unroll
            for (int b = 0; b < 2; ++b)
#pragma unroll
                for (int m = 0; m < 4; ++m)
#pragma unroll
                    for (int n = 0; n < 2; ++n) acc[a][b][m][n] = (f32x4){0.f, 0.f, 0.f, 0.f};
        cur = nxt; cA = nA; cB = nB; ++ui;
        if constexpr (ALIGN_EPI) { if (wr == 1) PG8_BAR; }
    }
    PG8_WAIT_V(0);
    if constexpr (!ALIGN_EPI) { if (wr == 0) PG8_BAR; }
    PG8_BAR;
    if constexpr (Epi::AFTER_DRAIN) { E.fused(acc, cur, wr, wc, fr, fq, lds, wid, lane); S.done(cur); }
#undef PG8_SA
#undef PG8_SB
#undef PG8_STAGE
#undef PG8_LDA
#undef PG8_LDB
#undef PG8_MMA
#undef PG8_WAIT_V
#undef PG8_WAIT_L
#undef PG8_BAR
#undef PG8_SCHED
}

struct UnitX { int pm, pn; int arow, brow; const int* glist; const float* wlist; int gvalid; int e; unsigned* sync; };
__device__ __forceinline__ void moe_dep_wait(unsigned* dep, unsigned* wdc, unsigned wd_need, volatile PG8_LAS unsigned* lflag, unsigned seq, int wid, unsigned pre_d, unsigned pre_w) {
    if (wid == 0) { unsigned sp = 0; unsigned d = pre_d, w = pre_w;
        while (d < 2u || w < wd_need) { __builtin_amdgcn_s_sleep(16); if (++sp > (1u << 20)) break;
            d = __builtin_amdgcn_readfirstlane(__hip_atomic_load(dep, __ATOMIC_RELAXED, __HIP_MEMORY_SCOPE_AGENT)); w = __builtin_amdgcn_readfirstlane(__hip_atomic_load(wdc, __ATOMIC_RELAXED, __HIP_MEMORY_SCOPE_AGENT)); }
        *lflag = seq; }
    else { unsigned sp = 0; while (*lflag < seq) { __builtin_amdgcn_s_sleep(4); if (++sp > (1u << 22)) break; } }
    asm volatile("" ::: "memory");
}
template <class Epi, class Sched, bool GATHER, int MODE = 0>
__device__ __forceinline__ void gemm_phase_x(PG8_LAS unsigned char* lds, const Gemm g, const Sched& S, const Epi& E, volatile PG8_LAS unsigned* lflag = nullptr, unsigned* wdc = nullptr, unsigned wd_need = 0u) {
    const int tid = threadIdx.x, wid = __builtin_amdgcn_readfirstlane(tid >> 6), lane = tid & 63, wr = wid >> 2, wc = wid & 3, fr = lane & 15, fq = lane >> 4;
    const int K = g.K, nt = K / BK;
    unsigned vA[2][2], voffB[2]; int tokn[2][2]; int Rr[2], Cc[2];
#pragma unroll
    for (int i = 0; i < 2; ++i) { int R, C; stage_rc(tid * 16 + i * 8192, R, C); const int Rb = Epi::PERM ? ((R & ~31) + perm32(R & 31)) : R; Rr[i] = R; Cc[i] = C; voffB[i] = (unsigned)(Rb * K + C) * 2u; }
    const size_t kstep = (size_t)(BK * 2), hstep = (size_t)HALF * K * 2;
    const unsigned ldsw = (unsigned)wid * 1024u;
    const int aoff = lds_byte(wr * 64 + fr, fq * 8), boff = lds_byte(wc * 32 + fr, fq * 8);
#define PG8_SA(b, h) (((b) * 2 + (h)) * HTB)
#define PG8_SB(b, h) ((4 + (b) * 2 + (h)) * HTB)
#define PG8_STAGE(bufoff, gbase, voff) do { _Pragma("unroll") for (int _i = 0; _i < 2; ++_i) \
        __builtin_amdgcn_global_load_lds((const unsigned*)((const char*)(gbase) + (voff)[_i]), (PG8_LAS unsigned*)(lds + (bufoff) + ldsw + _i * 8192), 16, 0, 0); } while (0)
#define PG8_LDA(dst, b, h) do { _Pragma("unroll") for (int m = 0; m < 4; ++m) _Pragma("unroll") for (int k = 0; k < 2; ++k) dst[m][k] = *(const PG8_LAS bf16x8*)(lds + PG8_SA(b, h) + aoff + m * 2048 + k * 1024); } while (0)
#define PG8_LDB(dst, b, h) do { _Pragma("unroll") for (int n = 0; n < 2; ++n) _Pragma("unroll") for (int k = 0; k < 2; ++k) dst[n][k] = *(const PG8_LAS bf16x8*)(lds + PG8_SB(b, h) + boff + n * 2048 + k * 1024); } while (0)
#define PG8_MMA(ai, bj, At, Bt) do { __builtin_amdgcn_s_setprio(1); _Pragma("unroll") for (int m = 0; m < 4; ++m) _Pragma("unroll") for (int n = 0; n < 2; ++n) _Pragma("unroll") for (int k = 0; k < 2; ++k) \
        acc[ai][bj][m][n] = __builtin_amdgcn_mfma_f32_16x16x32_bf16(Bt[n][k], At[m][k], acc[ai][bj][m][n], 0, 0, 0); __builtin_amdgcn_s_setprio(0); } while (0)
#define PG8_WAIT_V(n) asm volatile("s_waitcnt vmcnt(" #n ")" ::: "memory")
#define PG8_WAIT_L(n) asm volatile("s_waitcnt lgkmcnt(" #n ")" ::: "memory")
#define PG8_BAR __builtin_amdgcn_s_barrier()
#define PG8_SCHED __builtin_amdgcn_sched_barrier(0)
#define PG8_TOK(U, r) (GATHER ? (((r) < (U).gvalid) ? (U).glist[(r)] : 0) : ((U).arow + (r)))
    UnitX cur, nxt; int ui = 0;
    if (!S.next(0, cur)) return;
    if constexpr (MODE == 2) moe_dep_wait(cur.sync, wdc, wd_need, lflag, 1u, wid, 0u, 0u);
    f32x4 acc[2][2][4][2];
#pragma unroll
    for (int a = 0; a < 2; ++a)
#pragma unroll
        for (int b = 0; b < 2; ++b)
#pragma unroll
            for (int m = 0; m < 4; ++m)
#pragma unroll
                for (int n = 0; n < 2; ++n) acc[a][b][m][n] = (f32x4){0.f, 0.f, 0.f, 0.f};
    bf16x8 At[4][2], B0[2][2], B1[2][2];
#pragma unroll
    for (int h = 0; h < 2; ++h)
#pragma unroll
        for (int i = 0; i < 2; ++i) vA[h][i] = (unsigned)(PG8_TOK(cur, h * HALF + Rr[i]) * K + Cc[i]) * 2u;
    const char* gA = (const char*)g.A; const char* cB = (const char*)g.Bt + (size_t)cur.brow * K * 2;
    PG8_STAGE(PG8_SB(0, 0), cB, voffB); PG8_STAGE(PG8_SB(0, 1), cB + hstep, voffB); PG8_STAGE(PG8_SA(0, 0), gA, vA[0]); PG8_STAGE(PG8_SA(0, 1), gA, vA[1]);
    if (wr == 1) PG8_BAR;
    PG8_WAIT_V(2); PG8_BAR;
    PG8_STAGE(PG8_SB(1, 0), cB + kstep, voffB); PG8_STAGE(PG8_SA(1, 0), gA + kstep, vA[0]); PG8_STAGE(PG8_SB(1, 1), cB + hstep + kstep, voffB);
    PG8_WAIT_V(6); PG8_BAR;
    for (;;) {
        const bool has_next = S.next(ui + 1, nxt);
        unsigned pre_d = 0u, pre_w = 0u;
        if constexpr (MODE == 2) { if (has_next && wid == 0) { pre_d = __hip_atomic_load(nxt.sync, __ATOMIC_RELAXED, __HIP_MEMORY_SCOPE_AGENT); pre_w = __hip_atomic_load(wdc, __ATOMIC_RELAXED, __HIP_MEMORY_SCOPE_AGENT); } }
        const char* nB = has_next ? (const char*)g.Bt + (size_t)nxt.brow * K * 2 : cB;
        if (has_next) {
#pragma unroll
            for (int h = 0; h < 2; ++h)
#pragma unroll
                for (int i = 0; i < 2; ++i) tokn[h][i] = PG8_TOK(nxt, h * HALF + Rr[i]);
        }
#pragma clang loop unroll(disable)
        for (int t = 0; t < nt; t += 2) {
            const bool last = (t == nt - 2);
            const char* b2 = last ? nB : cB + (size_t)(t + 2) * kstep; const char* b3 = b2 + kstep;
            const size_t ko2 = last ? (size_t)0 : (size_t)(t + 2) * kstep;
            PG8_LDB(B0, 0, 0); PG8_LDB(B1, 0, 1); PG8_SCHED; PG8_LDA(At, 0, 0); PG8_STAGE(PG8_SA(1, 1), gA + (size_t)(t + 1) * kstep, vA[1]);
            PG8_WAIT_V(8); PG8_WAIT_L(0); PG8_BAR; PG8_MMA(0, 0, At, B0); PG8_MMA(0, 1, At, B1); PG8_BAR; PG8_SCHED;
            if (last && has_next) {
                if constexpr (MODE == 2) moe_dep_wait(nxt.sync, wdc, wd_need, lflag, (unsigned)(ui + 2), wid, (unsigned)__builtin_amdgcn_readfirstlane((int)pre_d), (unsigned)__builtin_amdgcn_readfirstlane((int)pre_w));
#pragma unroll
                for (int h = 0; h < 2; ++h)
#pragma unroll
                    for (int i = 0; i < 2; ++i) vA[h][i] = (unsigned)(tokn[h][i] * K + Cc[i]) * 2u;
            }
            PG8_LDA(At, 0, 1); PG8_STAGE(PG8_SB(0, 0), b2, voffB); PG8_STAGE(PG8_SB(0, 1), b2 + hstep, voffB); PG8_STAGE(PG8_SA(0, 0), gA + ko2, vA[0]);
            PG8_WAIT_V(8); PG8_WAIT_L(0); PG8_BAR; PG8_MMA(1, 0, At, B0); PG8_MMA(1, 1, At, B1); PG8_BAR; PG8_SCHED;
            PG8_LDB(B0, 1, 0); PG8_LDB(B1, 1, 1); PG8_SCHED; PG8_LDA(At, 1, 0); PG8_STAGE(PG8_SA(0, 1), gA + ko2, vA[1]);
            PG8_WAIT_V(8); PG8_WAIT_L(0); PG8_BAR; PG8_MMA(0, 0, At, B0); PG8_MMA(0, 1, At, B1); PG8_BAR; PG8_SCHED;
            PG8_LDA(At, 1, 1); PG8_STAGE(PG8_SB(1, 0), b3, voffB); PG8_STAGE(PG8_SB(1, 1), b3 + hstep, voffB); PG8_STAGE(PG8_SA(1, 0), gA + ko2 + kstep, vA[0]);
            PG8_WAIT_V(8); PG8_WAIT_L(0); PG8_BAR; PG8_MMA(1, 0, At, B0); PG8_MMA(1, 1, At, B1); PG8_BAR; PG8_SCHED;
        }
        if (wr == 0) PG8_BAR;
        { const int l2_ = (int)__builtin_amdgcn_mbcnt_hi(~0u, __builtin_amdgcn_mbcnt_lo(~0u, 0u)); E(acc, cur, wr, wc, l2_ & 15, l2_ >> 4); }
        if constexpr (MODE == 1) {
            asm volatile("s_waitcnt vmcnt(0)" ::: "memory"); PG8_BAR;
            if (wid == 0 && __builtin_amdgcn_mbcnt_hi(~0u, __builtin_amdgcn_mbcnt_lo(~0u, 0u)) == 0u) __hip_atomic_fetch_add(cur.sync, 1u, __ATOMIC_RELAXED, __HIP_MEMORY_SCOPE_AGENT); }
        if (!has_next) break;
#pragma unroll
        for (int a = 0; a < 2; ++a)
#pragma unroll
            for (int b = 0; b < 2; ++b)
#pragma unroll
                for (int m = 0; m < 4; ++m)
#pragma unroll
                    for (int n = 0; n < 2; ++n) acc[a][b][m][n] = (f32x4){0.f, 0.f, 0.f, 0.f};
        cur = nxt; cB = nB; ++ui;
        if (wr == 1) PG8_BAR;
    }
    PG8_WAIT_V(0);
    PG8_BAR;
#undef PG8_TOK
#undef PG8_SA
#undef PG8_SB
#undef PG8_STAGE
#undef PG8_LDA
#undef PG8_LDB
#undef PG8_MMA
#undef PG8_WAIT_V
#undef PG8_WAIT_L
#undef PG8_BAR
#undef PG8_SCHED
}
struct MoeTiles { PG8_LAS int* te; PG8_LAS int* tm; PG8_LAS int* tv; int T; };
struct SchedMoeA {
    MoeTiles mt; const int* ELT; const float* ELW; int vcu, G; unsigned* DONE;
    __device__ __forceinline__ bool next(int i, UnitX& u) const {
        const int idx = i * G + vcu; if (idx >= 2 * mt.T) return false;
        const int ti = idx >> 1, nn = idx & 1, e = mt.te[ti], m = mt.tm[ti];
        u.pm = ti; u.pn = nn; u.arow = 0; u.brow = e * 512 + nn * 256; u.glist = ELT + e * M + m * 256; u.wlist = ELW + e * M + m * 256; u.gvalid = mt.tv[ti]; u.e = e; u.sync = DONE + ti * 16; return true; }
};
struct SchedMoeB {
    MoeTiles mt; int vcu, G; unsigned* DONE;
    __device__ __forceinline__ bool next(int i, UnitX& u) const {
        int nA = 2 * mt.T - G; if (nA < 0 || nA >= G - 32) nA = 0; const int nB = G - nA;
        int idx; const int base3 = 3 * nB + nA;
        if (vcu < nA) idx = i == 0 ? 2 * nB + vcu : base3 + (i - 1) * G + vcu;
        else { const int j = vcu - nA; idx = i < 2 ? i * nB + j : (i == 2 ? 2 * nB + nA + j : base3 + (i - 3) * G + vcu); }
        if (idx >= 4 * mt.T) return false;
        const int ti = idx >> 2, nn = idx & 3, e = mt.te[ti];
        u.pm = ti; u.pn = nn; u.arow = ti * 256; u.brow = e * 1024 + nn * 256; u.glist = nullptr; u.wlist = nullptr; u.gvalid = 256; u.e = e; u.sync = DONE + ti * 16; return true; }
};
struct EpiAct {
    static constexpr bool PERM = true;
    bf16_t* ACT; __amdgpu_buffer_rsrc_t rsrc;
    __device__ __forceinline__ void operator()(const f32x4 (&acc)[2][2][4][2], const UnitX& u, int wr, int wc, int fr, int fq) const {
        int base = ((u.pm * BM + wr * 64 + fr) * 256 + u.pn * 128 + wc * 32 + 8 * fq) * 2; asm volatile("" : "+v"(base));
        const int r0 = wr * 64 + fr;
#pragma unroll
        for (int ai = 0; ai < 2; ++ai)
#pragma unroll
            for (int m = 0; m < 4; ++m) { const int r = ai * HALF + m * 16 + r0; const float w = r < u.gvalid ? u.wlist[r] : 0.f;
                f32x4 v0, v1;
#pragma unroll
                for (int j = 0; j < 4; ++j) { const float g0 = acc[ai][0][m][0][j], g1 = acc[ai][0][m][1][j];
                    v0[j] = g0 * __builtin_amdgcn_rcpf(1.f + __builtin_amdgcn_exp2f(-1.4426950408889634f * g0)) * acc[ai][1][m][0][j] * w;
                    v1[j] = g1 * __builtin_amdgcn_rcpf(1.f + __builtin_amdgcn_exp2f(-1.4426950408889634f * g1)) * acc[ai][1][m][1][j] * w; }
                u32x4 o; o.x = cvt_pk_bf16(v0[0], v0[1]); o.y = cvt_pk_bf16(v0[2], v0[3]); o.z = cvt_pk_bf16(v1[0], v1[1]); o.w = cvt_pk_bf16(v1[2], v1[3]);
                __builtin_amdgcn_raw_buffer_store_b128(o, rsrc, base + (ai * HALF + m * 16) * 512, 0, 16  ); }
    }
};
struct EpiY {
    static constexpr bool PERM = true;
    bf16_t* Y; __amdgpu_buffer_rsrc_t yrsrc;
    __device__ __forceinline__ void operator()(const f32x4 (&acc)[2][2][4][2], const UnitX& u, int wr, int wc, int fr, int fq) const {
        const int c0 = u.pn * BM + wc * 32 + 8 * fq;
#pragma unroll
        for (int ai = 0; ai < 2; ++ai)
#pragma unroll
            for (int m = 0; m < 4; ++m) { const int ro = (u.pm * BM + ai * HALF + wr * 64 + m * 16 + fr) * 1024 + c0;
#pragma unroll
                for (int bj = 0; bj < 2; ++bj) { const f32x4 v0 = acc[ai][bj][m][0], v1 = acc[ai][bj][m][1]; u32x4 o;
                    o.x = cvt_pk_bf16(v0[0], v0[1]); o.y = cvt_pk_bf16(v0[2], v0[3]); o.z = cvt_pk_bf16(v1[0], v1[1]); o.w = cvt_pk_bf16(v1[2], v1[3]);
                    __builtin_amdgcn_raw_buffer_store_b128(o, yrsrc, (ro + bj * HALF) * 2, 0, 16  ); } }
    }
};
}

struct TrItem { const float* W; bf16_t* WT; int N, ldd, k0, kd0, n0, drow0; };
DEV void tr_load(const TrItem& t, f32x4 (&r)[8], int lane) {
    const float* p = t.W + (size_t)(t.k0 + (lane >> 3)) * t.N + t.n0 + (lane & 7) * 4;
#pragma unroll
    for (int i = 0; i < 8; ++i) r[i] = __builtin_nontemporal_load((const f32x4*)(p + (size_t)(8 * i) * t.N));
}
template <bool SC1 = false> DEV void tr_emit(const TrItem& t, const f32x4 (&r)[8], LAS float* scr, int lane, __amdgpu_buffer_rsrc_t wrsrc = __amdgpu_buffer_rsrc_t(), const bf16_t* wbase = nullptr) {
    { const int kq = lane >> 3, nq = (lane & 7) * 4;
#pragma unroll
      for (int i = 0; i < 8; ++i) { LAS float* d = scr + (8 * i + kq) * 33 + nq; d[0] = r[i].x; d[1] = r[i].y; d[2] = r[i].z; d[3] = r[i].w; } }
    LDS_WAIT(); asm volatile("" ::: "memory");
    const int c = lane & 7;
#pragma unroll
    for (int j = 0; j < 4; ++j) { const int n = (lane >> 3) + 8 * j; const LAS float* s = scr + (8 * c) * 33 + n;
        v4u o; o.x = pk2(s[0 * 33], s[1 * 33]); o.y = pk2(s[2 * 33], s[3 * 33]); o.z = pk2(s[4 * 33], s[5 * 33]); o.w = pk2(s[6 * 33], s[7 * 33]);
        if constexpr (SC1) __builtin_amdgcn_raw_buffer_store_b128(o, wrsrc, (int)((t.WT + (size_t)(t.drow0 + n) * t.ldd + t.kd0 + 8 * c) - wbase) * 2, 0, 16  );
        else *(GAS v4u*)(t.WT + (size_t)(t.drow0 + n) * t.ldd + t.kd0 + 8 * c) = o; }
    LDS_WAIT(); asm volatile("" ::: "memory");
}
DEV int in_row_map(int c0) {
    if (c0 < 1024) { const int sect = c0 >> 9, cc = c0 & 511, tile = cc >> 8, u = (cc & 255) >> 6, half = (cc & 63) >> 5; return sect * 512 + tile * 256 + half * 128 + u * 32; }
    if (c0 < 2048) return c0;
    if (c0 < 3072) { const int isu = c0 >= 2560, ch = c0 - (isu ? 2560 : 2048); return 2048 + (ch >> 7) * 256 + isu * 128 + (ch & 127); }
    return c0;
}
DEV void p0_prologue(Frame& F, const Args& a) {
    const float* c = (const float*)a.in[1]; const int* pos = (const int*)a.in[2]; const float* w_ada = (const float*)a.in[3]; const float* b_ada = (const float*)a.in[4];
    float* MOD = (float*)(F.ws + WS_MOD); float* ROPE = (float*)(F.ws + WS_ROPE);
    {
        LAS float* ca = (LAS float*)F.lds;
        LAS float* part = (LAS float*)(F.lds + 16384);
        for (int i = F.tid; i < 4 * DM; i += NTHR) { const float v = c[i]; ca[i] = v / (1.f + expf(-v)); }
        __syncthreads();
        for (int ch = blockIdx.x; ch < 256; ch += F.G) {
            const int col = F.tid % 24, ks = F.tid / 24;
            if (ks < 21) {
                float a0 = 0.f, a1 = 0.f, a2 = 0.f, a3 = 0.f;
                const float* wp = w_ada + (size_t)ks * 6144 + ch * 24 + col;
                for (int k = ks; k < DM; k += 21 * 13) {
                    float w[13];
#pragma unroll
                    for (int j = 0; j < 13; ++j) w[j] = (k + 21 * j < DM) ? __builtin_nontemporal_load(wp + (size_t)(k - ks + 21 * j) * 6144) : 0.f;
#pragma unroll
                    for (int j = 0; j < 13; ++j) { const int kk = (k + 21 * j < DM) ? k + 21 * j : 0; a0 += ca[kk] * w[j]; a1 += ca[DM + kk] * w[j]; a2 += ca[2 * DM + kk] * w[j]; a3 += ca[3 * DM + kk] * w[j]; }
                }
                part[(ks * 4 + 0) * 24 + col] = a0; part[(ks * 4 + 1) * 24 + col] = a1; part[(ks * 4 + 2) * 24 + col] = a2; part[(ks * 4 + 3) * 24 + col] = a3;
            }
            __syncthreads();
            if (F.tid < 96) { const int b = F.tid / 24, cc = F.tid % 24; float s = b_ada[ch * 24 + cc];
                for (int q = 0; q < 21; ++q) s += part[(q * 4 + b) * 24 + cc];
                __hip_atomic_store(MOD + b * 6144 + ch * 24 + cc, s, __ATOMIC_RELAXED, __HIP_MEMORY_SCOPE_AGENT); }
            asm volatile("s_waitcnt vmcnt(0)" ::: "memory");
            __syncthreads();
            if (F.tid == 0) __hip_atomic_fetch_add(F.ctl + CW_MODC, 1u, __ATOMIC_RELAXED, __HIP_MEMORY_SCOPE_AGENT);
        }
    }
    const int gt = F.vcu * NTHR + F.tid, NGT = F.G * NTHR;
    for (int idx = gt; idx < M * 32; idx += NGT) {
        const int row = idx >> 5, i = idx & 31;
        const float inv = exp2f(-(float)i * (13.287712379549449f / 32.f));
        float s, cs; sincosf((float)pos[row] * inv, &s, &cs);
        __hip_atomic_store((unsigned long long*)(ROPE + idx * 2), (unsigned long long)__float_as_uint(cs) | ((unsigned long long)__float_as_uint(s) << 32), __ATOMIC_RELAXED, __HIP_MEMORY_SCOPE_AGENT);
    }
    {
        const float* w_grp = (const float*)a.in[17]; const float* w_exr = (const float*)a.in[19];
        bf16_t* RH = (bf16_t*)(F.ws + WS_WT_R); bf16_t* RL = RH + 48 * DM;
        for (int idx = gt; idx < 48 * DM; idx += NGT) { const int n = idx >> 10, k = idx & 1023;
            const float w = n < 4 ? w_grp[k * 4 + n] : (n < 36 ? w_exr[k * 32 + (n - 4)] : 0.f);
            const bf16_t h = f2bf(w); __hip_atomic_store((unsigned short*)(RH + idx), (unsigned short)h, __ATOMIC_RELAXED, __HIP_MEMORY_SCOPE_AGENT); __hip_atomic_store((unsigned short*)(RL + idx), (unsigned short)f2bf(w - bf2f(h)), __ATOMIC_RELAXED, __HIP_MEMORY_SCOPE_AGENT); }
    }
    __syncthreads();
    LAS float* scr = (LAS float*)(F.lds + F.wave * 16384);
    const int gw = F.vcu * NWAVES + F.wave, NGW = F.G * NWAVES;
    constexpr int I_IN = 16 * 160, I_A = 8 * 32, I_O = 16 * 32, I_G = 32 * 16 * 8, I_D = 32 * 4 * 32;
    constexpr int NITEMS = I_IN + 2 * I_A + I_O + 2 * I_G;
    (void)I_D;
    auto decode = [&](int it) -> TrItem {
        TrItem t; int r = it;
        if (r < I_IN) { const int kb = r / 160, nb = r % 160; t.W = (const float*)a.in[6]; t.N = INW; t.WT = (bf16_t*)(F.ws + WS_WT_IN); t.ldd = DM; t.k0 = kb * 64; t.kd0 = t.k0; t.n0 = nb * 32; t.drow0 = in_row_map(nb * 32); return t; } r -= I_IN;
        if (r < I_A) { const int kb = r / 32, nb = r % 32; t.W = (const float*)a.in[13]; t.N = DM; t.WT = (bf16_t*)(F.ws + WS_WT_A); t.ldd = 1024; t.k0 = kb * 64; t.kd0 = t.k0; t.n0 = nb * 32; t.drow0 = nb * 32; return t; } r -= I_A;
        if (r < I_A) { const int kb = r / 32, nb = r % 32; t.W = (const float*)a.in[14]; t.N = DM; t.WT = (bf16_t*)(F.ws + WS_WT_A); t.ldd = 1024; t.k0 = kb * 64; t.kd0 = 512 + t.k0; t.n0 = nb * 32; t.drow0 = nb * 32; return t; } r -= I_A;
        if (r < I_O) { const int kb = r / 32, nb = r % 32; t.W = (const float*)a.in[15]; t.N = DM; t.WT = (bf16_t*)(F.ws + WS_WT_O); t.ldd = DM; t.k0 = kb * 64; t.kd0 = t.k0; t.n0 = nb * 32; t.drow0 = nb * 32; return t; } r -= I_O;
        if (r < 2 * I_G) { const int isu = r >= I_G; if (isu) r -= I_G; const int e = r / 128, q = r % 128, kb = q / 8, nb = q % 8, n0 = nb * 32;
            t.W = (const float*)a.in[isu ? 22 : 21] + (size_t)e * DM * FF; t.N = FF; t.WT = (bf16_t*)(F.ws + WS_WT_GU) + (size_t)e * 512 * DM; t.ldd = DM; t.k0 = kb * 64; t.kd0 = t.k0; t.n0 = n0; t.drow0 = (n0 >> 7) * 256 + isu * 128 + (n0 & 127); return t; } r -= 2 * I_G;
        { const int e = r / 128, q = r % 128, kb = q / 32, nb = q % 32;
          t.W = (const float*)a.in[23] + (size_t)e * FF * DM; t.N = DM; t.WT = (bf16_t*)(F.ws + WS_WT_D) + (size_t)e * DM * FF; t.ldd = FF; t.k0 = kb * 64; t.kd0 = t.k0; t.n0 = nb * 32; t.drow0 = nb * 32; return t; }
    };
    const __amdgpu_buffer_rsrc_t wrsrc = __builtin_amdgcn_make_buffer_rsrc((void*)(F.ws + WS_WEIGHTS), 0, 64 * 1024 * 1024, 0x00020000);
    if (gw < NITEMS) {
        TrItem cur = decode(gw); f32x4 rc[8]; tr_load(cur, rc, F.lane);
        for (int it = gw; it < NITEMS; it += NGW) {
            const int nx = it + NGW; TrItem nxt = cur; f32x4 rn[8];
            if (nx < NITEMS) { nxt = decode(nx); tr_load(nxt, rn, F.lane); }
            tr_emit<true>(cur, rc, scr, F.lane, wrsrc, (const bf16_t*)(F.ws + WS_WEIGHTS));
            if (nx < NITEMS) { cur = nxt;
#pragma unroll
                for (int i = 0; i < 8; ++i) rc[i] = rn[i]; }
        }
    }
    asm volatile("s_waitcnt vmcnt(0)" ::: "memory"); __syncthreads();
    if (F.tid == 0) __hip_atomic_fetch_add(F.ctl + CW_P0C, 1u, __ATOMIC_RELAXED, __HIP_MEMORY_SCOPE_AGENT);
}

DEV void p7_wdown_transposes(Frame& F, const Args& a, int worker, int nworkers, unsigned* wdc) {
    LAS float* scr = (LAS float*)(F.lds + F.wave * 16384);
    constexpr int I_D = 32 * 4 * 32;
    auto decode = [&](int r) -> TrItem { TrItem t; const int e = r / 128, q = r % 128, kb = q / 32, nb = q % 32;
        t.W = (const float*)a.in[23] + (size_t)e * FF * DM; t.N = DM; t.WT = (bf16_t*)(F.ws + WS_WT_D) + (size_t)e * DM * FF; t.ldd = FF; t.k0 = kb * 64; t.kd0 = t.k0; t.n0 = nb * 32; t.drow0 = nb * 32; return t; };
    const int gw = worker * NWAVES + F.wave, NGW = nworkers * NWAVES;
    const __amdgpu_buffer_rsrc_t wrsrc = __builtin_amdgcn_make_buffer_rsrc((void*)(F.ws + WS_WEIGHTS), 0, 64 * 1024 * 1024, 0x00020000);
    if (gw < I_D) {
        TrItem cur = decode(gw); f32x4 rc[8]; tr_load(cur, rc, F.lane);
        for (int it = gw; it < I_D; it += NGW) {
            const int nx = it + NGW; TrItem nxt = cur; f32x4 rn[8];
            if (nx < I_D) { nxt = decode(nx); tr_load(nxt, rn, F.lane); }
            tr_emit<true>(cur, rc, scr, F.lane, wrsrc, (const bf16_t*)(F.ws + WS_WEIGHTS));
            if (nx < I_D) { cur = nxt;
#pragma unroll
                for (int i = 0; i < 8; ++i) rc[i] = rn[i]; }
        }
    }
    asm volatile("s_waitcnt vmcnt(0)" ::: "memory"); __syncthreads();
    if (F.tid == 0) __hip_atomic_fetch_add(wdc, 1u, __ATOMIC_RELAXED, __HIP_MEMORY_SCOPE_AGENT);
}
DEV void p1_h(Frame& F, const Args& a) {
    { unsigned sp = 0;
      while (__builtin_amdgcn_readfirstlane(__hip_atomic_load(F.ctl + CW_MODC, __ATOMIC_RELAXED, __HIP_MEMORY_SCOPE_AGENT)) < 256u) { __builtin_amdgcn_s_sleep(8); if (++sp > (1u << 20)) break; }
      asm volatile("" ::: "memory"); }
    const float* x = (const float*)a.in[0]; const float* g = (const float*)a.in[5]; const float* MOD = (const float*)(F.ws + WS_MOD); bf16_t* Hb = (bf16_t*)(F.ws + WS_H);
    for (int ch = F.vcu; ch < M / 64; ch += F.G) {
    for (int m0 = ch * 64 + F.wave; m0 < ch * 64 + 64; m0 += 2 * NWAVES) {
        const int m1 = m0 + NWAVES;
        const GAS f32x4* xr0 = (const GAS f32x4*)(x + (size_t)m0 * DM) + F.lane; const GAS f32x4* xr1 = (const GAS f32x4*)(x + (size_t)m1 * DM) + F.lane;
        f32x4 v0[4], v1[4]; float s0 = 0.f, s1 = 0.f;
#pragma unroll
        for (int j = 0; j < 4; ++j) { v0[j] = __builtin_nontemporal_load(xr0 + 64 * j); v1[j] = __builtin_nontemporal_load(xr1 + 64 * j); }
#pragma unroll
        for (int j = 0; j < 4; ++j) { s0 += (v0[j].x * v0[j].x + v0[j].y * v0[j].y) + (v0[j].z * v0[j].z + v0[j].w * v0[j].w); s1 += (v1[j].x * v1[j].x + v1[j].y * v1[j].y) + (v1[j].z * v1[j].z + v1[j].w * v1[j].w); }
        const float r0 = rsqrtf(wave_sum(s0) * (1.f / DM) + EPS), r1 = rsqrtf(wave_sum(s1) * (1.f / DM) + EPS);
        const float* md0 = MOD + (m0 / SEQ) * 6144; const float* md1 = MOD + (m1 / SEQ) * 6144;
        GAS unsigned long long* o0 = (GAS unsigned long long*)(Hb + (size_t)m0 * DM) + F.lane; GAS unsigned long long* o1 = (GAS unsigned long long*)(Hb + (size_t)m1 * DM) + F.lane;
#pragma unroll
        for (int j = 0; j < 4; ++j) { const int k = 4 * F.lane + 256 * j; const f32x4 gg = *(const f32x4*)(g + k);
            const f32x4 h0 = v0[j] * r0 * gg * (*(const f32x4*)(md0 + 1024 + k) + 1.f) + *(const f32x4*)(md0 + k);
            const f32x4 h1 = v1[j] * r1 * gg * (*(const f32x4*)(md1 + 1024 + k) + 1.f) + *(const f32x4*)(md1 + k);
            __hip_atomic_store((unsigned long long*)(o0 + 64 * j), (unsigned long long)pk2(h0.x, h0.y) | ((unsigned long long)pk2(h0.z, h0.w) << 32), __ATOMIC_RELAXED, __HIP_MEMORY_SCOPE_AGENT);
            __hip_atomic_store((unsigned long long*)(o1 + 64 * j), (unsigned long long)pk2(h1.x, h1.y) | ((unsigned long long)pk2(h1.z, h1.w) << 32), __ATOMIC_RELAXED, __HIP_MEMORY_SCOPE_AGENT); }
    }
    asm volatile("s_waitcnt vmcnt(0)" ::: "memory"); __syncthreads();
    if (F.tid == 0) __hip_atomic_fetch_add(F.ctl + CW_PC1 + (ch >> 2) * 16, 1u, __ATOMIC_RELAXED, __HIP_MEMORY_SCOPE_AGENT);
    }
}

namespace att {
typedef short bf16x8 __attribute__((ext_vector_type(8)));
typedef short s16x4 __attribute__((ext_vector_type(4)));
typedef float f32x16 __attribute__((ext_vector_type(16)));
typedef float f32x4 __attribute__((ext_vector_type(4)));
typedef unsigned u32x4 __attribute__((ext_vector_type(4)));
constexpr int LD = 512;
constexpr int LDO = 1024;
constexpr int NW = 8, QBLK = 32, KVBLK = 64, QB = 128, NQB = SEQ / QB;
constexpr int SHM_V = KVBLK * 128 * 2, SHM_K = KVBLK * 128 * 2;
constexpr int LDS_WS = 2 * SHM_V + 2 * SHM_K, LDS_XCH = LDS_WS + NW * 64 * 4, LDS_END = LDS_XCH + 4 * 32 * 128 * 4;
constexpr float SCALE = 0.125f, THR = 8.f;
#define KSWZ(row, colB) ((row) * 256 + ((colB) ^ (((row) & 7) << 4)))
#define SBAR() __builtin_amdgcn_sched_barrier(0)
__device__ __forceinline__ int v_st(int k, int c) { const int kk = (k & ~0xC) | ((k & 4) << 1) | ((k & 8) >> 1); return ((kk >> 3) * 4 + (c >> 5)) * 512 + ((kk & 7) * 32 + (c & 31)) * 2; }
__device__ __forceinline__ int v_rd_base(int lane) { return ((lane & 3) << 3) | (((lane >> 2) & 3) << 6) | (((lane >> 4) & 1) << 5) | (((lane >> 5) & 1) << 8); }
constexpr int v_rd_off(int d0, int ks, int half) { return d0 * 512 + ks * 4096 + half * 2048; }
__device__ __forceinline__ int crow(int r, int hi) { return (r & 3) + 8 * (r >> 2) + 4 * hi; }
typedef float f32x2a_t __attribute__((ext_vector_type(2))); typedef __bf16 bf16x2a_t __attribute__((ext_vector_type(2)));
__device__ __forceinline__ unsigned cvtpk(float lo, float hi) { f32x2a_t v = {lo, hi}; bf16x2a_t b = __builtin_convertvector(v, bf16x2a_t); return __builtin_bit_cast(unsigned, b); }
__device__ __forceinline__ bf16x8 load8(const bf16_t* p) { return *reinterpret_cast<const bf16x8*>(p); }
template <int CTRL> __device__ __forceinline__ float dppf(float v) { return __int_as_float(__builtin_amdgcn_update_dpp(0, __float_as_int(v), CTRL, 0xF, 0xF, true)); }
__device__ __forceinline__ void mask_tile(f32x16& p0, f32x16& p1, int dq) {
    const float NEG = -__builtin_inff();
#pragma unroll
    for (int r = 0; r < 16; ++r) { const int c = (r & 3) + 8 * (r >> 2); if (dq - c < 0) p0[r] = NEG; if (dq - c - 32 < 0) p1[r] = NEG; }
}
__device__ __forceinline__ void partialSM(f32x16& p0, f32x16& p1, float& m_reg, float& mn, float& alpha) {
    float pmax = p0[0]; for (int r = 1; r < 16; ++r) pmax = fmaxf(pmax, p0[r]); for (int r = 0; r < 16; ++r) pmax = fmaxf(pmax, p1[r]);
    { auto rr = __builtin_amdgcn_permlane32_swap(__float_as_uint(pmax), __float_as_uint(pmax), false, false);
      pmax = fmaxf(__uint_as_float(rr[0]), __uint_as_float(rr[1])); }
    constexpr float C2 = 1.4426950408889634f * SCALE;
    if (__builtin_expect(__all((pmax - m_reg) * SCALE <= THR), 1)) { mn = m_reg; alpha = 1.f; }
    else { mn = fmaxf(m_reg, pmax); alpha = __builtin_amdgcn_exp2f((m_reg - mn) * C2); m_reg = mn; }
    const float mnL = -mn * C2;
    for (int r = 0; r < 16; ++r) p0[r] = fmaf(p0[r], C2, mnL); for (int r = 0; r < 16; ++r) p1[r] = fmaf(p1[r], C2, mnL);
    for (int r = 0; r < 16; ++r) p0[r] = __builtin_amdgcn_exp2f(p0[r]);
}
__device__ __forceinline__ void finishSM(f32x16& p0, f32x16& p1, float alpha, float& l_reg, bf16x8& pa0, bf16x8& pa1, bf16x8& pa2, bf16x8& pa3) {
    for (int r = 0; r < 16; ++r) p1[r] = __builtin_amdgcn_exp2f(p1[r]);
    float ps = 0; for (int r = 0; r < 16; ++r) ps += p0[r]; for (int r = 0; r < 16; ++r) ps += p1[r];
    { auto rr = __builtin_amdgcn_permlane32_swap(__float_as_uint(ps), __float_as_uint(ps), false, false);
      ps = __uint_as_float(rr[0]) + __uint_as_float(rr[1]); }
    l_reg = l_reg * alpha + ps;
#define PK4(P, B_, OUT) do { unsigned a0 = cvtpk(P[B_+0], P[B_+1]), a1 = cvtpk(P[B_+2], P[B_+3]);                          \
        unsigned b0 = cvtpk(P[B_+4], P[B_+5]), b1 = cvtpk(P[B_+6], P[B_+7]);                                             \
        auto r0 = __builtin_amdgcn_permlane32_swap(a0, b0, false, false); auto r1 = __builtin_amdgcn_permlane32_swap(a1, b1, false, false); \
        u32x4 w = {r0[0], r1[0], r0[1], r1[1]}; OUT = *reinterpret_cast<bf16x8*>(&w); } while (0)
    PK4(p0, 0, pa0); PK4(p0, 8, pa1); PK4(p1, 0, pa2); PK4(p1, 8, pa3);
#undef PK4
}
template <int KB>
__device__ __forceinline__ void qkt(f32x16& p0, f32x16& p1, const char* K_lds, int r32, int hi, int mp, const bf16x8* qr) {
    p0 = f32x16{}; p1 = f32x16{};
    const char* kb[4];
#pragma unroll
    for (int dd = 0; dd < 4; ++dd) kb[dd] = K_lds + KB * SHM_K + KSWZ(r32, (dd * 16 + hi * 8) * 2) + mp * 128;

#pragma unroll
    for (int d0 = 0; d0 < 4; ++d0) { const char* a = kb[d0];
        bf16x8 b0 = *reinterpret_cast<const bf16x8*>(a);
        bf16x8 b1 = *reinterpret_cast<const bf16x8*>(a + 32 * 256);
        p0 = __builtin_amdgcn_mfma_f32_32x32x16_bf16(b0, qr[d0], p0, 0, 0, 0);
        p1 = __builtin_amdgcn_mfma_f32_32x32x16_bf16(b1, qr[d0], p1, 0, 0, 0); }

}
template <int VB>
__device__ __forceinline__ void pv_tile(f32x16* o, int vb0, bf16x8 pa0, bf16x8 pa1, bf16x8 pa2, bf16x8 pa3) {
#define TRRD(dst, off) asm volatile("ds_read_b64_tr_b16 %0, %1 offset:%2" : "=&v"(dst) : "v"(vb0), "i"(off) : "memory")
#define PV_RD(S, d0) do { constexpr int b_ = VB * SHM_V + v_rd_off(d0, 0, 0); \
        TRRD(S##l0, b_); TRRD(S##h0, b_ + 2048); TRRD(S##l1, b_ + 4096); TRRD(S##h1, b_ + 6144); TRRD(S##l2, b_ + 8192); TRRD(S##h2, b_ + 10240); TRRD(S##l3, b_ + 12288); TRRD(S##h3, b_ + 14336); } while (0)
#define PV_MM(S, d0) do { \
        o[d0] = __builtin_amdgcn_mfma_f32_32x32x16_bf16(pa0, (bf16x8){S##l0[0], S##l0[1], S##l0[2], S##l0[3], S##h0[0], S##h0[1], S##h0[2], S##h0[3]}, o[d0], 0, 0, 0);   \
        o[d0] = __builtin_amdgcn_mfma_f32_32x32x16_bf16(pa1, (bf16x8){S##l1[0], S##l1[1], S##l1[2], S##l1[3], S##h1[0], S##h1[1], S##h1[2], S##h1[3]}, o[d0], 0, 0, 0);   \
        o[d0] = __builtin_amdgcn_mfma_f32_32x32x16_bf16(pa2, (bf16x8){S##l2[0], S##l2[1], S##l2[2], S##l2[3], S##h2[0], S##h2[1], S##h2[2], S##h2[3]}, o[d0], 0, 0, 0);   \
        o[d0] = __builtin_amdgcn_mfma_f32_32x32x16_bf16(pa3, (bf16x8){S##l3[0], S##l3[1], S##l3[2], S##l3[3], S##h3[0], S##h3[1], S##h3[2], S##h3[3]}, o[d0], 0, 0, 0); } while (0)
    s16x4 al0, al1, al2, al3, ah0, ah1, ah2, ah3, bl0, bl1, bl2, bl3, bh0, bh1, bh2, bh3;

    PV_RD(a, 0);
    PV_RD(b, 1); asm volatile("s_waitcnt lgkmcnt(8)" ::: "memory"); SBAR(); PV_MM(a, 0); SBAR();
    PV_RD(a, 2); asm volatile("s_waitcnt lgkmcnt(8)" ::: "memory"); SBAR(); PV_MM(b, 1); SBAR();
    PV_RD(b, 3); asm volatile("s_waitcnt lgkmcnt(8)" ::: "memory"); SBAR(); PV_MM(a, 2); SBAR();
    asm volatile("s_waitcnt lgkmcnt(0)" ::: "memory"); SBAR(); PV_MM(b, 3);

#undef PV_MM
#undef PV_RD
#undef TRRD
}
struct BlockRef { int qoff, koff, P0, ooff; };
struct Bufs { const bf16_t* Q; const bf16_t* K; const bf16_t* V; bf16_t* O; };
struct Seam { bf16x8 qr[4]; bf16x8 st_v0, st_v1, st_k0, st_k1; };
#define ROW(p, k0, rr) ((p) + (size_t)((k0) + (rr)) * LD + sc)
#define VMW() asm volatile("s_waitcnt vmcnt(0)" ::: "memory")
#define VMWN(n) asm volatile("s_waitcnt vmcnt(%0)" :: "i"(n) : "memory")
#define SLOAD_H(Kp, Vp, k0) do { S.st_v0 = load8(ROW(Vp, k0, sr)); S.st_v1 = load8(ROW(Vp, k0, 32 + sr));              \
                         S.st_k0 = load8(ROW(Kp, k0, sr)); S.st_k1 = load8(ROW(Kp, k0, 32 + sr)); } while (0)
#define SWRITE_HK(bf) do { *(bf16x8*)(K_lds + (bf) * SHM_K + kws) = S.st_k0; *(bf16x8*)(K_lds + (bf) * SHM_K + kws + 32 * 256) = S.st_k1; } while (0)
#define SWRITE_HV(bf) do { *(bf16x8*)(V_lds + (bf) * SHM_V + vst0) = S.st_v0; *(bf16x8*)(V_lds + (bf) * SHM_V + vst1) = S.st_v1; } while (0)
#define SWRITE_H(bf) do { SWRITE_HV(bf); SWRITE_HK(bf); } while (0)
__device__ __forceinline__ void attn_prime(const Bufs& B, const BlockRef& cur, char* lds, Seam& S) {
    const int tid = threadIdx.x, wid = __builtin_amdgcn_readfirstlane(tid >> 6), lane = tid & 63, r32 = lane & 31, hi = lane >> 5, wq = wid & 3, mp = wid >> 2;
    const int sr = tid >> 4, sc = (tid & 15) * 8, kws = KSWZ(sr, sc * 2); char* K_lds = lds + 2 * SHM_V;
#pragma unroll
    for (int d0 = 0; d0 < 4; ++d0) S.qr[d0] = load8(B.Q + cur.qoff + (size_t)(wq * QBLK + r32) * LD + mp * 64 + d0 * 16 + hi * 8);
    SLOAD_H(B.K + cur.koff, B.V + cur.koff, 0); VMW(); SWRITE_HK(0);
    __syncthreads();
}
__device__ __forceinline__ void attn_block(const Bufs& B, const BlockRef& cur, const BlockRef& nxt, char* lds, LAS unsigned char* ldsl, Seam& S, float lam, const float* __restrict__ subln_g) {
    const int tid = threadIdx.x, wid = __builtin_amdgcn_readfirstlane(tid >> 6), lane = tid & 63, r32 = lane & 31, hi = lane >> 5, wq = wid & 3, mp = wid >> 2;
    const int NT = (cur.P0 + QB - 1) / KVBLK + 1;
    const int qlo = cur.P0 + wq * QBLK, qm = qlo + r32 - 4 * hi;
    char* V_lds = lds; char* K_lds = lds + 2 * SHM_V;
    float* ws = (float*)(lds + LDS_WS) + wid * 64; float* li_l = ws, * al_l = ws + 32;
    float m_reg = -1e30f, l_reg = 0; f32x16 o[4] = {};
    const int sr = tid >> 4, sc = (tid & 15) * 8, vst0 = v_st(sr, sc), vst1 = v_st(32 + sr, sc), kws = KSWZ(sr, sc * 2);
    const int vb0 = (int)(uintptr_t)V_lds + v_rd_base(lane);
    const bf16_t* Kh = B.K + cur.koff; const bf16_t* Vh = B.V + cur.koff;
    int kso0, vso0;
    { const int r0 = (wid * 2) * 4 + (lane >> 4); kso0 = r0 * LD + (((lane & 15) ^ (r0 & 7)) << 3);
      const int b0_ = (wid * 2) * 2 + (lane >> 5), kl = (lane & 31) >> 2, cl = (lane & 3) * 8;
      const int kk0 = (b0_ >> 2) * 8 + kl;
      const int k0_ = (kk0 & ~0xC) | ((kk0 & 4) << 1) | ((kk0 & 8) >> 1);
      vso0 = k0_ * LD + (b0_ & 3) * 32 + cl; }
#define DMA_K(bf, tile) do { const bf16_t* kp_ = Kh + (size_t)KBASE(tile) * LD;                                                                         \
        __builtin_amdgcn_global_load_lds((const unsigned*)(kp_ + kso0), (LAS unsigned*)(ldsl + 2 * SHM_V + (bf) * SHM_K + wid * 2048), 16, 0, 0);          \
        __builtin_amdgcn_global_load_lds((const unsigned*)(kp_ + ((kso0 ^ 32) + 4 * LD)), (LAS unsigned*)(ldsl + 2 * SHM_V + (bf) * SHM_K + wid * 2048 + 1024), 16, 0, 0); } while (0)
#define DMA_V(bf, tile) do { const bf16_t* vp_ = Vh + (size_t)KBASE(tile) * LD;                                                                         \
        __builtin_amdgcn_global_load_lds((const unsigned*)(vp_ + vso0), (LAS unsigned*)(ldsl + (bf) * SHM_V + wid * 2048), 16, 0, 0);                      \
        __builtin_amdgcn_global_load_lds((const unsigned*)(vp_ + vso0 + 64), (LAS unsigned*)(ldsl + (bf) * SHM_V + wid * 2048 + 1024), 16, 0, 0); } while (0)
#define RESC(a) do { if (__any((a) < 1.f)) { if (hi == 0) al_l[r32] = (a); asm volatile("s_waitcnt lgkmcnt(0)" ::: "memory");              \
                     for (int d_ = 0; d_ < 4; ++d_) for (int r = 0; r < 16; ++r) o[d_][r] *= al_l[crow(r, hi)]; } } while (0)
#define KBASE(t) ((t) * KVBLK)
#define MASKT(P0_, P1_, t) do { const int kb_ = KBASE(t); if (kb_ + KVBLK - 1 > qlo) mask_tile(P0_, P1_, qm - kb_); } while (0)
    constexpr int NQL = 4;
#define SEAM_K0() do { VMWN(NQL); SWRITE_HK(0); SBAR(); } while (0)
    f32x16 pA0, pA1, pB0, pB1; float mnA, mnB, alA, alB; bf16x8 pa0, pa1, pa2, pa3;
    SWRITE_HV(0); SBAR();
    if (NT > 1) { SLOAD_H(Kh, Vh, KBASE(1)); }
    SBAR(); qkt<0>(pA0, pA1, K_lds, r32, hi, mp, S.qr);
    if (mp == 0) { MASKT(pA0, pA1, 0); partialSM(pA0, pA1, m_reg, mnA, alA); }
    if (NT > 1) { VMW(); SWRITE_H(1); }
    __syncthreads();
#define HALF_STEP(PX0, PX1, mnX, alX, PY0, PY1, mnY, alY, t, KB, VB, SB) do {                                                 \
        SBAR();                                                                                                               \
        if ((t) + 1 < NT) DMA_K(SB, (t) + 1);                    \
        DMA_V(KB, (t));                                         \
          \
          \
        if (mp == 1) { MASKT(PY0, PY1, (t) - 1); partialSM(PY0, PY1, m_reg, mnY, alY); RESC(alY); }                            \
        SBAR(); qkt<KB>(PX0, PX1, K_lds, r32, hi, mp, S.qr);                                                                   \
        finishSM(PY0, PY1, alY, l_reg, pa0, pa1, pa2, pa3); SBAR();                                                           \
        pv_tile<VB>(o, vb0, pa0, pa1, pa2, pa3);                                                                               \
        if (mp == 0) { MASKT(PX0, PX1, (t)); partialSM(PX0, PX1, m_reg, mnX, alX); RESC(alX); }                               \
        VMW();                                                                    \
        __syncthreads(); } while (0)
    for (int t = 1; t + 1 < NT; t += 2) {
        HALF_STEP(pB0, pB1, mnB, alB, pA0, pA1, mnA, alA, t, 1, 0, 0);
        HALF_STEP(pA0, pA1, mnA, alA, pB0, pB1, mnB, alB, t + 1, 0, 1, 1);
    }
    const bool even = (NT & 1) == 0;
    if (mp == 1) { MASKT(pA0, pA1, even ? NT - 2 : NT - 1); partialSM(pA0, pA1, m_reg, mnA, alA); RESC(alA); }
    if (even) { DMA_V(1, NT - 1); SBAR(); qkt<1>(pB0, pB1, K_lds, r32, hi, mp, S.qr); SBAR(); }
    SLOAD_H(B.K + nxt.koff, B.V + nxt.koff, 0); SBAR();
#pragma unroll
    for (int d0 = 0; d0 < 4; ++d0) S.qr[d0] = load8(B.Q + nxt.qoff + (size_t)(wq * QBLK + r32) * LD + mp * 64 + d0 * 16 + hi * 8);
    SBAR();
    finishSM(pA0, pA1, alA, l_reg, pa0, pa1, pa2, pa3); SBAR();
    pv_tile<0>(o, vb0, pa0, pa1, pa2, pa3);
    if (even) { MASKT(pB0, pB1, NT - 1); partialSM(pB0, pB1, m_reg, mnB, alB); VMW(); __syncthreads(); RESC(alB);
        finishSM(pB0, pB1, alB, l_reg, pa0, pa1, pa2, pa3); SBAR(); pv_tile<1>(o, vb0, pa0, pa1, pa2, pa3); }
    SBAR(); SEAM_K0();
    int r32e = lane & 31, hie = lane >> 5; asm volatile("" : "+v"(r32e), "+v"(hie));
    if (hie == 0) li_l[r32e] = l_reg; asm volatile("s_waitcnt lgkmcnt(0)" ::: "memory");
    float* xch = (float*)(lds + LDS_XCH) + wq * 4096;
#define EP_SEND(R0) do { float rlv[8]; _Pragma("unroll") for (int r8 = 0; r8 < 8; ++r8) rlv[r8] = __builtin_amdgcn_rcpf(li_l[crow((R0) + r8, hie)]);                   \
        _Pragma("unroll") for (int r8 = 0; r8 < 8; ++r8) { const int r = (R0) + r8; const int orow = crow(r, hie);                                             \
            _Pragma("unroll") for (int d0 = 0; d0 < 4; ++d0) xch[orow * 128 + d0 * 32 + r32e] = o[d0][r] * rlv[r8]; } } while (0)
#define EP_PROC(R0, OWN1) do { float dd[8][4], ssv[8];                                                                                                       \
        _Pragma("unroll") for (int r8 = 0; r8 < 8; ++r8) { const int r = (R0) + r8; const int orow = crow(r, hie); const float rl = __builtin_amdgcn_rcpf(li_l[orow]); float ss = 0.f; \
            _Pragma("unroll") for (int d0 = 0; d0 < 4; ++d0) { const float own = o[d0][r] * rl, oth = xch[orow * 128 + d0 * 32 + r32e]; const float dv = (OWN1) ? own - lam * oth : oth - lam * own; dd[r8][d0] = dv; ss += dv * dv; } \
            ssv[r8] = ss; }                                                                                                                                    \
          \
        _Pragma("unroll") for (int r8 = 0; r8 < 8; ++r8) { float t = ssv[r8]; t += dppf<0xB1>(t); t += dppf<0x4E>(t); t += dppf<0x141>(t); t += dppf<0x140>(t); ssv[r8] = t; } \
        float sx[8]; _Pragma("unroll") for (int r8 = 0; r8 < 8; ++r8) sx[r8] = __shfl_xor(ssv[r8], 16);                                                         \
        _Pragma("unroll") for (int r8 = 0; r8 < 8; ++r8) { const int r = (R0) + r8; const int crel = (r & 3) + 8 * (r >> 2); const float rs = rsqrtf((ssv[r8] + sx[r8]) * (1.f / 128.f) + EPS); \
            _Pragma("unroll") for (int d0 = 0; d0 < 4; ++d0) { const float v = dd[r8][d0] * rs * gv[d0]; const float vn = dppf<0xB1>(v);                          \
                if ((r32e & 1) == 0) __hip_atomic_store((unsigned*)(B.O + obase + crel * LDO + d0 * 32), cvtpk(v, vn), __ATOMIC_RELAXED, __HIP_MEMORY_SCOPE_AGENT); } } } while (0)
    if (mp == 0) { asm volatile("" ::: "memory"); EP_SEND(8); } else EP_SEND(0);
    __syncthreads();
    {
        float gv[4];
#pragma unroll
        for (int d0 = 0; d0 < 4; ++d0) gv[d0] = subln_g[d0 * 32 + r32e] * (1.f - LAMBDA_INIT);
        int obase = cur.ooff + (wq * QBLK + 4 * hie) * LDO + r32e; asm volatile("" : "+v"(obase));
        if (mp == 0) EP_PROC(0, true); else EP_PROC(8, false);
    }
    __syncthreads();
#undef EP_SEND
#undef EP_PROC
#undef RESC
#undef DMA_K
#undef DMA_V
#undef KBASE
#undef MASKT
#undef SEAM_K0
#undef HALF_STEP
}
#undef ROW
#undef VMW
#undef VMWN
#undef SLOAD_H
#undef SWRITE_HK
#undef SWRITE_HV
#undef SWRITE_H
#undef KSWZ
#undef SBAR
}

DEV void p3_attn_conv(Frame& F, const Args& a, char* lds_generic) {
    const att::Bufs B{(const bf16_t*)(F.ws + WS_Q), (const bf16_t*)(F.ws + WS_K), (const bf16_t*)(F.ws + WS_V), (bf16_t*)(F.ws + WS_ATT)};
    float lam;
    { const float* q1 = (const float*)a.in[7]; const float* k1 = (const float*)a.in[8]; const float* q2 = (const float*)a.in[9]; const float* k2 = (const float*)a.in[10];
      const float s1 = wave_sum(q1[F.lane] * k1[F.lane]), s2 = wave_sum(q2[F.lane] * k2[F.lane]);
      lam = __uint_as_float(__builtin_amdgcn_readfirstlane(__float_as_uint(expf(s1) - expf(s2) + LAMBDA_INIT))); }
    const float* subln_g = (const float*)a.in[11];
    for (int L = F.vcu; L < 256; L += F.G) {
        const int bh = L >> 4, y = L & 15, b = bh >> 2, h = bh & 3;
        const int hb = b * SEQ * att::LD + h * 128;
        const int ob = b * SEQ * att::LDO + h * 128;
        const att::BlockRef b0{hb + y * att::QB * att::LD, hb, y * att::QB, ob + y * att::QB * att::LDO}, b1{hb + (att::NQB - 1 - y) * att::QB * att::LD, hb, (att::NQB - 1 - y) * att::QB, ob + (att::NQB - 1 - y) * att::QB * att::LDO};
        att::Seam S;
        att::attn_prime(B, b0, lds_generic, S);
        att::attn_block(B, b0, b1, lds_generic, F.lds, S, lam, subln_g);
        att::attn_block(B, b1, b1, lds_generic, F.lds, S, lam, subln_g);
    }
    int ctid = threadIdx.x; asm volatile("" : "+v"(ctid));
    const bf16_t* CB = (const bf16_t*)(F.ws + WS_CB); const bf16_t* CCU = (const bf16_t*)(F.ws + WS_CCU); bf16_t* CONV = (bf16_t*)(F.ws + WS_ATT);
    const float* cw = (const float*)a.in[12]; (void)CONV;
    const __amdgpu_buffer_rsrc_t crsrc = __builtin_amdgcn_make_buffer_rsrc((void*)(F.ws + WS_ATT), 0, 32 * 1024 * 1024, 0x00020000);
    const int gt = F.vcu * NTHR + ctid, NGT = F.G * NTHR;
    const int chc = (gt & 63) * 8;
    float cwv[3][8];
#pragma unroll
    for (int j = 0; j < 3; ++j)
#pragma unroll
        for (int i = 0; i < 8; ++i) cwv[j][i] = cw[j * 512 + chc + i];
    for (int idx0 = gt; idx0 < M * 64; idx0 += 4 * NGT) {
        v4u cbv[4], u0[4], u1[4], u2[4];
#pragma unroll
        for (int p = 0; p < 4; ++p) { const int idx = idx0 + p * NGT; const int row = idx >> 6, t = row & (SEQ - 1);
            const size_t off = (size_t)row * 512 + chc;
            cbv[p] = __builtin_nontemporal_load((const v4u*)(CB + off)); u0[p] = *(const v4u*)(CCU + off);
            u1[p] = (v4u){0u, 0u, 0u, 0u}; u2[p] = (v4u){0u, 0u, 0u, 0u};
            if (t >= 1) u1[p] = *(const v4u*)(CCU + off - 512);
            if (t >= 2) u2[p] = *(const v4u*)(CCU + off - 1024); }
#pragma unroll
        for (int p = 0; p < 4; ++p) { const int idx = idx0 + p * NGT; const int row = idx >> 6;
            v4u o;
#pragma unroll
            for (int i = 0; i < 4; ++i) {
                const float y0 = cwv[0][2 * i] * __uint_as_float(u0[p][i] << 16) + cwv[1][2 * i] * __uint_as_float(u1[p][i] << 16) + cwv[2][2 * i] * __uint_as_float(u2[p][i] << 16);
                const float y1 = cwv[0][2 * i + 1] * __uint_as_float(u0[p][i] & 0xffff0000u) + cwv[1][2 * i + 1] * __uint_as_float(u1[p][i] & 0xffff0000u) + cwv[2][2 * i + 1] * __uint_as_float(u2[p][i] & 0xffff0000u);
                o[i] = pk2(__uint_as_float(cbv[p][i] << 16) * y0, __uint_as_float(cbv[p][i] & 0xffff0000u) * y1);
            }
            __builtin_amdgcn_raw_buffer_store_b128(o, crsrc, (row * 1024 + 512 + chc) * 2, 0, 16  ); }
    }
}

constexpr size_t WS_X1B = 72 * MiB;
constexpr size_t WS_ELT = 250 * MiB;
constexpr size_t WS_ELW = 252 * MiB;
constexpr size_t WS_TOKP = 254 * MiB;
constexpr size_t WS_ACT = 104 * MiB;
constexpr size_t WS_Y = 168 * MiB;
constexpr int CW_CNT = 32768;
constexpr int CW_DONE = 40960;
constexpr int CW_PC4 = 50176, CW_PC5 = 51200;
constexpr int CW_WDC = 49152;
constexpr int LDS_TAB = 131072;

DEV void p6_route(Frame& F, const Args& a, const bool wait5) {
    typedef float f32x4v __attribute__((ext_vector_type(4)));
    const bf16_t* X1 = (const bf16_t*)(F.ws + WS_X1B); const float* SSQ = (const float*)(F.ws + WS_SSQ); const float* MOD = (const float*)(F.ws + WS_MOD);
    const float* gN = (const float*)a.in[16]; const float* bg = (const float*)a.in[18]; const float* be = (const float*)a.in[20];
    const bf16_t* RH = (const bf16_t*)(F.ws + WS_WT_R); const bf16_t* RL = RH + 48 * DM;
    const __amdgpu_buffer_rsrc_t hrsrc = __builtin_amdgcn_make_buffer_rsrc((void*)(F.ws + WS_H2), 0, 32 * 1024 * 1024, 0x00020000);
    int* ELT = (int*)(F.ws + WS_ELT); float* ELW = (float*)(F.ws + WS_ELW); int* TOKP = (int*)(F.ws + WS_TOKP);
    LAS float* GS = (LAS float*)F.lds; LAS float* SH = GS + DM; LAS float* PL = SH + DM;
    LAS float* LG = PL + 8 * 64 * 48;
    LAS int* lcnt = (LAS int*)(LG + 64 * 48); LAS int* gbase = lcnt + 32;
    const int r = F.lane & 15, q = F.lane >> 4, w = F.wave;
    for (int ch = F.vcu; ch < M / 64; ch += F.G) {
        const int R0 = ch * 64, b = R0 / SEQ; const float* md = MOD + b * 6144;
        for (int k = F.tid; k < DM; k += NTHR) { GS[k] = gN[k] * (1.f + md[4096 + k]); SH[k] = md[3072 + k]; }
        if (F.tid < 32) lcnt[F.tid] = 0;
        if (wait5 && F.tid == 64) {
            unsigned sp = 0; while (__hip_atomic_load(F.ctl + CW_PC5 + (ch >> 2) * 16, __ATOMIC_RELAXED, __HIP_MEMORY_SCOPE_AGENT) < (unsigned)(DM / pg8::BM)) { __builtin_amdgcn_s_sleep(2); if (++sp > (1u << 22)) break; }
            __builtin_amdgcn_fence(__ATOMIC_ACQUIRE, "agent"); asm volatile("s_waitcnt vmcnt(0)" ::: "memory"); }
        __syncthreads();
        float rstd[4];
#pragma unroll
        for (int rg = 0; rg < 4; ++rg) { const f32x4v* sp = (const f32x4v*)(SSQ + (size_t)(R0 + rg * 16 + r) * 16); const f32x4v s0 = sp[0], s1 = sp[1], s2 = sp[2], s3 = sp[3];
            const float ss = ((s0[0] + s0[1]) + (s0[2] + s0[3])) + ((s1[0] + s1[1]) + (s1[2] + s1[3])) + ((s2[0] + s2[1]) + (s2[2] + s2[3])) + ((s3[0] + s3[1]) + (s3[2] + s3[3]));
            rstd[rg] = rsqrtf(ss * (1.f / DM) + EPS); }
        pg8::f32x4 acc[4][3];
#pragma unroll
        for (int rg = 0; rg < 4; ++rg)
#pragma unroll
            for (int n = 0; n < 3; ++n) acc[rg][n] = (pg8::f32x4){0.f, 0.f, 0.f, 0.f};
#pragma unroll
        for (int s = 0; s < 4; ++s) {
            const int k0 = w * 128 + s * 32 + 8 * q;
            bf16x8 bh[3], bl[3];
#pragma unroll
            for (int n = 0; n < 3; ++n) { bh[n] = *(const bf16x8*)(RH + (size_t)(n * 16 + r) * DM + k0); bl[n] = *(const bf16x8*)(RL + (size_t)(n * 16 + r) * DM + k0); }
            v4u xq[4];
#pragma unroll
            for (int rg = 0; rg < 4; ++rg) xq[rg] = *(const v4u*)(X1 + (size_t)(R0 + rg * 16 + r) * DM + k0);
            const f32x4v ga = *(const LAS f32x4v*)(GS + k0), gb = *(const LAS f32x4v*)(GS + k0 + 4), sa = *(const LAS f32x4v*)(SH + k0), sb = *(const LAS f32x4v*)(SH + k0 + 4);
#pragma unroll
            for (int rg = 0; rg < 4; ++rg) {
                const v4u xr_ = xq[rg];
                const f32x4v xa = {__uint_as_float(xr_.x << 16), __uint_as_float(xr_.x & 0xffff0000u), __uint_as_float(xr_.y << 16), __uint_as_float(xr_.y & 0xffff0000u)}, xb = {__uint_as_float(xr_.z << 16), __uint_as_float(xr_.z & 0xffff0000u), __uint_as_float(xr_.w << 16), __uint_as_float(xr_.w & 0xffff0000u)};
                const f32x4v ha = xa * rstd[rg] * ga + sa, hb = xb * rstd[rg] * gb + sb;
                v4u hi, lo;
                hi.x = pg8::cvt_pk_bf16(ha[0], ha[1]); hi.y = pg8::cvt_pk_bf16(ha[2], ha[3]); hi.z = pg8::cvt_pk_bf16(hb[0], hb[1]); hi.w = pg8::cvt_pk_bf16(hb[2], hb[3]);
                lo.x = pg8::cvt_pk_bf16(ha[0] - __uint_as_float(hi.x << 16), ha[1] - __uint_as_float(hi.x & 0xffff0000u)); lo.y = pg8::cvt_pk_bf16(ha[2] - __uint_as_float(hi.y << 16), ha[3] - __uint_as_float(hi.y & 0xffff0000u));
                lo.z = pg8::cvt_pk_bf16(hb[0] - __uint_as_float(hi.z << 16), hb[1] - __uint_as_float(hi.z & 0xffff0000u)); lo.w = pg8::cvt_pk_bf16(hb[2] - __uint_as_float(hi.w << 16), hb[3] - __uint_as_float(hi.w & 0xffff0000u));
                __builtin_amdgcn_raw_buffer_store_b128(hi, hrsrc, ((R0 + rg * 16 + r) * DM + k0) * 2, 0, 16  );
                const bf16x8 ahi = __builtin_bit_cast(bf16x8, hi), alo = __builtin_bit_cast(bf16x8, lo);
#pragma unroll
                for (int n = 0; n < 3; ++n) {
                    acc[rg][n] = __builtin_amdgcn_mfma_f32_16x16x32_bf16(ahi, bh[n], acc[rg][n], 0, 0, 0);
                    acc[rg][n] = __builtin_amdgcn_mfma_f32_16x16x32_bf16(ahi, bl[n], acc[rg][n], 0, 0, 0);
                    acc[rg][n] = __builtin_amdgcn_mfma_f32_16x16x32_bf16(alo, bh[n], acc[rg][n], 0, 0, 0);
                }
            }
        }
#pragma unroll
        for (int rg = 0; rg < 4; ++rg)
#pragma unroll
            for (int n = 0; n < 3; ++n)
#pragma unroll
                for (int j = 0; j < 4; ++j) PL[(w * 64 + rg * 16 + 4 * q + j) * 48 + n * 16 + r] = acc[rg][n][j];
        __syncthreads();
        for (int i = F.tid; i < 64 * 48; i += NTHR) { float sacc = 0.f;
#pragma unroll
            for (int ww = 0; ww < 8; ++ww) sacc += PL[ww * 64 * 48 + i];
            LG[i] = sacc; }
        __syncthreads();
        int e0 = 0, e1 = 0, p0 = 0, p1 = 0; float w0 = 0.f, w1 = 0.f;
        if (F.tid < 64) {
            const LAS float* l0 = LG + (size_t)F.tid * 48;
            int gi = 0; float gmax = l0[0] + bg[0];
            for (int i = 1; i < 4; ++i) { const float v = l0[i] + bg[i]; if (v > gmax) { gmax = v; gi = i; } }
            float se = 0.f; for (int i = 0; i < 4; ++i) se += expf(l0[i] + bg[i] - gmax);
            const float gw = 1.f / se;
            int i0 = 0; float m0 = -1e30f; int i1 = 0; float m1 = -1e30f;
            for (int i = 0; i < 8; ++i) { const float v = l0[4 + gi * 8 + i] + be[gi * 8 + i];
                if (v > m0) { m1 = m0; i1 = i0; m0 = v; i0 = i; } else if (v > m1) { m1 = v; i1 = i; } }
            const float ex = expf(m1 - m0); w0 = gw / (1.f + ex); w1 = gw * ex / (1.f + ex);
            e0 = gi * 8 + i0; e1 = gi * 8 + i1;
            p0 = atomicAdd((int*)(lcnt + e0), 1); p1 = atomicAdd((int*)(lcnt + e1), 1);
        }
        __syncthreads();
        if (F.tid < 32) { const int c = lcnt[F.tid]; gbase[F.tid] = c ? (int)atomicAdd(F.ctl + CW_CNT + F.tid * 64, (unsigned)c) : 0; }
        __syncthreads();
        if (F.tid < 64) { const int tok = R0 + F.tid; const int g0 = gbase[e0] + p0, g1 = gbase[e1] + p1;
            __hip_atomic_store(ELT + e0 * M + g0, tok, __ATOMIC_RELAXED, __HIP_MEMORY_SCOPE_AGENT); __hip_atomic_store(ELW + e0 * M + g0, w0, __ATOMIC_RELAXED, __HIP_MEMORY_SCOPE_AGENT);
            __hip_atomic_store(ELT + e1 * M + g1, tok, __ATOMIC_RELAXED, __HIP_MEMORY_SCOPE_AGENT); __hip_atomic_store(ELW + e1 * M + g1, w1, __ATOMIC_RELAXED, __HIP_MEMORY_SCOPE_AGENT);
            __hip_atomic_store((unsigned long long*)(TOKP + tok * 2), (unsigned long long)(unsigned)(e0 * M + g0) | ((unsigned long long)(unsigned)(e1 * M + g1) << 32), __ATOMIC_RELAXED, __HIP_MEMORY_SCOPE_AGENT); }
        __syncthreads();
    }
}
DEV pg8::MoeTiles moe_build_tiles(Frame& F) {
    pg8::MoeTiles mt; mt.te = (LAS int*)(F.lds + LDS_TAB); mt.tm = mt.te + 192; mt.tv = mt.tm + 192; LAS int* Tp = mt.tv + 192; LAS int* BASE = Tp + 4;
    LAS int* cntl = BASE + 32;
    if (F.tid < NE) cntl[F.tid] = (int)__hip_atomic_load(F.ctl + CW_CNT + F.tid * 64, __ATOMIC_RELAXED, __HIP_MEMORY_SCOPE_AGENT);
    __syncthreads();
    if (F.tid == 0) { int T = 0;
        for (int e = 0; e < NE; ++e) { const int c = cntl[e]; BASE[e] = T * 256;
            for (int m = 0; m * 256 < c; ++m) { mt.te[T] = e; mt.tm[T] = m; mt.tv[T] = (c - m * 256) < 256 ? (c - m * 256) : 256; ++T; } }
        Tp[0] = T; }
    __syncthreads();
    mt.T = Tp[0];
    return mt;
}
DEV pg8::MoeTiles moe_tiles_view(Frame& F) {
    pg8::MoeTiles mt; mt.te = (LAS int*)(F.lds + LDS_TAB); mt.tm = mt.te + 192; mt.tv = mt.tm + 192; mt.T = (mt.tv + 192)[0]; return mt;
}
DEV void p9_final(Frame& F, const Args& a) {
    const LAS int* BASE = (const LAS int*)(F.lds + LDS_TAB) + 3 * 192 + 4;
    const float* MOD = (const float*)(F.ws + WS_MOD); const float* fg = (const float*)a.in[24]; const int* TOKP = (const int*)(F.ws + WS_TOKP); const bf16_t* Y = (const bf16_t*)(F.ws + WS_Y); const bf16_t* X1 = (const bf16_t*)(F.ws + WS_X1B);
    const int gw = F.vcu * NWAVES + F.wave, NGW = F.G * NWAVES;
    f32x4 fgv[4];
#pragma unroll
    for (int j = 0; j < 4; ++j) fgv[j] = *(const f32x4*)(fg + 4 * F.lane + 256 * j);
    for (int mb = gw; mb < M; mb += 32 * NGW) {
    int slotv = 0;
    { const int row = mb + (F.lane >> 1) * NGW; if (row < M) { const int t = TOKP[row * 2 + (F.lane & 1)]; slotv = BASE[t / M] + (t % M); } }
    for (int m0 = mb, itl = 0; m0 < M && itl < 16; m0 += 2 * NGW, ++itl) {
        int mm[2] = {m0, m0 + NGW}; int sl[2][2];
#pragma unroll
        for (int p = 0; p < 2; ++p) { sl[p][0] = __shfl(slotv, itl * 4 + p * 2); sl[p][1] = __shfl(slotv, itl * 4 + p * 2 + 1); }
        unsigned long long xq[2][4], ya[2][4], yb[2][4];
#pragma unroll
        for (int p = 0; p < 2; ++p) {
            const GAS unsigned long long* xr = (const GAS unsigned long long*)(X1 + (size_t)mm[p] * DM) + F.lane;
            const GAS unsigned long long* y0 = (const GAS unsigned long long*)(Y + (size_t)sl[p][0] * DM) + F.lane; const GAS unsigned long long* y1 = (const GAS unsigned long long*)(Y + (size_t)sl[p][1] * DM) + F.lane;
#pragma unroll
            for (int j = 0; j < 4; ++j) { xq[p][j] = __builtin_nontemporal_load(xr + 64 * j); ya[p][j] = __builtin_nontemporal_load(y0 + 64 * j); yb[p][j] = __builtin_nontemporal_load(y1 + 64 * j); }
        }
#pragma unroll
        for (int p = 0; p < 2; ++p) {
            const float* gf = MOD + (mm[p] / SEQ) * 6144 + 5120; float s = 0.f; f32x4 v[4];
#pragma unroll
            for (int j = 0; j < 4; ++j) { const int k = 4 * F.lane + 256 * j; const unsigned long long a0 = ya[p][j], a1 = yb[p][j]; const f32x4 g4 = *(const f32x4*)(gf + k);
                f32x4 yy; yy.x = __uint_as_float((unsigned)a0 << 16) + __uint_as_float((unsigned)a1 << 16); yy.y = __uint_as_float((unsigned)a0 & 0xffff0000u) + __uint_as_float((unsigned)a1 & 0xffff0000u);
                yy.z = __uint_as_float((unsigned)(a0 >> 32) << 16) + __uint_as_float((unsigned)(a1 >> 32) << 16); yy.w = __uint_as_float((unsigned)(a0 >> 32) & 0xffff0000u) + __uint_as_float((unsigned)(a1 >> 32) & 0xffff0000u);
                const unsigned long long xx = xq[p][j]; f32x4 x4; x4.x = __uint_as_float((unsigned)xx << 16); x4.y = __uint_as_float((unsigned)xx & 0xffff0000u); x4.z = __uint_as_float((unsigned)(xx >> 32) << 16); x4.w = __uint_as_float((unsigned)(xx >> 32) & 0xffff0000u);
                v[j] = x4 + g4 * yy; s += (v[j].x * v[j].x + v[j].y * v[j].y) + (v[j].z * v[j].z + v[j].w * v[j].w); }
            const float rstd = rsqrtf(wave_sum(s) * (1.f / DM) + EPS);
            GAS f32x4* xw = (GAS f32x4*)(F.out + (size_t)mm[p] * DM) + F.lane;
#pragma unroll
            for (int j = 0; j < 4; ++j) __builtin_nontemporal_store(v[j] * rstd * fgv[j], xw + 64 * j);
        }
    }
    }
}

__global__ void __launch_bounds__(NTHR, 2) mk(Args args) {
    __shared__ __attribute__((aligned(16))) unsigned char lds_raw[LDS_BYTES];
    Frame F;
    F.lds = (LAS unsigned char*)lds_raw; F.MISC = (volatile LAS unsigned*)(F.lds + MISC_OFF);
    F.tid = threadIdx.x; F.lane = F.tid & 63; F.wave = __builtin_amdgcn_readfirstlane(F.tid >> 6);
    F.G = gridDim.x; { const int bx = blockIdx.x; F.vcu = (F.G % 8 == 0) ? (bx % 8) * (F.G / 8) + bx / 8 : bx; }
    F.ws = args.ws; F.out = args.out; F.ctl = (unsigned*)(args.ws + WS_CTL);
    for (int u = F.tid; u < (LDS_BYTES - LDSCTL_OFF) / 4; u += NTHR) ((LAS unsigned*)(F.lds + LDSCTL_OFF))[u] = 0u;
    __syncthreads();
    XcdBarrier bar = xcd_barrier_post(F.ctl + CW_BAR + args.li * XCD_BAR_WORDS, F.MISC + 8);
    const int lo = args.ph_lo, hi = args.ph_hi;
#define REFRESH() do { int t_ = threadIdx.x; asm volatile("" : "+v"(t_)); F.tid = t_; F.lane = t_ & 63; F.wave = __builtin_amdgcn_readfirstlane(t_ >> 6); } while (0)
#define IN(k) (lo <= (k) && (k) < hi)
#define BOTH(k) (IN(k) && IN((k) + 1))
    if (IN(0)) { REFRESH(); p0_prologue(F, args); }
    if (IN(1)) { REFRESH(); p1_h(F, args); }
    if (IN(2)) { REFRESH();
        pg8::Gemm g{(const bf16_t*)(F.ws + WS_H), (const bf16_t*)(F.ws + WS_WT_IN), M, INW, DM}; pg8::StaticOrder S; S.init(M, INW, F.G, (int)blockIdx.x);
        pg8::EpiIn E{(bf16_t*)(F.ws + WS_Q), (bf16_t*)(F.ws + WS_K), (bf16_t*)(F.ws + WS_V), (bf16_t*)(F.ws + WS_CB), (bf16_t*)(F.ws + WS_CCU), (bf16_t*)(F.ws + WS_GA), (bf16_t*)(F.ws + WS_GC), (const float*)(F.ws + WS_ROPE), __builtin_amdgcn_make_buffer_rsrc((void*)(F.ws + WS_Q), 0, 144 * 1024 * 1024, 0x00020000)};
        if (IN(1)) {
            if (F.wave == 0) {
                const unsigned* pa = F.ctl + CW_P0C; unsigned need = (unsigned)F.G; bool act = F.lane == 0;
                if (F.lane >= 1 && F.lane < 32) { pg8::Unit u; if (S.next(F.lane - 1, u)) { pa = F.ctl + CW_PC1 + u.pm * 16; need = 4u; act = true; } }
                unsigned sp = 0;
                for (;;) { const unsigned v = act ? __hip_atomic_load(pa, __ATOMIC_RELAXED, __HIP_MEMORY_SCOPE_AGENT) : need; if (__all(v >= need)) break; __builtin_amdgcn_s_sleep(2); if (++sp > (1u << 22)) break; } }
            __syncthreads(); }
        pg8::gemm_phase<pg8::EpiIn, pg8::StaticOrder, true, true>(F.lds, g, S, E);
        if (BOTH(2)) xcd_barrier(bar);
    }
    if (IN(3)) { REFRESH(); p3_attn_conv(F, args, (char*)lds_raw); if (BOTH(3)) xcd_barrier(bar); }
    if (IN(4)) { REFRESH();
        pg8::StaticOrder S; S.init(M, DM, F.G, (int)blockIdx.x);
        pg8::Gemm g{(const bf16_t*)(F.ws + WS_ATT), (const bf16_t*)(F.ws + WS_WT_A), M, DM, DM};
        pg8::EpiG E{(const bf16_t*)(F.ws + WS_GA), (const bf16_t*)(F.ws + WS_GC), (bf16_t*)(F.ws + WS_MERGED), __builtin_amdgcn_make_buffer_rsrc((void*)(F.ws + WS_MERGED), 0, M * DM * 2, 0x00020000)};
        pg8::gemm_phase<pg8::EpiG, pg8::StaticOrder, false, true>(F.lds, g, S, E);
        if (BOTH(4) && F.tid == 0) { pg8::Unit u; if (S.next(0, u)) __hip_atomic_fetch_add(F.ctl + CW_PC4 + u.pm * 16, 1u, __ATOMIC_RELAXED, __HIP_MEMORY_SCOPE_AGENT); }
    }
    if (IN(5)) { REFRESH();
        pg8::StaticOrder S; S.init(M, DM, F.G, (int)blockIdx.x);
        pg8::Gemm g{(const bf16_t*)(F.ws + WS_MERGED), (const bf16_t*)(F.ws + WS_WT_O), M, DM, DM};
        pg8::EpiX1 E{(const float*)args.in[0], (const float*)(F.ws + WS_MOD) + 2048, (bf16_t*)(F.ws + WS_X1B), (float*)(F.ws + WS_SSQ), __builtin_amdgcn_make_buffer_rsrc((void*)(F.ws + WS_X1B), 0, M * DM * 2, 0x00020000)};
        if (IN(4)) {
            if (F.tid == 0) { pg8::Unit u; if (S.next(0, u)) { unsigned sp = 0; while (__hip_atomic_load(F.ctl + CW_PC4 + u.pm * 16, __ATOMIC_RELAXED, __HIP_MEMORY_SCOPE_AGENT) < (unsigned)(DM / pg8::BM)) { __builtin_amdgcn_s_sleep(2); if (++sp > (1u << 22)) break; } } }
            __syncthreads(); }
        pg8::gemm_phase<pg8::EpiX1, pg8::StaticOrder, false, true>(F.lds, g, S, E);
        if (BOTH(5) && F.tid == 0) { pg8::Unit u; if (S.next(0, u)) __hip_atomic_fetch_add(F.ctl + CW_PC5 + u.pm * 16, 1u, __ATOMIC_RELAXED, __HIP_MEMORY_SCOPE_AGENT); }
    }
    if (IN(6)) { REFRESH(); p6_route(F, args, IN(5)); if (BOTH(6)) xcd_barrier(bar); }
    if (IN(7)) { REFRESH();
        { const pg8::MoeTiles mt = moe_build_tiles(F);
          volatile LAS unsigned* lflag = (volatile LAS unsigned*)(F.lds + LDSCTL_OFF + 512);
          if (F.tid == 0) *lflag = 0u;
          __syncthreads();
          const int nbusy = 2 * mt.T - F.G;
          const int first = nbusy > 0 ? (nbusy < F.G - 32 ? nbusy : 0) : 0;
          if (F.vcu >= first) p7_wdown_transposes(F, args, F.vcu - first, F.G - first, F.ctl + CW_WDC); }
        { REFRESH(); const pg8::MoeTiles mt = moe_tiles_view(F);
          pg8::Gemm g{(const bf16_t*)(F.ws + WS_H2), (const bf16_t*)(F.ws + WS_WT_GU), 0, 0, DM};
          pg8::SchedMoeA S{mt, (const int*)(F.ws + WS_ELT), (const float*)(F.ws + WS_ELW), F.vcu, F.G, F.ctl + CW_DONE};
          pg8::EpiAct E{(bf16_t*)(F.ws + WS_ACT), __builtin_amdgcn_make_buffer_rsrc((void*)(F.ws + WS_ACT), 0, 40960 * 256 * 2, 0x00020000)};
          pg8::gemm_phase_x<pg8::EpiAct, pg8::SchedMoeA, true, 1>(F.lds, g, S, E); }
        { REFRESH(); const pg8::MoeTiles mt = moe_tiles_view(F);
          const int nbusy = 2 * mt.T - F.G; const int first = nbusy > 0 ? (nbusy < F.G - 32 ? nbusy : 0) : 0;
          pg8::Gemm g{(const bf16_t*)(F.ws + WS_ACT), (const bf16_t*)(F.ws + WS_WT_D), 0, 0, FF};
          pg8::SchedMoeB S{mt, F.vcu, F.G, F.ctl + CW_DONE};
          pg8::EpiY E{(bf16_t*)(F.ws + WS_Y), __builtin_amdgcn_make_buffer_rsrc((void*)(F.ws + WS_Y), 0, 40960 * 1024 * 2, 0x00020000)};
          pg8::gemm_phase_x<pg8::EpiY, pg8::SchedMoeB, false, 2>(F.lds, g, S, E, (volatile LAS unsigned*)(F.lds + LDSCTL_OFF + 512), F.ctl + CW_WDC, (unsigned)(F.G - first)); }
        if (BOTH(7)) xcd_barrier(bar);
    }
    if (IN(9)) { REFRESH(); if (!IN(7)) (void)moe_build_tiles(F); p9_final(F, args); }
#undef IN
#undef BOTH
}


static int g_grid = 0;
static void mk_launch(const Args& base, int lo, int hi, int li, hipStream_t stream) {
    Args a = base; a.ph_lo = lo; a.ph_hi = hi; a.li = li; a.pad = 0;
    hipLaunchKernelGGL(mk, dim3(g_grid), dim3(NTHR), 0, stream, a);
}

extern "C" void kernel_launch(void* const* d_in, const int* in_sizes, int n_in, void* d_out, int out_size, void* d_ws, size_t ws_size, hipStream_t stream) {
    (void)in_sizes; (void)n_in; (void)out_size; (void)ws_size;
    if (g_grid == 0) {
        int dev = 0, cus = 0; (void)hipGetDevice(&dev); (void)hipDeviceGetAttribute(&cus, hipDeviceAttributeMultiprocessorCount, dev);
        g_grid = cus > 0 ? cus : 256;
    }
    (void)hipMemsetAsync((char*)d_ws + WS_CTL, 0, CTL_ZERO_BYTES, stream);
    Args base{}; for (int i = 0; i < 25; ++i) base.in[i] = d_in[i]; base.out = (float*)d_out; base.ws = (unsigned char*)d_ws;
    mk_launch(base, 0, 10, 0, stream);
}
```

```cpp
#include <hip/hip_runtime.h>
#include <stdint.h>

typedef unsigned short bf16_t;
#define DEV __device__ __forceinline__

constexpr int BATCH = 4, SEQ = 4096, DM = 1024, M = BATCH * SEQ;
constexpr int NH = 4, HD = 64, VD = 128, QKW = 512, VW = 512, CW = 512, INW = 5120;
constexpr int NG = 4, EPG = 8, NE = 32, FF = 256;
constexpr float EPS = 1e-6f;
constexpr float LAMBDA_INIT = 0.2f;

constexpr size_t MiB = 1u << 20;
constexpr size_t WS_CTL = 0;
constexpr size_t WS_MOD = 1 * MiB;
constexpr size_t WS_LAM = 1 * MiB + 128 * 1024;
constexpr size_t WS_ROPE = 2 * MiB;
constexpr size_t WS_TOKE = 6 * MiB;
constexpr size_t WS_TOKW = 6 * MiB + 256 * 1024;
constexpr size_t WS_WEIGHTS = 8 * MiB;
constexpr size_t WS_H = 72 * MiB;
constexpr size_t WS_ATT = 72 * MiB, WS_CONV = 88 * MiB;
constexpr size_t WS_Q = 104 * MiB, WS_K = 120 * MiB, WS_V = 136 * MiB, WS_CB = 152 * MiB, WS_CCU = 168 * MiB;
constexpr size_t WS_GA = 184 * MiB, WS_GC = 216 * MiB;
constexpr size_t WS_MERGED = 104 * MiB;
constexpr size_t WS_H2 = 136 * MiB;
constexpr size_t WS_SSQ = 248 * MiB;

DEV float bf2f(bf16_t v) { return __uint_as_float(((unsigned)v) << 16); }
DEV bf16_t f2bf(float f) { unsigned u = __float_as_uint(f); u += 0x7fffu + ((u >> 16) & 1u); return (bf16_t)(u >> 16); }

#define GAS __attribute__((address_space(1)))
#define LAS __attribute__((address_space(3)))
typedef unsigned v4u __attribute__((ext_vector_type(4)));
typedef float f32x4 __attribute__((ext_vector_type(4)));
typedef short bf16x8 __attribute__((ext_vector_type(8)));
#define LDS_WAIT() asm volatile("s_waitcnt lgkmcnt(0)" ::: "memory")
#define VM_WAIT() asm volatile("s_waitcnt vmcnt(0)" ::: "memory")
typedef float f32x2p_t __attribute__((ext_vector_type(2))); typedef __bf16 bf16x2p_t __attribute__((ext_vector_type(2)));
DEV unsigned pk2(float lo, float hi) { f32x2p_t v = {lo, hi}; bf16x2p_t b = __builtin_convertvector(v, bf16x2p_t); return __builtin_bit_cast(unsigned, b); }

constexpr int NWAVES = 8, NTHR = 512;
constexpr int RING_BYTES = 131072;
constexpr int LDSCTL_OFF = 139264, MISC_OFF = LDSCTL_OFF + 320;
constexpr int LDS_BYTES = 147456;
constexpr size_t CTL_ZERO_BYTES = 1 * MiB;
constexpr int CW_P0C = 24640, CW_PC1 = 25600;
constexpr int CW_MODC = 24576;
constexpr int CW_BAR = 4096;
constexpr size_t WS_WT_IN = WS_WEIGHTS;
constexpr size_t WS_WT_A = WS_WEIGHTS + 10 * MiB;
constexpr size_t WS_WT_C = WS_WEIGHTS + 11 * MiB;
constexpr size_t WS_WT_O = WS_WEIGHTS + 12 * MiB;
constexpr size_t WS_WT_GU = WS_WEIGHTS + 14 * MiB;
constexpr size_t WS_WT_D = WS_WEIGHTS + 46 * MiB;
constexpr size_t WS_WT_R = WS_WEIGHTS + 62 * MiB;

#define XB_TMO      128
#define XB_XCNT(j)  (256  + 64 * (j))
#define XB_XSUB(j)  (1280 + 64 * (j))
#define XB_XGEN(j)  (2304 + 64 * (j))
#define XB_TOP      3328
#define XB_TOPGEN   3392
#define XCD_BAR_WORDS 3456
#define XB_SPIN_CAP (1u << 18)
DEV unsigned xb_ld(unsigned* p)              { return __hip_atomic_load(p, __ATOMIC_RELAXED, __HIP_MEMORY_SCOPE_AGENT); }
DEV unsigned xb_add(unsigned* p, unsigned v) { return __hip_atomic_fetch_add(p, v, __ATOMIC_RELAXED, __HIP_MEMORY_SCOPE_AGENT); }
DEV unsigned xb_xcc_id() { return (unsigned)__builtin_amdgcn_s_getreg((3 << 11) | 20) & 0xFu; }
#define XB_SPIN(cond, bar) do { unsigned _sp = 0; while (cond) { __builtin_amdgcn_s_sleep(1); \
    if ((++_sp & 255u) == 0u) { if (xb_ld(&(bar)[XB_TMO])) break; if (_sp > XB_SPIN_CAP) { atomicAdd(&(bar)[XB_TMO], 1u); break; } } } } while (0)
struct XcdBarrier { unsigned* bar; unsigned x; volatile LAS unsigned* st; };
DEV XcdBarrier xcd_barrier_post(unsigned* bar, volatile LAS unsigned* st) {
    XcdBarrier b; b.bar = bar; b.x = xb_xcc_id(); b.st = st;
    if (threadIdx.x == 0) (void)xb_add(&bar[XB_XCNT(b.x)], 1u);
    return b;
}
DEV void xcd_barrier_complete(unsigned* bar, unsigned x, unsigned& nloc, unsigned& nx) {
    const unsigned G = gridDim.x * gridDim.y * gridDim.z;
    unsigned sum, cnt, mine, sp = 0u;
    for (;;) {
        sum = 0u; cnt = 0u; mine = 0u;
#pragma unroll
        for (unsigned j = 0; j < 16; ++j) { const unsigned c = xb_ld(&bar[XB_XCNT(j)]); sum += c; cnt += (c > 0u) ? 1u : 0u; mine = (j == x) ? c : mine; }
        if (sum == G) break;
        __builtin_amdgcn_s_sleep(1);
        if ((++sp & 255u) == 0u) { if (xb_ld(&bar[XB_TMO])) break; if (sp > XB_SPIN_CAP) { atomicAdd(&bar[XB_TMO], 1u); break; } }
    }
    nloc = mine > 0u ? mine : 1u; nx = cnt > 0u ? cnt : 1u;
}
DEV void xcd_barrier(const XcdBarrier& b) {
    asm volatile("s_waitcnt vmcnt(0)" ::: "memory");
    __syncthreads();
    if (threadIdx.x == 0) {
        unsigned* bar = b.bar;
        __builtin_amdgcn_s_waitcnt(0);
        asm volatile("buffer_inv sc1" ::: "memory");
        unsigned nloc = b.st[0], nx = b.st[1];
        if (nloc == 0u) { xcd_barrier_complete(bar, b.x, nloc, nx); b.st[0] = nloc; b.st[1] = nx; }
        const unsigned old = xb_add(&bar[XB_XSUB(b.x)], 1u);
        const unsigned gen = old / nloc;
        if (old + 1u == (gen + 1u) * nloc) {
            __builtin_amdgcn_fence(__ATOMIC_RELEASE, "agent");
            asm volatile("s_waitcnt vmcnt(0)" ::: "memory");
            const unsigned og = xb_add(&bar[XB_TOP], 1u);
            const unsigned tg = og / nx;
            if (og + 1u == (tg + 1u) * nx) xb_add(&bar[XB_TOPGEN], 1u);
            else XB_SPIN(xb_ld(&bar[XB_TOPGEN]) == tg, bar);
            xb_add(&bar[XB_XGEN(b.x)], 1u);
            asm volatile("s_waitcnt vmcnt(0)" ::: "memory");
        } else {
            XB_SPIN(xb_ld(&bar[XB_XGEN(b.x)]) == gen, bar);
            asm volatile("s_waitcnt vmcnt(0)" ::: "memory");
        }
    }
    __syncthreads();
}

struct Args { const void* in[25]; float* out; unsigned char* ws; int ph_lo, ph_hi, li, pad; };
struct Frame {
    LAS unsigned char* lds; volatile LAS unsigned* MISC; unsigned* ctl;
    int tid, lane, wave, vcu, G;
    unsigned char* ws; float* out;
};
DEV float wave_sum(float v) {
    v += __int_as_float(__builtin_amdgcn_update_dpp(0, __float_as_int(v), 0xB1, 0xF, 0xF, true));
    v += __int_as_float(__builtin_amdgcn_update_dpp(0, __float_as_int(v), 0x4E, 0xF, 0xF, true));
    v += __int_as_float(__builtin_amdgcn_update_dpp(0, __float_as_int(v), 0x141, 0xF, 0xF, true));
    v += __int_as_float(__builtin_amdgcn_update_dpp(0, __float_as_int(v), 0x140, 0xF, 0xF, true));
    v += __shfl_xor(v, 16);
    { auto rr = __builtin_amdgcn_permlane32_swap(__float_as_uint(v), __float_as_uint(v), false, false); v = __uint_as_float(rr[0]) + __uint_as_float(rr[1]); }
    return v;
}
namespace pg8 {
#define PG8_LAS __attribute__((address_space(3)))
typedef unsigned short bf16_t;
typedef short bf16x8 __attribute__((ext_vector_type(8)));
typedef float f32x4 __attribute__((ext_vector_type(4)));
typedef unsigned u32x4 __attribute__((ext_vector_type(4)));
constexpr int BM = 256, BK = 64, HALF = 128, HTB = HALF * BK * 2  , STAGE_BYTES = 8 * HTB, NXCD = 8, WGM = 8;

__host__ __device__ __forceinline__ int lds_byte(int r, int c) { const int st = (r >> 4) * 2 + (c >> 5), rr = r & 15, cc = c & 31, ob = rr * 64 + cc * 2; return st * 1024 + (ob ^ (((ob >> 9) & 1) << 5)); }
__host__ __device__ __forceinline__ void stage_rc(int b, int& R, int& C) { const int st = b / 1024, sb = b % 1024, swz = sb ^ (((sb >> 9) & 1) << 5); R = (st >> 1) * 16 + swz / 64; C = (st & 1) * 32 + (swz % 64) / 2; }
__host__ __device__ __forceinline__ int perm32(int rho) { const int n = rho >> 4, i = rho & 15; return 8 * (i >> 2) + 4 * n + (i & 3); }

struct Unit { int pm, pn; };
struct Gemm { const bf16_t* A; const bf16_t* Bt; int M, N, K; };

struct StaticOrder {
    int nM, nN, nwg, G, c;
    __host__ __device__ void init(int M, int N, int G_, int c_) { nM = M / BM; nN = N / BM; nwg = nM * nN; G = G_; c = c_; }
    __host__ __device__ bool next(int i, Unit& u) const {
        const long L = (long)i * G + c; if (L >= nwg) return false;
        int wgid = (int)L; { const int q = nwg / NXCD, r = nwg % NXCD, xcd = wgid % NXCD, off = wgid / NXCD; wgid = (xcd < r ? xcd * (q + 1) : r * (q + 1) + (xcd - r) * q) + off; }
        const int nig = WGM * nN, gid = wgid / nig, fm = gid * WGM, gsz = (nM - fm) < WGM ? (nM - fm) : WGM;
        u.pm = fm + ((wgid % nig) % gsz); u.pn = (wgid % nig) / gsz; return true;
    }
    __device__ __forceinline__ void a_ready(const Unit&) const {}
    __device__ __forceinline__ void done(const Unit&) const {}
};

typedef float f32x2c_t __attribute__((ext_vector_type(2))); typedef __bf16 bf16x2c_t __attribute__((ext_vector_type(2)));
__device__ __forceinline__ unsigned cvt_pk_bf16(float lo, float hi) { f32x2c_t v = {lo, hi}; bf16x2c_t b = __builtin_convertvector(v, bf16x2c_t); return __builtin_bit_cast(unsigned, b); }
typedef float f32x2 __attribute__((ext_vector_type(2)));


struct EpiIn {
    static constexpr bool PERM = true, AFTER_DRAIN = false, MID = false;
    bf16_t *Qb, *Kb, *Vb, *CB, *CCU, *GA, *GC; const float* ROPE; __amdgpu_buffer_rsrc_t orsrc;
    __device__ __forceinline__ void st(const int eoff, const u32x4 w) const { __builtin_amdgcn_raw_buffer_store_b128(w, orsrc, eoff * 2, 0, 16); }
    __device__ __forceinline__ void operator()(const f32x4 (&acc)[2][2][4][2], const Unit& u, int wr, int wc, int fr, int fq) const {
        const int pn = u.pn, row0 = u.pm * BM + wr * 64 + fr;
        if (pn < 4) {
            const int dst = pn < 2 ? 0 : (8 << 20); const int c0 = ((pn & 1) * 4 + wc) * 64 + 8 * fq;
            const float qs = pn < 2 ? 0.18033688011112042f : 1.f;
#pragma unroll
            for (int ai = 0; ai < 2; ++ai) {
                f32x4 cs[4][4];
#pragma unroll
                for (int m = 0; m < 4; ++m) { const f32x4* rp = (const f32x4*)(ROPE + ((size_t)(row0 + ai * HALF + m * 16) * 32 + 8 * fq) * 2);
#pragma unroll
                    for (int q = 0; q < 4; ++q) cs[m][q] = rp[q]; }
#pragma unroll
                for (int m = 0; m < 4; ++m) { const int row = row0 + ai * HALF + m * 16;
                    const f32x4 cs0 = cs[m][0], cs1 = cs[m][1], cs2 = cs[m][2], cs3 = cs[m][3];
                    const f32x4 xa = acc[ai][0][m][0], xb = acc[ai][0][m][1], ya = acc[ai][1][m][0], yb = acc[ai][1][m][1];
                    u32x4 w1, w2;
                    w1.x = cvt_pk_bf16(qs * (xa[0] * cs0[0] - ya[0] * cs0[1]), qs * (xa[1] * cs0[2] - ya[1] * cs0[3]));
                    w1.y = cvt_pk_bf16(qs * (xa[2] * cs1[0] - ya[2] * cs1[1]), qs * (xa[3] * cs1[2] - ya[3] * cs1[3]));
                    w1.z = cvt_pk_bf16(qs * (xb[0] * cs2[0] - yb[0] * cs2[1]), qs * (xb[1] * cs2[2] - yb[1] * cs2[3]));
                    w1.w = cvt_pk_bf16(qs * (xb[2] * cs3[0] - yb[2] * cs3[1]), qs * (xb[3] * cs3[2] - yb[3] * cs3[3]));
                    w2.x = cvt_pk_bf16(qs * (ya[0] * cs0[0] + xa[0] * cs0[1]), qs * (ya[1] * cs0[2] + xa[1] * cs0[3]));
                    w2.y = cvt_pk_bf16(qs * (ya[2] * cs1[0] + xa[2] * cs1[1]), qs * (ya[3] * cs1[2] + xa[3] * cs1[3]));
                    w2.z = cvt_pk_bf16(qs * (yb[0] * cs2[0] + xb[0] * cs2[1]), qs * (yb[1] * cs2[2] + xb[1] * cs2[3]));
                    w2.w = cvt_pk_bf16(qs * (yb[2] * cs3[0] + xb[2] * cs3[1]), qs * (yb[3] * cs3[2] + xb[3] * cs3[3]));
                    st(dst + row * 512 + c0, w1); st(dst + row * 512 + c0 + 32, w2); }
            }
        } else if (pn < 8) {
            const int dst = pn < 6 ? (16 << 20) : (24 << 20); const int c0 = (pn & 1) * 256 + wc * 32 + 8 * fq;
#pragma unroll
            for (int ai = 0; ai < 2; ++ai)
#pragma unroll
                for (int m = 0; m < 4; ++m) { const int row = row0 + ai * HALF + m * 16;
#pragma unroll
                    for (int bj = 0; bj < 2; ++bj) { const f32x4 v0 = acc[ai][bj][m][0], v1 = acc[ai][bj][m][1]; u32x4 w;
                        w.x = cvt_pk_bf16(v0[0], v0[1]); w.y = cvt_pk_bf16(v0[2], v0[3]); w.z = cvt_pk_bf16(v1[0], v1[1]); w.w = cvt_pk_bf16(v1[2], v1[3]);
                        st(dst + row * 512 + c0 + bj * HALF, w); } }
        } else if (pn < 12) {
            const int c0 = (pn - 8) * 128 + wc * 32 + 8 * fq;
#pragma unroll
            for (int ai = 0; ai < 2; ++ai)
#pragma unroll
                for (int m = 0; m < 4; ++m) { const int row = row0 + ai * HALF + m * 16;
                    const f32x4 v0 = acc[ai][0][m][0] * acc[ai][1][m][0], v1 = acc[ai][0][m][1] * acc[ai][1][m][1]; u32x4 w;
                    w.x = cvt_pk_bf16(v0[0], v0[1]); w.y = cvt_pk_bf16(v0[2], v0[3]); w.z = cvt_pk_bf16(v1[0], v1[1]); w.w = cvt_pk_bf16(v1[2], v1[3]);
                    st((32 << 20) + row * 512 + c0, w); }
        } else {
            const int dst = pn < 16 ? (40 << 20) : (56 << 20); const int c0 = ((pn - 12) & 3) * 256 + wc * 32 + 8 * fq;
#pragma unroll
            for (int ai = 0; ai < 2; ++ai)
#pragma unroll
                for (int m = 0; m < 4; ++m) { const int row = row0 + ai * HALF + m * 16;
#pragma unroll
                    for (int bj = 0; bj < 2; ++bj) { f32x4 v0 = acc[ai][bj][m][0], v1 = acc[ai][bj][m][1];
#pragma unroll
                        for (int j = 0; j < 4; ++j) { v0[j] = __builtin_amdgcn_rcpf(1.f + __builtin_amdgcn_exp2f(-1.4426950408889634f * v0[j])); v1[j] = __builtin_amdgcn_rcpf(1.f + __builtin_amdgcn_exp2f(-1.4426950408889634f * v1[j])); }
                        u32x4 w; w.x = cvt_pk_bf16(v0[0], v0[1]); w.y = cvt_pk_bf16(v0[2], v0[3]); w.z = cvt_pk_bf16(v1[0], v1[1]); w.w = cvt_pk_bf16(v1[2], v1[3]);
                        st(dst + row * 1024 + c0 + bj * HALF, w); } }
        }
    }
};

struct EpiG {
    static constexpr bool PERM = true, AFTER_DRAIN = false, MID = true;
    const bf16_t* GA; const bf16_t* GC; bf16_t* O; __amdgpu_buffer_rsrc_t orsrc;
    __device__ __forceinline__ void mid(f32x4 (&acc)[2][2][4][2], const Unit& u, int wr, int wc, int fr, int fq) const {
        int base = (u.pm * BM + wr * 64 + fr) * 1024 + u.pn * BM + wc * 32 + 8 * fq; asm volatile("" : "+v"(base));
#pragma unroll
        for (int ai = 0; ai < 2; ++ai)
#pragma unroll
            for (int mh = 0; mh < 2; ++mh) {
            u32x4 ga[2][2], gc[2][2];
#pragma unroll
            for (int mm = 0; mm < 2; ++mm)
#pragma unroll
                for (int bj = 0; bj < 2; ++bj) { const int ro = base + (ai * HALF + (2 * mh + mm) * 16) * 1024 + bj * HALF; ga[mm][bj] = __builtin_nontemporal_load((const u32x4*)(GA + ro)); gc[mm][bj] = *(const u32x4*)(GC + ro); }
#pragma unroll
            for (int mm = 0; mm < 2; ++mm)
#pragma unroll
                for (int bj = 0; bj < 2; ++bj) { const u32x4 a = ga[mm][bj], c = gc[mm][bj]; const int m = 2 * mh + mm;
                    f32x4& v0 = acc[ai][bj][m][0]; f32x4& v1 = acc[ai][bj][m][1];
                    v0[0] *= __uint_as_float(a.x << 16) * __builtin_amdgcn_rcpf(__uint_as_float(c.x << 16)); v0[1] *= __uint_as_float(a.x & 0xffff0000u) * __builtin_amdgcn_rcpf(__uint_as_float(c.x & 0xffff0000u));
                    v0[2] *= __uint_as_float(a.y << 16) * __builtin_amdgcn_rcpf(__uint_as_float(c.y << 16)); v0[3] *= __uint_as_float(a.y & 0xffff0000u) * __builtin_amdgcn_rcpf(__uint_as_float(c.y & 0xffff0000u));
                    v1[0] *= __uint_as_float(a.z << 16) * __builtin_amdgcn_rcpf(__uint_as_float(c.z << 16)); v1[1] *= __uint_as_float(a.z & 0xffff0000u) * __builtin_amdgcn_rcpf(__uint_as_float(c.z & 0xffff0000u));
                    v1[2] *= __uint_as_float(a.w << 16) * __builtin_amdgcn_rcpf(__uint_as_float(c.w << 16)); v1[3] *= __uint_as_float(a.w & 0xffff0000u) * __builtin_amdgcn_rcpf(__uint_as_float(c.w & 0xffff0000u)); }
        }
    }
    __device__ __forceinline__ void operator()(const f32x4 (&acc)[2][2][4][2], const Unit& u, int wr, int wc, int fr, int fq) const {
        int base = (u.pm * BM + wr * 64 + fr) * 1024 + u.pn * BM + wc * 32 + 8 * fq; asm volatile("" : "+v"(base));
        u32x4 gca[2][4][2];
#pragma unroll
        for (int ai = 0; ai < 2; ++ai)
#pragma unroll
            for (int m = 0; m < 4; ++m)
#pragma unroll
                for (int bj = 0; bj < 2; ++bj) gca[ai][m][bj] = __builtin_nontemporal_load((const u32x4*)(GC + base + (ai * HALF + m * 16) * 1024 + bj * HALF));
        __builtin_amdgcn_sched_barrier(0);
#pragma unroll
        for (int ai = 0; ai < 2; ++ai) {
#pragma unroll
            for (int m = 0; m < 4; ++m)
#pragma unroll
                for (int bj = 0; bj < 2; ++bj) { const u32x4 c = gca[ai][m][bj]; const int ro = base + (ai * HALF + m * 16) * 1024 + bj * HALF;
                    const f32x4 v0 = acc[ai][bj][m][0], v1 = acc[ai][bj][m][1]; u32x4 w;
                    w.x = cvt_pk_bf16(v0[0] * __uint_as_float(c.x << 16), v0[1] * __uint_as_float(c.x & 0xffff0000u)); w.y = cvt_pk_bf16(v0[2] * __uint_as_float(c.y << 16), v0[3] * __uint_as_float(c.y & 0xffff0000u));
                    w.z = cvt_pk_bf16(v1[0] * __uint_as_float(c.z << 16), v1[1] * __uint_as_float(c.z & 0xffff0000u)); w.w = cvt_pk_bf16(v1[2] * __uint_as_float(c.w << 16), v1[3] * __uint_as_float(c.w & 0xffff0000u));
                    __builtin_amdgcn_raw_buffer_store_b128(w, orsrc, ro * 2, 0, 16  ); }
        }
    }
};
struct EpiX1 {
    static constexpr bool PERM = true, AFTER_DRAIN = false, MID = false;
    const float* X; const float* GM; bf16_t* X1; float* SSQ; __amdgpu_buffer_rsrc_t xrsrc;
    __device__ __forceinline__ void operator()(const f32x4 (&acc)[2][2][4][2], const Unit& u, int wr, int wc, int fr, int fq) const {
        const int row0 = u.pm * BM + wr * 64 + fr, c0 = u.pn * BM + wc * 32 + 8 * fq;
        const float* gm = GM + (u.pm >> 4) * 6144 + c0;
        f32x4 gv[2][2];
#pragma unroll
        for (int bj = 0; bj < 2; ++bj)
#pragma unroll
            for (int n = 0; n < 2; ++n) gv[bj][n] = *(const f32x4*)(gm + bj * HALF + n * 4);
#pragma unroll
        for (int ai = 0; ai < 2; ++ai)
#pragma unroll
            for (int mh = 0; mh < 2; ++mh) {
            f32x4 xv[2][2][2];
#pragma unroll
            for (int mm = 0; mm < 2; ++mm) { const size_t ro = (size_t)(row0 + ai * HALF + (2 * mh + mm) * 16) * 1024 + c0;
#pragma unroll
                for (int bj = 0; bj < 2; ++bj)
#pragma unroll
                    for (int n = 0; n < 2; ++n) xv[mm][bj][n] = __builtin_nontemporal_load((const f32x4*)(X + ro + bj * HALF + n * 4)); }
#pragma unroll
            for (int mm = 0; mm < 2; ++mm) { const int m = 2 * mh + mm; const int row = row0 + ai * HALF + m * 16; const size_t ro = (size_t)row * 1024 + c0; float ss = 0.f;
#pragma unroll
                for (int bj = 0; bj < 2; ++bj) { const f32x4 o0 = xv[mm][bj][0] + gv[bj][0] * acc[ai][bj][m][0], o1 = xv[mm][bj][1] + gv[bj][1] * acc[ai][bj][m][1];
                    ss += ((o0[0] * o0[0] + o0[1] * o0[1]) + (o0[2] * o0[2] + o0[3] * o0[3])) + ((o1[0] * o1[0] + o1[1] * o1[1]) + (o1[2] * o1[2] + o1[3] * o1[3]));
                    u32x4 w; w.x = cvt_pk_bf16(o0[0], o0[1]); w.y = cvt_pk_bf16(o0[2], o0[3]); w.z = cvt_pk_bf16(o1[0], o1[1]); w.w = cvt_pk_bf16(o1[2], o1[3]);
                    __builtin_amdgcn_raw_buffer_store_b128(w, xrsrc, (int)(ro + bj * HALF) * 2, 0, 16  ); }
                ss += __shfl_xor(ss, 16); { auto rr_ = __builtin_amdgcn_permlane32_swap(__float_as_uint(ss), __float_as_uint(ss), false, false); ss = __uint_as_float(rr_[0]) + __uint_as_float(rr_[1]); }
                if (fq == 0) __hip_atomic_store(SSQ + (size_t)row * 16 + u.pn * 4 + wc, ss, __ATOMIC_RELAXED, __HIP_MEMORY_SCOPE_AGENT); }
        }
    }
};

template <class Epi, class Sched, bool ALIGN_EPI = false, bool SP2 = false>
__device__ __forceinline__ void gemm_phase(PG8_LAS unsigned char* lds, const Gemm g, const Sched& S, const Epi& E) {
    const int tid = threadIdx.x, wid = __builtin_amdgcn_readfirstlane(tid >> 6), lane = tid & 63, wr = wid >> 2, wc = wid & 3, fr = lane & 15, fq = lane >> 4;
    const int K = g.K, nt = K / BK;
    unsigned voffA[2], voffB[2];
#pragma unroll
    for (int i = 0; i < 2; ++i) { int R, C; stage_rc(tid * 16 + i * 8192, R, C); const int Rb = Epi::PERM ? ((R & ~31) + perm32(R & 31)) : R;
        voffA[i] = (unsigned)(R * K + C) * 2u; voffB[i] = (unsigned)(Rb * K + C) * 2u; }
    const size_t kstep = (size_t)(BK * 2);
    const size_t hstep = (size_t)HALF * K * 2;
    const size_t tstep = 2 * hstep;
    const unsigned ldsw = (unsigned)wid * 1024u;
    const int aoff = lds_byte(wr * 64 + fr, fq * 8), boff = lds_byte(wc * 32 + fr, fq * 8);
#define PG8_SA(b, h) (((b) * 2 + (h)) * HTB)
#define PG8_SB(b, h) ((4 + (b) * 2 + (h)) * HTB)
#define PG8_STAGE(bufoff, gbase, voff) do { _Pragma("unroll") for (int _i = 0; _i < 2; ++_i) \
        __builtin_amdgcn_global_load_lds((const unsigned*)((const char*)(gbase) + (voff)[_i]), (PG8_LAS unsigned*)(lds + (bufoff) + ldsw + _i * 8192), 16, 0, 0); } while (0)
#define PG8_LDA(dst, b, h) do { _Pragma("unroll") for (int m = 0; m < 4; ++m) _Pragma("unroll") for (int k = 0; k < 2; ++k) dst[m][k] = *(const PG8_LAS bf16x8*)(lds + PG8_SA(b, h) + aoff + m * 2048 + k * 1024); } while (0)
#define PG8_LDB(dst, b, h) do { _Pragma("unroll") for (int n = 0; n < 2; ++n) _Pragma("unroll") for (int k = 0; k < 2; ++k) dst[n][k] = *(const PG8_LAS bf16x8*)(lds + PG8_SB(b, h) + boff + n * 2048 + k * 1024); } while (0)
#define PG8_MMA(ai, bj, At, Bt) do { __builtin_amdgcn_s_setprio(1); _Pragma("unroll") for (int m = 0; m < 4; ++m) _Pragma("unroll") for (int n = 0; n < 2; ++n) _Pragma("unroll") for (int k = 0; k < 2; ++k) \
        acc[ai][bj][m][n] = __builtin_amdgcn_mfma_f32_16x16x32_bf16(Bt[n][k], At[m][k], acc[ai][bj][m][n], 0, 0, 0); __builtin_amdgcn_s_setprio(0); } while (0)
#define PG8_WAIT_V(n) asm volatile("s_waitcnt vmcnt(" #n ")" ::: "memory")
#define PG8_WAIT_L(n) asm volatile("s_waitcnt lgkmcnt(" #n ")" ::: "memory")
#define PG8_BAR __builtin_amdgcn_s_barrier()
#define PG8_SCHED __builtin_amdgcn_sched_barrier(0)
    Unit cur, nxt; int ui = 0;
    if (!S.next(0, cur)) return;
    f32x4 acc[2][2][4][2];
#pragma unroll
    for (int a = 0; a < 2; ++a)
#pragma unroll
        for (int b = 0; b < 2; ++b)
#pragma unroll
            for (int m = 0; m < 4; ++m)
#pragma unroll
                for (int n = 0; n < 2; ++n) acc[a][b][m][n] = (f32x4){0.f, 0.f, 0.f, 0.f};
    bf16x8 At[4][2], B0[2][2], B1[2][2];
    const char* cA = (const char*)g.A + (size_t)cur.pm * tstep; const char* cB = (const char*)g.Bt + (size_t)cur.pn * tstep;
    S.a_ready(cur);
    if constexpr (SP2) {
        PG8_STAGE(PG8_SB(0, 0), cB, voffB); PG8_STAGE(PG8_SB(0, 1), cB + hstep, voffB); PG8_STAGE(PG8_SA(0, 0), cA, voffA); PG8_STAGE(PG8_SA(0, 1), cA + hstep, voffA);
        if (wr == 1) PG8_BAR;
        PG8_WAIT_V(2); PG8_BAR;
        PG8_STAGE(PG8_SB(1, 0), cB + kstep, voffB); PG8_STAGE(PG8_SA(1, 0), cA + kstep, voffA); PG8_STAGE(PG8_SB(1, 1), cB + hstep + kstep, voffB);
        PG8_WAIT_V(6); PG8_BAR;
    } else {
        PG8_STAGE(PG8_SB(0, 0), cB, voffB); PG8_STAGE(PG8_SA(0, 0), cA, voffA); PG8_STAGE(PG8_SB(0, 1), cB + hstep, voffB); PG8_STAGE(PG8_SA(0, 1), cA + hstep, voffA);
        if (wr == 1) PG8_BAR;
        PG8_WAIT_V(4); PG8_BAR;
        PG8_STAGE(PG8_SB(1, 0), cB + kstep, voffB); PG8_STAGE(PG8_SA(1, 0), cA + kstep, voffA); PG8_STAGE(PG8_SB(1, 1), cB + hstep + kstep, voffB);
        PG8_WAIT_V(6); PG8_BAR;
    }
    for (;;) {
        const bool has_next = S.next(ui + 1, nxt);
        const char* nA = has_next ? (const char*)g.A + (size_t)nxt.pm * tstep : cA; const char* nB = has_next ? (const char*)g.Bt + (size_t)nxt.pn * tstep : cB;
        for (int t = 0; t < nt; t += 2) {
            const bool last = (t == nt - 2);
            const char* a1 = cA + (size_t)(t + 1) * kstep;
            const char* a2 = last ? nA : cA + (size_t)(t + 2) * kstep; const char* b2 = last ? nB : cB + (size_t)(t + 2) * kstep;
            const char* a3 = a2 + kstep; const char* b3 = b2 + kstep;
            if (last && has_next) S.a_ready(nxt);
            if constexpr (Epi::MID) { if (t == nt / 2) E.mid(acc, cur, wr, wc, fr, fq); }
            if constexpr (SP2) {
            PG8_LDB(B0, 0, 0); PG8_LDB(B1, 0, 1); PG8_SCHED; PG8_LDA(At, 0, 0); PG8_STAGE(PG8_SA(1, 1), a1 + hstep, voffA);
            PG8_WAIT_V(8); PG8_WAIT_L(0); PG8_BAR; PG8_MMA(0, 0, At, B0); PG8_MMA(0, 1, At, B1); PG8_BAR; PG8_SCHED;
            PG8_LDA(At, 0, 1); PG8_STAGE(PG8_SB(0, 0), b2, voffB); PG8_STAGE(PG8_SB(0, 1), b2 + hstep, voffB); PG8_STAGE(PG8_SA(0, 0), a2, voffA);
            PG8_WAIT_V(8); PG8_WAIT_L(0); PG8_BAR; PG8_MMA(1, 0, At, B0); PG8_MMA(1, 1, At, B1); PG8_BAR; PG8_SCHED;
            PG8_LDB(B0, 1, 0); PG8_LDB(B1, 1, 1); PG8_SCHED; PG8_LDA(At, 1, 0); PG8_STAGE(PG8_SA(0, 1), a2 + hstep, voffA);
            PG8_WAIT_V(8); PG8_WAIT_L(0); PG8_BAR; PG8_MMA(0, 0, At, B0); PG8_MMA(0, 1, At, B1); PG8_BAR; PG8_SCHED;
            PG8_LDA(At, 1, 1); PG8_STAGE(PG8_SB(1, 0), b3, voffB); PG8_STAGE(PG8_SB(1, 1), b3 + hstep, voffB); PG8_STAGE(PG8_SA(1, 0), a3, voffA);
            PG8_WAIT_V(8); PG8_WAIT_L(0); PG8_BAR; PG8_MMA(1, 0, At, B0); PG8_MMA(1, 1, At, B1); PG8_BAR; PG8_SCHED;
            } else {
            PG8_LDB(B0, 0, 0); PG8_SCHED; PG8_LDA(At, 0, 0); PG8_STAGE(PG8_SA(1, 1), a1 + hstep, voffA);
            PG8_WAIT_L(8); PG8_BAR; PG8_WAIT_L(0); PG8_MMA(0, 0, At, B0); PG8_BAR; PG8_SCHED;
            PG8_LDB(B1, 0, 1); PG8_STAGE(PG8_SB(0, 0), b2, voffB);
            PG8_BAR; PG8_WAIT_L(0); PG8_MMA(0, 1, At, B1); PG8_BAR;
            PG8_LDA(At, 0, 1); PG8_STAGE(PG8_SA(0, 0), a2, voffA);
            PG8_BAR; PG8_WAIT_L(0); PG8_MMA(1, 0, At, B0); PG8_BAR; PG8_SCHED;
            PG8_STAGE(PG8_SB(0, 1), b2 + hstep, voffB);
            PG8_WAIT_V(6); PG8_BAR; PG8_MMA(1, 1, At, B1); PG8_BAR;
            PG8_LDB(B0, 1, 0); PG8_SCHED; PG8_LDA(At, 1, 0); PG8_STAGE(PG8_SA(0, 1), a2 + hstep, voffA);
            PG8_WAIT_L(8); PG8_BAR; PG8_WAIT_L(0); PG8_MMA(0, 0, At, B0); PG8_BAR; PG8_SCHED;
            PG8_LDB(B1, 1, 1); PG8_STAGE(PG8_SB(1, 0), b3, voffB);
            PG8_BAR; PG8_WAIT_L(0); PG8_MMA(0, 1, At, B1); PG8_BAR;
            PG8_LDA(At, 1, 1); PG8_STAGE(PG8_SA(1, 0), a3, voffA);
            PG8_BAR; PG8_WAIT_L(0); PG8_MMA(1, 0, At, B0); PG8_BAR; PG8_SCHED;
            PG8_STAGE(PG8_SB(1, 1), b3 + hstep, voffB);
            PG8_WAIT_V(6); PG8_BAR; PG8_MMA(1, 1, At, B1); PG8_BAR;
            }
        }
        if constexpr (ALIGN_EPI) { if (wr == 0) PG8_BAR; }
        if constexpr (!Epi::AFTER_DRAIN) { E(acc, cur, wr, wc, fr, fq); S.done(cur); }
        if (!has_next) break;
#pragma unroll
        for (int a = 0; a < 2; ++a)
#pragma unroll
            for (int b = 0; b < 2; ++b)
#pragma unroll
                for (int m = 0; m < 4; ++m)
#pragma unroll
                    for (int n = 0; n < 2; ++n) acc[a][b][m][n] = (f32x4){0.f, 0.f, 0.f, 0.f};
        cur = nxt; cA = nA; cB = nB; ++ui;
        if constexpr (ALIGN_EPI) { if (wr == 1) PG8_BAR; }
    }
    PG8_WAIT_V(0);
    if constexpr (!ALIGN_EPI) { if (wr == 0) PG8_BAR; }
    PG8_BAR;
    if constexpr (Epi::AFTER_DRAIN) { E.fused(acc, cur, wr, wc, fr, fq, lds, wid, lane); S.done(cur); }
#undef PG8_SA
#undef PG8_SB
#undef PG8_STAGE
#undef PG8_LDA
#undef PG8_LDB
#undef PG8_MMA
#undef PG8_WAIT_V
#undef PG8_WAIT_L
#undef PG8_BAR
#undef PG8_SCHED
}

struct UnitX { int pm, pn; int arow, brow; const int* glist; const float* wlist; int gvalid; int e; unsigned* sync; };
__device__ __forceinline__ void moe_dep_wait(unsigned* dep, unsigned* wdc, unsigned wd_need, volatile PG8_LAS unsigned* lflag, unsigned seq, int wid, unsigned pre_d, unsigned pre_w) {
    if (wid == 0) { unsigned sp = 0; unsigned d = pre_d, w = pre_w;
        while (d < 2u || w < wd_need) { __builtin_amdgcn_s_sleep(16); if (++sp > (1u << 20)) break;
            d = __builtin_amdgcn_readfirstlane(__hip_atomic_load(dep, __ATOMIC_RELAXED, __HIP_MEMORY_SCOPE_AGENT)); w = __builtin_amdgcn_readfirstlane(__hip_atomic_load(wdc, __ATOMIC_RELAXED, __HIP_MEMORY_SCOPE_AGENT)); }
        *lflag = seq; }
    else { unsigned sp = 0; while (*lflag < seq) { __builtin_amdgcn_s_sleep(4); if (++sp > (1u << 22)) break; } }
    asm volatile("" ::: "memory");
}
template <class Epi, class Sched, bool GATHER, int MODE = 0>
__device__ __forceinline__ void gemm_phase_x(PG8_LAS unsigned char* lds, const Gemm g, const Sched& S, const Epi& E, volatile PG8_LAS unsigned* lflag = nullptr, unsigned* wdc = nullptr, unsigned wd_need = 0u) {
    const int tid = threadIdx.x, wid = __builtin_amdgcn_readfirstlane(tid >> 6), lane = tid & 63, wr = wid >> 2, wc = wid & 3, fr = lane & 15, fq = lane >> 4;
    const int K = g.K, nt = K / BK;
    unsigned vA[2][2], voffB[2]; int tokn[2][2]; int Rr[2], Cc[2];
#pragma unroll
    for (int i = 0; i < 2; ++i) { int R, C; stage_rc(tid * 16 + i * 8192, R, C); const int Rb = Epi::PERM ? ((R & ~31) + perm32(R & 31)) : R; Rr[i] = R; Cc[i] = C; voffB[i] = (unsigned)(Rb * K + C) * 2u; }
    const size_t kstep = (size_t)(BK * 2), hstep = (size_t)HALF * K * 2;
    const unsigned ldsw = (unsigned)wid * 1024u;
    const int aoff = lds_byte(wr * 64 + fr, fq * 8), boff = lds_byte(wc * 32 + fr, fq * 8);
#define PG8_SA(b, h) (((b) * 2 + (h)) * HTB)
#define PG8_SB(b, h) ((4 + (b) * 2 + (h)) * HTB)
#define PG8_STAGE(bufoff, gbase, voff) do { _Pragma("unroll") for (int _i = 0; _i < 2; ++_i) \
        __builtin_amdgcn_global_load_lds((const unsigned*)((const char*)(gbase) + (voff)[_i]), (PG8_LAS unsigned*)(lds + (bufoff) + ldsw + _i * 8192), 16, 0, 0); } while (0)
#define PG8_LDA(dst, b, h) do { _Pragma("unroll") for (int m = 0; m < 4; ++m) _Pragma("unroll") for (int k = 0; k < 2; ++k) dst[m][k] = *(const PG8_LAS bf16x8*)(lds + PG8_SA(b, h) + aoff + m * 2048 + k * 1024); } while (0)
#define PG8_LDB(dst, b, h) do { _Pragma("unroll") for (int n = 0; n < 2; ++n) _Pragma("unroll") for (int k = 0; k < 2; ++k) dst[n][k] = *(const PG8_LAS bf16x8*)(lds + PG8_SB(b, h) + boff + n * 2048 + k * 1024); } while (0)
#define PG8_MMA(ai, bj, At, Bt) do { __builtin_amdgcn_s_setprio(1); _Pragma("unroll") for (int m = 0; m < 4; ++m) _Pragma("unroll") for (int n = 0; n < 2; ++n) _Pragma("unroll") for (int k = 0; k < 2; ++k) \
        acc[ai][bj][m][n] = __builtin_amdgcn_mfma_f32_16x16x32_bf16(Bt[n][k], At[m][k], acc[ai][bj][m][n], 0, 0, 0); __builtin_amdgcn_s_setprio(0); } while (0)
#define PG8_WAIT_V(n) asm volatile("s_waitcnt vmcnt(" #n ")" ::: "memory")
#define PG8_WAIT_L(n) asm volatile("s_waitcnt lgkmcnt(" #n ")" ::: "memory")
#define PG8_BAR __builtin_amdgcn_s_barrier()
#define PG8_SCHED __builtin_amdgcn_sched_barrier(0)
#define PG8_TOK(U, r) (GATHER ? (((r) < (U).gvalid) ? (U).glist[(r)] : 0) : ((U).arow + (r)))
    UnitX cur, nxt; int ui = 0;
    if (!S.next(0, cur)) return;
    if constexpr (MODE == 2) moe_dep_wait(cur.sync, wdc, wd_need, lflag, 1u, wid, 0u, 0u);
    f32x4 acc[2][2][4][2];
#pragma unroll
    for (int a = 0; a < 2; ++a)
#pragma unroll
        for (int b = 0; b < 2; ++b)
#pragma unroll
            for (int m = 0; m < 4; ++m)
#pragma unroll
                for (int n = 0; n < 2; ++n) acc[a][b][m][n] = (f32x4){0.f, 0.f, 0.f, 0.f};
    bf16x8 At[4][2], B0[2][2], B1[2][2];
#pragma unroll
    for (int h = 0; h < 2; ++h)
#pragma unroll
        for (int i = 0; i < 2; ++i) vA[h][i] = (unsigned)(PG8_TOK(cur, h * HALF + Rr[i]) * K + Cc[i]) * 2u;
    const char* gA = (const char*)g.A; const char* cB = (const char*)g.Bt + (size_t)cur.brow * K * 2;
    PG8_STAGE(PG8_SB(0, 0), cB, voffB); PG8_STAGE(PG8_SB(0, 1), cB + hstep, voffB); PG8_STAGE(PG8_SA(0, 0), gA, vA[0]); PG8_STAGE(PG8_SA(0, 1), gA, vA[1]);
    if (wr == 1) PG8_BAR;
    PG8_WAIT_V(2); PG8_BAR;
    PG8_STAGE(PG8_SB(1, 0), cB + kstep, voffB); PG8_STAGE(PG8_SA(1, 0), gA + kstep, vA[0]); PG8_STAGE(PG8_SB(1, 1), cB + hstep + kstep, voffB);
    PG8_WAIT_V(6); PG8_BAR;
    for (;;) {
        const bool has_next = S.next(ui + 1, nxt);
        unsigned pre_d = 0u, pre_w = 0u;
        if constexpr (MODE == 2) { if (has_next && wid == 0) { pre_d = __hip_atomic_load(nxt.sync, __ATOMIC_RELAXED, __HIP_MEMORY_SCOPE_AGENT); pre_w = __hip_atomic_load(wdc, __ATOMIC_RELAXED, __HIP_MEMORY_SCOPE_AGENT); } }
        const char* nB = has_next ? (const char*)g.Bt + (size_t)nxt.brow * K * 2 : cB;
        if (has_next) {
#pragma unroll
            for (int h = 0; h < 2; ++h)
#pragma unroll
                for (int i = 0; i < 2; ++i) tokn[h][i] = PG8_TOK(nxt, h * HALF + Rr[i]);
        }
#pragma clang loop unroll(disable)
        for (int t = 0; t < nt; t += 2) {
            const bool last = (t == nt - 2);
            const char* b2 = last ? nB : cB + (size_t)(t + 2) * kstep; const char* b3 = b2 + kstep;
            const size_t ko2 = last ? (size_t)0 : (size_t)(t + 2) * kstep;
            PG8_LDB(B0, 0, 0); PG8_LDB(B1, 0, 1); PG8_SCHED; PG8_LDA(At, 0, 0); PG8_STAGE(PG8_SA(1, 1), gA + (size_t)(t + 1) * kstep, vA[1]);
            PG8_WAIT_V(8); PG8_WAIT_L(0); PG8_BAR; PG8_MMA(0, 0, At, B0); PG8_MMA(0, 1, At, B1); PG8_BAR; PG8_SCHED;
            if (last && has_next) {
                if constexpr (MODE == 2) moe_dep_wait(nxt.sync, wdc, wd_need, lflag, (unsigned)(ui + 2), wid, (unsigned)__builtin_amdgcn_readfirstlane((int)pre_d), (unsigned)__builtin_amdgcn_readfirstlane((int)pre_w));
#pragma unroll
                for (int h = 0; h < 2; ++h)
#pragma unroll
                    for (int i = 0; i < 2; ++i) vA[h][i] = (unsigned)(tokn[h][i] * K + Cc[i]) * 2u;
            }
            PG8_LDA(At, 0, 1); PG8_STAGE(PG8_SB(0, 0), b2, voffB); PG8_STAGE(PG8_SB(0, 1), b2 + hstep, voffB); PG8_STAGE(PG8_SA(0, 0), gA + ko2, vA[0]);
            PG8_WAIT_V(8); PG8_WAIT_L(0); PG8_BAR; PG8_MMA(1, 0, At, B0); PG8_MMA(1, 1, At, B1); PG8_BAR; PG8_SCHED;
            PG8_LDB(B0, 1, 0); PG8_LDB(B1, 1, 1); PG8_SCHED; PG8_LDA(At, 1, 0); PG8_STAGE(PG8_SA(0, 1), gA + ko2, vA[1]);
            PG8_WAIT_V(8); PG8_WAIT_L(0); PG8_BAR; PG8_MMA(0, 0, At, B0); PG8_MMA(0, 1, At, B1); PG8_BAR; PG8_SCHED;
            PG8_LDA(At, 1, 1); PG8_STAGE(PG8_SB(1, 0), b3, voffB); PG8_STAGE(PG8_SB(1, 1), b3 + hstep, voffB); PG8_STAGE(PG8_SA(1, 0), gA + ko2 + kstep, vA[0]);
            PG8_WAIT_V(8); PG8_WAIT_L(0); PG8_BAR; PG8_MMA(1, 0, At, B0); PG8_MMA(1, 1, At, B1); PG8_BAR; PG8_SCHED;
        }
        if (wr == 0) PG8_BAR;
        { const int l2_ = (int)__builtin_amdgcn_mbcnt_hi(~0u, __builtin_amdgcn_mbcnt_lo(~0u, 0u)); E(acc, cur, wr, wc, l2_ & 15, l2_ >> 4); }
        if constexpr (MODE == 1) {
            asm volatile("s_waitcnt vmcnt(0)" ::: "memory"); PG8_BAR;
            if (wid == 0 && __builtin_amdgcn_mbcnt_hi(~0u, __builtin_amdgcn_mbcnt_lo(~0u, 0u)) == 0u) __hip_atomic_fetch_add(cur.sync, 1u, __ATOMIC_RELAXED, __HIP_MEMORY_SCOPE_AGENT); }
        if (!has_next) break;
#pragma unroll
        for (int a = 0; a < 2; ++a)
#pragma unroll
            for (int b = 0; b < 2; ++b)
#pragma unroll
                for (int m = 0; m < 4; ++m)
#pragma unroll
                    for (int n = 0; n < 2; ++n) acc[a][b][m][n] = (f32x4){0.f, 0.f, 0.f, 0.f};
        cur = nxt; cB = nB; ++ui;
        if (wr == 1) PG8_BAR;
    }
    PG8_WAIT_V(0);
    PG8_BAR;
#undef PG8_TOK
#undef PG8_SA
#undef PG8_SB
#undef PG8_STAGE
#undef PG8_LDA
#undef PG8_LDB
#undef PG8_MMA
#undef PG8_WAIT_V
#undef PG8_WAIT_L
#undef PG8_BAR
#undef PG8_SCHED
}
struct MoeTiles { PG8_LAS int* te; PG8_LAS int* tm; PG8_LAS int* tv; int T; };
struct SchedMoeA {
    MoeTiles mt; const int* ELT; const float* ELW; int vcu, G; unsigned* DONE;
    __device__ __forceinline__ bool next(int i, UnitX& u) const {
        const int idx = i * G + vcu; if (idx >= 2 * mt.T) return false;
        const int ti = idx >> 1, nn = idx & 1, e = mt.te[ti], m = mt.tm[ti];
        u.pm = ti; u.pn = nn; u.arow = 0; u.brow = e * 512 + nn * 256; u.glist = ELT + e * M + m * 256; u.wlist = ELW + e * M + m * 256; u.gvalid = mt.tv[ti]; u.e = e; u.sync = DONE + ti * 16; return true; }
};
struct SchedMoeB {
    MoeTiles mt; int vcu, G; unsigned* DONE;
    __device__ __forceinline__ bool next(int i, UnitX& u) const {
        int nA = 2 * mt.T - G; if (nA < 0 || nA >= G - 32) nA = 0; const int nB = G - nA;
        int idx; const int base3 = 3 * nB + nA;
        if (vcu < nA) idx = i == 0 ? 2 * nB + vcu : base3 + (i - 1) * G + vcu;
        else { const int j = vcu - nA; idx = i < 2 ? i * nB + j : (i == 2 ? 2 * nB + nA + j : base3 + (i - 3) * G + vcu); }
        if (idx >= 4 * mt.T) return false;
        const int ti = idx >> 2, nn = idx & 3, e = mt.te[ti];
        u.pm = ti; u.pn = nn; u.arow = ti * 256; u.brow = e * 1024 + nn * 256; u.glist = nullptr; u.wlist = nullptr; u.gvalid = 256; u.e = e; u.sync = DONE + ti * 16; return true; }
};
struct EpiAct {
    static constexpr bool PERM = true;
    bf16_t* ACT; __amdgpu_buffer_rsrc_t rsrc;
    __device__ __forceinline__ void operator()(const f32x4 (&acc)[2][2][4][2], const UnitX& u, int wr, int wc, int fr, int fq) const {
        int base = ((u.pm * BM + wr * 64 + fr) * 256 + u.pn * 128 + wc * 32 + 8 * fq) * 2; asm volatile("" : "+v"(base));
        const int r0 = wr * 64 + fr;
        float wv[2][4];
#pragma unroll
        for (int ai = 0; ai < 2; ++ai)
#pragma unroll
            for (int m = 0; m < 4; ++m) { const int r = ai * HALF + m * 16 + r0; wv[ai][m] = r < u.gvalid ? u.wlist[r] : 0.f; }
        __builtin_amdgcn_sched_barrier(0);
#pragma unroll
        for (int ai = 0; ai < 2; ++ai)
#pragma unroll
            for (int m = 0; m < 4; ++m) { const float w = wv[ai][m];
                f32x4 v0, v1;
#pragma unroll
                for (int j = 0; j < 4; ++j) { const float g0 = acc[ai][0][m][0][j], g1 = acc[ai][0][m][1][j];
                    v0[j] = g0 * __builtin_amdgcn_rcpf(1.f + __builtin_amdgcn_exp2f(-1.4426950408889634f * g0)) * acc[ai][1][m][0][j] * w;
                    v1[j] = g1 * __builtin_amdgcn_rcpf(1.f + __builtin_amdgcn_exp2f(-1.4426950408889634f * g1)) * acc[ai][1][m][1][j] * w; }
                u32x4 o; o.x = cvt_pk_bf16(v0[0], v0[1]); o.y = cvt_pk_bf16(v0[2], v0[3]); o.z = cvt_pk_bf16(v1[0], v1[1]); o.w = cvt_pk_bf16(v1[2], v1[3]);
                __builtin_amdgcn_raw_buffer_store_b128(o, rsrc, base + (ai * HALF + m * 16) * 512, 0, 16  ); }
    }
};
struct EpiY {
    static constexpr bool PERM = true;
    bf16_t* Y; __amdgpu_buffer_rsrc_t yrsrc;
    __device__ __forceinline__ void operator()(const f32x4 (&acc)[2][2][4][2], const UnitX& u, int wr, int wc, int fr, int fq) const {
        const int c0 = u.pn * BM + wc * 32 + 8 * fq;
#pragma unroll
        for (int ai = 0; ai < 2; ++ai)
#pragma unroll
            for (int m = 0; m < 4; ++m) { const int ro = (u.pm * BM + ai * HALF + wr * 64 + m * 16 + fr) * 1024 + c0;
#pragma unroll
                for (int bj = 0; bj < 2; ++bj) { const f32x4 v0 = acc[ai][bj][m][0], v1 = acc[ai][bj][m][1]; u32x4 o;
                    o.x = cvt_pk_bf16(v0[0], v0[1]); o.y = cvt_pk_bf16(v0[2], v0[3]); o.z = cvt_pk_bf16(v1[0], v1[1]); o.w = cvt_pk_bf16(v1[2], v1[3]);
                    __builtin_amdgcn_raw_buffer_store_b128(o, yrsrc, (ro + bj * HALF) * 2, 0, 16  ); } }
    }
};
}

struct TrItem { const float* W; bf16_t* WT; int N, ldd, k0, kd0, n0, drow0; };
DEV void tr_load(const TrItem& t, f32x4 (&r)[8], int lane) {
    const float* p = t.W + (size_t)(t.k0 + (lane >> 3)) * t.N + t.n0 + (lane & 7) * 4;
#pragma unroll
    for (int i = 0; i < 8; ++i) r[i] = __builtin_nontemporal_load((const f32x4*)(p + (size_t)(8 * i) * t.N));
}
template <bool SC1 = false> DEV void tr_emit(const TrItem& t, const f32x4 (&r)[8], LAS float* scr, int lane, __amdgpu_buffer_rsrc_t wrsrc = __amdgpu_buffer_rsrc_t(), const bf16_t* wbase = nullptr) {
    { const int kq = lane >> 3, nq = (lane & 7) * 4;
#pragma unroll
      for (int i = 0; i < 8; ++i) { LAS float* d = scr + (8 * i + kq) * 33 + nq; d[0] = r[i].x; d[1] = r[i].y; d[2] = r[i].z; d[3] = r[i].w; } }
    LDS_WAIT(); asm volatile("" ::: "memory");
    const int c = lane & 7;
#pragma unroll
    for (int j = 0; j < 4; ++j) { const int n = (lane >> 3) + 8 * j; const LAS float* s = scr + (8 * c) * 33 + n;
        v4u o; o.x = pk2(s[0 * 33], s[1 * 33]); o.y = pk2(s[2 * 33], s[3 * 33]); o.z = pk2(s[4 * 33], s[5 * 33]); o.w = pk2(s[6 * 33], s[7 * 33]);
        if constexpr (SC1) __builtin_amdgcn_raw_buffer_store_b128(o, wrsrc, (int)((t.WT + (size_t)(t.drow0 + n) * t.ldd + t.kd0 + 8 * c) - wbase) * 2, 0, 16  );
        else *(GAS v4u*)(t.WT + (size_t)(t.drow0 + n) * t.ldd + t.kd0 + 8 * c) = o; }
    LDS_WAIT(); asm volatile("" ::: "memory");
}
DEV int in_row_map(int c0) {
    if (c0 < 1024) { const int sect = c0 >> 9, cc = c0 & 511, tile = cc >> 8, u = (cc & 255) >> 6, half = (cc & 63) >> 5; return sect * 512 + tile * 256 + half * 128 + u * 32; }
    if (c0 < 2048) return c0;
    if (c0 < 3072) { const int isu = c0 >= 2560, ch = c0 - (isu ? 2560 : 2048); return 2048 + (ch >> 7) * 256 + isu * 128 + (ch & 127); }
    return c0;
}
DEV void p0_prologue(Frame& F, const Args& a) {
    const float* c = (const float*)a.in[1]; const int* pos = (const int*)a.in[2]; const float* w_ada = (const float*)a.in[3]; const float* b_ada = (const float*)a.in[4];
    float* MOD = (float*)(F.ws + WS_MOD); float* ROPE = (float*)(F.ws + WS_ROPE);
    {
        LAS float* ca = (LAS float*)F.lds;
        LAS float* part = (LAS float*)(F.lds + 16384);
        bool need_ca = true;
        for (int ch = F.vcu; ch < 192; ch += F.G) {
            const int c4 = F.tid & 7, ks = F.tid >> 3;
            f32x4 wv[16];
#pragma unroll
            for (int j = 0; j < 16; ++j) wv[j] = __builtin_nontemporal_load((const f32x4*)(w_ada + (size_t)(ks + 64 * j) * 6144 + ch * 32 + 4 * c4));
            if (need_ca) { need_ca = false; __builtin_amdgcn_sched_barrier(0);
                for (int i = F.tid; i < 4 * DM; i += NTHR) { const float v = c[i]; ca[i] = v / (1.f + expf(-v)); }
                __syncthreads(); }
            f32x4 a0 = {0.f, 0.f, 0.f, 0.f}, a1 = a0, a2 = a0, a3 = a0;
#pragma unroll
            for (int j = 0; j < 16; ++j) { const int k = ks + 64 * j; a0 += wv[j] * ca[k]; a1 += wv[j] * ca[DM + k]; a2 += wv[j] * ca[2 * DM + k]; a3 += wv[j] * ca[3 * DM + k]; }
            *(LAS f32x4*)(part + (ks * 4 + 0) * 36 + 4 * c4) = a0; *(LAS f32x4*)(part + (ks * 4 + 1) * 36 + 4 * c4) = a1;
            *(LAS f32x4*)(part + (ks * 4 + 2) * 36 + 4 * c4) = a2; *(LAS f32x4*)(part + (ks * 4 + 3) * 36 + 4 * c4) = a3;
            __syncthreads();
            { const int o_ = F.tid >> 2, sub = F.tid & 3, b = o_ >> 5, cc = o_ & 31;
              float sacc = 0.f;
#pragma unroll
              for (int q = 0; q < 16; ++q) sacc += part[((sub * 16 + q) * 4 + b) * 36 + cc];
              sacc += __int_as_float(__builtin_amdgcn_update_dpp(0, __float_as_int(sacc), 0xB1, 0xF, 0xF, true));
              sacc += __int_as_float(__builtin_amdgcn_update_dpp(0, __float_as_int(sacc), 0x4E, 0xF, 0xF, true));
              if (sub == 0) __hip_atomic_store(MOD + b * 6144 + ch * 32 + cc, sacc + b_ada[ch * 32 + cc], __ATOMIC_RELAXED, __HIP_MEMORY_SCOPE_AGENT); }
            asm volatile("s_waitcnt vmcnt(0)" ::: "memory");
            __syncthreads();
            if (F.tid == 0) __hip_atomic_fetch_add(F.ctl + CW_MODC, 1u, __ATOMIC_RELAXED, __HIP_MEMORY_SCOPE_AGENT);
        }
    }
    const int gt = F.vcu * NTHR + F.tid, NGT = F.G * NTHR;
    for (int idx = gt; idx < M * 32; idx += NGT) {
        const int row = idx >> 5, i = idx & 31;
        const float inv = exp2f(-(float)i * (13.287712379549449f / 32.f));
        float s, cs; sincosf((float)pos[row] * inv, &s, &cs);
        __hip_atomic_store((unsigned long long*)(ROPE + idx * 2), (unsigned long long)__float_as_uint(cs) | ((unsigned long long)__float_as_uint(s) << 32), __ATOMIC_RELAXED, __HIP_MEMORY_SCOPE_AGENT);
    }
    {
        const float* w_grp = (const float*)a.in[17]; const float* w_exr = (const float*)a.in[19];
        bf16_t* RH = (bf16_t*)(F.ws + WS_WT_R); bf16_t* RL = RH + 48 * DM;
        for (int idx = gt; idx < 48 * DM; idx += NGT) { const int n = idx >> 10, k = idx & 1023;
            const float w = n < 4 ? w_grp[k * 4 + n] : (n < 36 ? w_exr[k * 32 + (n - 4)] : 0.f);
            const bf16_t h = f2bf(w); __hip_atomic_store((unsigned short*)(RH + idx), (unsigned short)h, __ATOMIC_RELAXED, __HIP_MEMORY_SCOPE_AGENT); __hip_atomic_store((unsigned short*)(RL + idx), (unsigned short)f2bf(w - bf2f(h)), __ATOMIC_RELAXED, __HIP_MEMORY_SCOPE_AGENT); }
    }
    __syncthreads();
    LAS float* scr = (LAS float*)(F.lds + F.wave * 16384);
    const int gw = F.vcu * NWAVES + F.wave, NGW = F.G * NWAVES;
    constexpr int I_IN = 16 * 160, I_A = 8 * 32, I_O = 16 * 32, I_G = 32 * 16 * 8, I_D = 32 * 4 * 32;
    constexpr int NITEMS = I_IN + 2 * I_A + I_O + 2 * I_G;
    (void)I_D;
    auto decode = [&](int it) -> TrItem {
        TrItem t; int r = it;
        if (r < I_IN) { const int kb = r / 160, nb = r % 160; t.W = (const float*)a.in[6]; t.N = INW; t.WT = (bf16_t*)(F.ws + WS_WT_IN); t.ldd = DM; t.k0 = kb * 64; t.kd0 = t.k0; t.n0 = nb * 32; t.drow0 = in_row_map(nb * 32); return t; } r -= I_IN;
        if (r < I_A) { const int kb = r / 32, nb = r % 32; t.W = (const float*)a.in[13]; t.N = DM; t.WT = (bf16_t*)(F.ws + WS_WT_A); t.ldd = 1024; t.k0 = kb * 64; t.kd0 = t.k0; t.n0 = nb * 32; t.drow0 = nb * 32; return t; } r -= I_A;
        if (r < I_A) { const int kb = r / 32, nb = r % 32; t.W = (const float*)a.in[14]; t.N = DM; t.WT = (bf16_t*)(F.ws + WS_WT_A); t.ldd = 1024; t.k0 = kb * 64; t.kd0 = 512 + t.k0; t.n0 = nb * 32; t.drow0 = nb * 32; return t; } r -= I_A;
        if (r < I_O) { const int kb = r / 32, nb = r % 32; t.W = (const float*)a.in[15]; t.N = DM; t.WT = (bf16_t*)(F.ws + WS_WT_O); t.ldd = DM; t.k0 = kb * 64; t.kd0 = t.k0; t.n0 = nb * 32; t.drow0 = nb * 32; return t; } r -= I_O;
        if (r < 2 * I_G) { const int isu = r >= I_G; if (isu) r -= I_G; const int e = r / 128, q = r % 128, kb = q / 8, nb = q % 8, n0 = nb * 32;
            t.W = (const float*)a.in[isu ? 22 : 21] + (size_t)e * DM * FF; t.N = FF; t.WT = (bf16_t*)(F.ws + WS_WT_GU) + (size_t)e * 512 * DM; t.ldd = DM; t.k0 = kb * 64; t.kd0 = t.k0; t.n0 = n0; t.drow0 = (n0 >> 7) * 256 + isu * 128 + (n0 & 127); return t; } r -= 2 * I_G;
        { const int e = r / 128, q = r % 128, kb = q / 32, nb = q % 32;
          t.W = (const float*)a.in[23] + (size_t)e * FF * DM; t.N = DM; t.WT = (bf16_t*)(F.ws + WS_WT_D) + (size_t)e * DM * FF; t.ldd = FF; t.k0 = kb * 64; t.kd0 = t.k0; t.n0 = nb * 32; t.drow0 = nb * 32; return t; }
    };
    const __amdgpu_buffer_rsrc_t wrsrc = __builtin_amdgcn_make_buffer_rsrc((void*)(F.ws + WS_WEIGHTS), 0, 64 * 1024 * 1024, 0x00020000);
    if (gw < NITEMS) {
        TrItem cur = decode(gw); f32x4 rc[8]; tr_load(cur, rc, F.lane);
        for (int it = gw; it < NITEMS; it += NGW) {
            const int nx = it + NGW; TrItem nxt = cur; f32x4 rn[8];
            if (nx < NITEMS) { nxt = decode(nx); tr_load(nxt, rn, F.lane); }
            tr_emit<true>(cur, rc, scr, F.lane, wrsrc, (const bf16_t*)(F.ws + WS_WEIGHTS));
            if (nx < NITEMS) { cur = nxt;
#pragma unroll
                for (int i = 0; i < 8; ++i) rc[i] = rn[i]; }
        }
    }
    asm volatile("s_waitcnt vmcnt(0)" ::: "memory"); __syncthreads();
    if (F.tid == 0) __hip_atomic_fetch_add(F.ctl + CW_P0C, 1u, __ATOMIC_RELAXED, __HIP_MEMORY_SCOPE_AGENT);
}

DEV void p7_wdown_transposes(Frame& F, const Args& a, int worker, int nworkers, unsigned* wdc) {
    LAS float* scr = (LAS float*)(F.lds + F.wave * 16384);
    constexpr int I_D = 32 * 4 * 32;
    auto decode = [&](int r) -> TrItem { TrItem t; const int e = r / 128, q = r % 128, kb = q / 32, nb = q % 32;
        t.W = (const float*)a.in[23] + (size_t)e * FF * DM; t.N = DM; t.WT = (bf16_t*)(F.ws + WS_WT_D) + (size_t)e * DM * FF; t.ldd = FF; t.k0 = kb * 64; t.kd0 = t.k0; t.n0 = nb * 32; t.drow0 = nb * 32; return t; };
    const int gw = worker * NWAVES + F.wave, NGW = nworkers * NWAVES;
    const __amdgpu_buffer_rsrc_t wrsrc = __builtin_amdgcn_make_buffer_rsrc((void*)(F.ws + WS_WEIGHTS), 0, 64 * 1024 * 1024, 0x00020000);
    if (gw < I_D) {
        TrItem cur = decode(gw); f32x4 rc[8]; tr_load(cur, rc, F.lane);
        for (int it = gw; it < I_D; it += NGW) {
            const int nx = it + NGW; TrItem nxt = cur; f32x4 rn[8];
            if (nx < I_D) { nxt = decode(nx); tr_load(nxt, rn, F.lane); }
            tr_emit<true>(cur, rc, scr, F.lane, wrsrc, (const bf16_t*)(F.ws + WS_WEIGHTS));
            if (nx < I_D) { cur = nxt;
#pragma unroll
                for (int i = 0; i < 8; ++i) rc[i] = rn[i]; }
        }
    }
    asm volatile("s_waitcnt vmcnt(0)" ::: "memory"); __syncthreads();
    if (F.tid == 0) __hip_atomic_fetch_add(wdc, 1u, __ATOMIC_RELAXED, __HIP_MEMORY_SCOPE_AGENT);
}
DEV void p1_h(Frame& F, const Args& a) {
    { unsigned sp = 0;
      while (__builtin_amdgcn_readfirstlane(__hip_atomic_load(F.ctl + CW_MODC, __ATOMIC_RELAXED, __HIP_MEMORY_SCOPE_AGENT)) < 192u) { __builtin_amdgcn_s_sleep(8); if (++sp > (1u << 20)) break; }
      asm volatile("" ::: "memory"); }
    const float* x = (const float*)a.in[0]; const float* g = (const float*)a.in[5]; const float* MOD = (const float*)(F.ws + WS_MOD); bf16_t* Hb = (bf16_t*)(F.ws + WS_H);
    for (int ch = F.vcu; ch < M / 64; ch += F.G) {
    for (int m0 = ch * 64 + F.wave; m0 < ch * 64 + 64; m0 += 2 * NWAVES) {
        const int m1 = m0 + NWAVES;
        const GAS f32x4* xr0 = (const GAS f32x4*)(x + (size_t)m0 * DM) + F.lane; const GAS f32x4* xr1 = (const GAS f32x4*)(x + (size_t)m1 * DM) + F.lane;
        f32x4 v0[4], v1[4]; float s0 = 0.f, s1 = 0.f;
#pragma unroll
        for (int j = 0; j < 4; ++j) { v0[j] = __builtin_nontemporal_load(xr0 + 64 * j); v1[j] = __builtin_nontemporal_load(xr1 + 64 * j); }
#pragma unroll
        for (int j = 0; j < 4; ++j) { s0 += (v0[j].x * v0[j].x + v0[j].y * v0[j].y) + (v0[j].z * v0[j].z + v0[j].w * v0[j].w); s1 += (v1[j].x * v1[j].x + v1[j].y * v1[j].y) + (v1[j].z * v1[j].z + v1[j].w * v1[j].w); }
        const float r0 = rsqrtf(wave_sum(s0) * (1.f / DM) + EPS), r1 = rsqrtf(wave_sum(s1) * (1.f / DM) + EPS);
        const float* md0 = MOD + (m0 / SEQ) * 6144; const float* md1 = MOD + (m1 / SEQ) * 6144;
        GAS unsigned long long* o0 = (GAS unsigned long long*)(Hb + (size_t)m0 * DM) + F.lane; GAS unsigned long long* o1 = (GAS unsigned long long*)(Hb + (size_t)m1 * DM) + F.lane;
#pragma unroll
        for (int j = 0; j < 4; ++j) { const int k = 4 * F.lane + 256 * j; const f32x4 gg = *(const f32x4*)(g + k);
            const f32x4 h0 = v0[j] * r0 * gg * (*(const f32x4*)(md0 + 1024 + k) + 1.f) + *(const f32x4*)(md0 + k);
            const f32x4 h1 = v1[j] * r1 * gg * (*(const f32x4*)(md1 + 1024 + k) + 1.f) + *(const f32x4*)(md1 + k);
            __hip_atomic_store((unsigned long long*)(o0 + 64 * j), (unsigned long long)pk2(h0.x, h0.y) | ((unsigned long long)pk2(h0.z, h0.w) << 32), __ATOMIC_RELAXED, __HIP_MEMORY_SCOPE_AGENT);
            __hip_atomic_store((unsigned long long*)(o1 + 64 * j), (unsigned long long)pk2(h1.x, h1.y) | ((unsigned long long)pk2(h1.z, h1.w) << 32), __ATOMIC_RELAXED, __HIP_MEMORY_SCOPE_AGENT); }
    }
    asm volatile("s_waitcnt vmcnt(0)" ::: "memory"); __syncthreads();
    if (F.tid == 0) __hip_atomic_fetch_add(F.ctl + CW_PC1 + (ch >> 2) * 16, 1u, __ATOMIC_RELAXED, __HIP_MEMORY_SCOPE_AGENT);
    }
}

namespace att {
typedef short bf16x8 __attribute__((ext_vector_type(8)));
typedef short s16x4 __attribute__((ext_vector_type(4)));
typedef float f32x16 __attribute__((ext_vector_type(16)));
typedef float f32x4 __attribute__((ext_vector_type(4)));
typedef unsigned u32x4 __attribute__((ext_vector_type(4)));
constexpr int LD = 512;
constexpr int LDO = 1024;
constexpr int NW = 8, QBLK = 32, KVBLK = 64, QB = 128, NQB = SEQ / QB;
constexpr int SHM_V = KVBLK * 128 * 2, SHM_K = KVBLK * 128 * 2;
constexpr int LDS_WS = 2 * SHM_V + 2 * SHM_K, LDS_XCH = LDS_WS + NW * 64 * 4, LDS_END = LDS_XCH + 4 * 32 * 128 * 4;
constexpr float SCALE = 0.125f, THR = 8.f;
#define KSWZ(row, colB) ((row) * 256 + ((colB) ^ (((row) & 7) << 4)))
#define SBAR() __builtin_amdgcn_sched_barrier(0)
__device__ __forceinline__ int v_st(int k, int c) { const int kk = k;     return ((kk >> 3) * 4 + (c >> 5)) * 512 + ((kk & 7) * 32 + (c & 31)) * 2; }
__device__ __forceinline__ int v_rd_base(int lane) { return ((lane & 3) << 3) | (((lane >> 2) & 3) << 6) | (((lane >> 4) & 1) << 5) | (((lane >> 5) & 1) << 8); }
constexpr int v_rd_off(int d0, int ks, int half) { return d0 * 512 + ks * 4096 + half * 2048; }
__device__ __forceinline__ int crow(int r, int hi) { return (r & 3) + 8 * (r >> 2) + 4 * hi; }
typedef float f32x2a_t __attribute__((ext_vector_type(2))); typedef __bf16 bf16x2a_t __attribute__((ext_vector_type(2)));
__device__ __forceinline__ unsigned cvtpk(float lo, float hi) { f32x2a_t v = {lo, hi}; bf16x2a_t b = __builtin_convertvector(v, bf16x2a_t); return __builtin_bit_cast(unsigned, b); }
__device__ __forceinline__ bf16x8 load8(const bf16_t* p) { return *reinterpret_cast<const bf16x8*>(p); }
template <int CTRL> __device__ __forceinline__ float dppf(float v) { return __int_as_float(__builtin_amdgcn_update_dpp(0, __float_as_int(v), CTRL, 0xF, 0xF, true)); }
__device__ __forceinline__ void mask_tile(f32x16& p0, f32x16& p1, int dq) {
    const float NEG = -__builtin_inff();
#pragma unroll
    for (int r = 0; r < 16; ++r) { const int c = (r & 3) + 8 * (r >> 2); if (dq - c < 0) p0[r] = NEG; if (dq - c - 32 < 0) p1[r] = NEG; }
}
__device__ __forceinline__ void partialSM(f32x16& p0, f32x16& p1, float& m_reg, float& mn, float& alpha) {
    float pmax = p0[0]; for (int r = 1; r < 16; ++r) pmax = fmaxf(pmax, p0[r]); for (int r = 0; r < 16; ++r) pmax = fmaxf(pmax, p1[r]);
    { auto rr = __builtin_amdgcn_permlane32_swap(__float_as_uint(pmax), __float_as_uint(pmax), false, false);
      pmax = fmaxf(__uint_as_float(rr[0]), __uint_as_float(rr[1])); }
    m_reg = pmax; mn = pmax; alpha = 0.f;
    for (int r = 0; r < 16; ++r) p0[r] -= pmax; for (int r = 0; r < 16; ++r) p1[r] -= pmax;
    for (int r = 0; r < 16; ++r) p0[r] = __builtin_amdgcn_exp2f(p0[r]);
    for (int r = 0; r < 8; ++r) p1[r] = __builtin_amdgcn_exp2f(p1[r]);
}
__device__ __forceinline__ void finishSM(f32x16& p0, f32x16& p1, float alpha, float& l_reg, bf16x8& pa0, bf16x8& pa1, bf16x8& pa2, bf16x8& pa3) {
    for (int r = 8; r < 16; ++r) p1[r] = __builtin_amdgcn_exp2f(p1[r]);
    float ps = 0; for (int r = 0; r < 16; ++r) ps += p0[r]; for (int r = 0; r < 16; ++r) ps += p1[r];
    { auto rr = __builtin_amdgcn_permlane32_swap(__float_as_uint(ps), __float_as_uint(ps), false, false);
      ps = __uint_as_float(rr[0]) + __uint_as_float(rr[1]); }
    l_reg = l_reg * alpha + ps;
#define PK4(P, B_, OUT) do { u32x4 w = {cvtpk(P[B_+0], P[B_+1]), cvtpk(P[B_+2], P[B_+3]), cvtpk(P[B_+4], P[B_+5]), cvtpk(P[B_+6], P[B_+7])};     \
        OUT = *reinterpret_cast<bf16x8*>(&w); } while (0)
    PK4(p0, 0, pa0); PK4(p0, 8, pa1); PK4(p1, 0, pa2); PK4(p1, 8, pa3);
#undef PK4
}
template <int KB>
__device__ __forceinline__ void qkt(f32x16& p0, f32x16& p1, const char* K_lds, int r32, int hi, int mp, const bf16x8* qr) {
    p0 = f32x16{}; p1 = f32x16{};
    const char* kb[4];
    int kb0_ = KSWZ(r32, hi * 16) + mp * 128; asm volatile("" : "+v"(kb0_));
#pragma unroll
    for (int dd = 0; dd < 4; ++dd) kb[dd] = K_lds + KB * SHM_K + (kb0_ ^ (dd << 5));

#pragma unroll
    for (int d0 = 0; d0 < 4; ++d0) { const char* a = kb[d0];
        bf16x8 b0 = *reinterpret_cast<const bf16x8*>(a);
        bf16x8 b1 = *reinterpret_cast<const bf16x8*>(a + 32 * 256);
        p0 = __builtin_amdgcn_mfma_f32_32x32x16_bf16(b0, qr[d0], p0, 0, 0, 0);
        p1 = __builtin_amdgcn_mfma_f32_32x32x16_bf16(b1, qr[d0], p1, 0, 0, 0); }

}
template <int VB>
__device__ __forceinline__ void pv_tile(f32x16* o, int vb0, bf16x8 pa0, bf16x8 pa1, bf16x8 pa2, bf16x8 pa3) {
#define TRRD(dst, off) asm volatile("ds_read_b64_tr_b16 %0, %1 offset:%2" : "=&v"(dst) : "v"(vb0), "i"(off) : "memory")
#define PV_RD(S, d0) do { constexpr int b_ = VB * SHM_V + v_rd_off(d0, 0, 0); \
        TRRD(S##l0, b_); TRRD(S##h0, b_ + 2048); TRRD(S##l1, b_ + 4096); TRRD(S##h1, b_ + 6144); TRRD(S##l2, b_ + 8192); TRRD(S##h2, b_ + 10240); TRRD(S##l3, b_ + 12288); TRRD(S##h3, b_ + 14336); } while (0)
#define PV_MM(S, d0) do { \
        o[d0] = __builtin_amdgcn_mfma_f32_32x32x16_bf16(pa0, (bf16x8){S##l0[0], S##l0[1], S##l0[2], S##l0[3], S##h0[0], S##h0[1], S##h0[2], S##h0[3]}, o[d0], 0, 0, 0);   \
        o[d0] = __builtin_amdgcn_mfma_f32_32x32x16_bf16(pa1, (bf16x8){S##l1[0], S##l1[1], S##l1[2], S##l1[3], S##h1[0], S##h1[1], S##h1[2], S##h1[3]}, o[d0], 0, 0, 0);   \
        o[d0] = __builtin_amdgcn_mfma_f32_32x32x16_bf16(pa2, (bf16x8){S##l2[0], S##l2[1], S##l2[2], S##l2[3], S##h2[0], S##h2[1], S##h2[2], S##h2[3]}, o[d0], 0, 0, 0);   \
        o[d0] = __builtin_amdgcn_mfma_f32_32x32x16_bf16(pa3, (bf16x8){S##l3[0], S##l3[1], S##l3[2], S##l3[3], S##h3[0], S##h3[1], S##h3[2], S##h3[3]}, o[d0], 0, 0, 0); } while (0)
    s16x4 al0, al1, al2, al3, ah0, ah1, ah2, ah3, bl0, bl1, bl2, bl3, bh0, bh1, bh2, bh3;

    PV_RD(a, 0);
    PV_RD(b, 1); asm volatile("s_waitcnt lgkmcnt(8)" ::: "memory"); SBAR(); PV_MM(a, 0); SBAR();
    PV_RD(a, 2); asm volatile("s_waitcnt lgkmcnt(8)" ::: "memory"); SBAR(); PV_MM(b, 1); SBAR();
    PV_RD(b, 3); asm volatile("s_waitcnt lgkmcnt(8)" ::: "memory"); SBAR(); PV_MM(a, 2); SBAR();
    asm volatile("s_waitcnt lgkmcnt(0)" ::: "memory"); SBAR(); PV_MM(b, 3);

#undef PV_MM
#undef PV_RD
#undef TRRD
}
struct BlockRef { int qoff, koff, P0, ooff; };
struct Bufs { const bf16_t* Q; const bf16_t* K; const bf16_t* V; bf16_t* O; };
struct Seam { bf16x8 qr[4]; bf16x8 st_v0, st_v1, st_k0, st_k1; };
#define ROW(p, k0, rr) ((p) + (size_t)((k0) + (rr)) * LD + sc)
#define VMW() asm volatile("s_waitcnt vmcnt(0)" ::: "memory")
#define VMWN(n) asm volatile("s_waitcnt vmcnt(%0)" :: "i"(n) : "memory")
#define SLOAD_H(Kp, Vp, k0) do { S.st_v0 = load8(ROW(Vp, k0, sr)); S.st_v1 = load8(ROW(Vp, k0, 32 + sr));              \
                         S.st_k0 = load8(ROW(Kp, k0, sr)); S.st_k1 = load8(ROW(Kp, k0, 32 + sr)); } while (0)
#define SWRITE_HK(bf) do { *(bf16x8*)(K_lds + (bf) * SHM_K + kws) = S.st_k0; *(bf16x8*)(K_lds + (bf) * SHM_K + kws + 32 * 256) = S.st_k1; } while (0)
#define SWRITE_HV(bf) do { *(bf16x8*)(V_lds + (bf) * SHM_V + vst0) = S.st_v0; *(bf16x8*)(V_lds + (bf) * SHM_V + vst1) = S.st_v1; } while (0)
#define SWRITE_H(bf) do { SWRITE_HV(bf); SWRITE_HK(bf); } while (0)
__device__ __forceinline__ void attn_prime(const Bufs& B, const BlockRef& cur, char* lds, Seam& S) {
    int tid = threadIdx.x; asm volatile("" : "+v"(tid));
    const int wid = __builtin_amdgcn_readfirstlane(tid >> 6), lane = tid & 63, r32 = lane & 31, hi = lane >> 5, wq = wid & 3, mp = wid >> 2;
    const int sr = tid >> 4, sc = (tid & 15) * 8, kws = KSWZ(sr, sc * 2); char* K_lds = lds + 2 * SHM_V;
#pragma unroll
    for (int d0 = 0; d0 < 4; ++d0) S.qr[d0] = load8(B.Q + cur.qoff + (size_t)(wq * QBLK + r32) * LD + mp * 64 + d0 * 16 + hi * 8);
    SLOAD_H(B.K + cur.koff, B.V + cur.koff, 0); VMW(); SWRITE_HK(0);
    __syncthreads();
}
template <bool FIRST>
__device__ __forceinline__ void attn_block(const Bufs& B, const BlockRef& cur, const BlockRef& nxt, char* lds, LAS unsigned char* ldsl, Seam& S, float lam, const float* __restrict__ subln_g) {
    int tid = threadIdx.x; asm volatile("" : "+v"(tid));
    const int wid = __builtin_amdgcn_readfirstlane(tid >> 6), lane = tid & 63, r32 = lane & 31, hi = lane >> 5, wq = wid & 3, mp = wid >> 2;
    const int NT = (cur.P0 + QB - 1) / KVBLK + 1;
    const int qlo = cur.P0 + wq * QBLK, qm = qlo + r32 - 4 * hi;
    char* V_lds = lds; char* K_lds = lds + 2 * SHM_V;
    float* ws = (float*)(lds + LDS_WS) + wid * 64; float* li_l = ws, * al_l = ws + 32;
    float m_reg = -1e30f, l_reg = 0; f32x16 o[4] = {};
    const int vb0 = (int)(uintptr_t)V_lds + v_rd_base(lane);
    const bf16_t* Kh = B.K + cur.koff; const bf16_t* Vh = B.V + cur.koff;
    int kso0, vso0;
    { const int r0 = (wid * 2) * 4 + (lane >> 4); kso0 = r0 * LD + (((lane & 15) ^ (r0 & 7)) << 3);
      const int b0_ = (wid * 2) * 2 + (lane >> 5), kl = (lane & 31) >> 2, cl = (lane & 3) * 8;
      const int kk0 = (b0_ >> 2) * 8 + kl;
      const int k0_ = kk0;
      vso0 = k0_ * LD + (b0_ & 3) * 32 + cl; }
#define DMA_K(bf, tile) do { const bf16_t* kp_ = Kh + (size_t)KBASE(tile) * LD;                                                                         \
        __builtin_amdgcn_global_load_lds((const unsigned*)(kp_ + kso0), (LAS unsigned*)(ldsl + 2 * SHM_V + (bf) * SHM_K + wid * 2048), 16, 0, 0);          \
        __builtin_amdgcn_global_load_lds((const unsigned*)(kp_ + ((kso0 ^ 32) + 4 * LD)), (LAS unsigned*)(ldsl + 2 * SHM_V + (bf) * SHM_K + wid * 2048 + 1024), 16, 0, 0); } while (0)
#define DMA_V(bf, tile) do { const bf16_t* vp_ = Vh + (size_t)KBASE(tile) * LD;                                                                         \
        __builtin_amdgcn_global_load_lds((const unsigned*)(vp_ + vso0), (LAS unsigned*)(ldsl + (bf) * SHM_V + wid * 2048), 16, 0, 0);                      \
        __builtin_amdgcn_global_load_lds((const unsigned*)(vp_ + vso0 + 64), (LAS unsigned*)(ldsl + (bf) * SHM_V + wid * 2048 + 1024), 16, 0, 0); } while (0)
#define RESC(a) do { if (__any((a) < 1.f)) { int t_ = threadIdx.x; asm volatile("" : "+v"(t_));     \
                     const int r_ = t_ & 31, h_ = (t_ >> 5) & 1; if (h_ == 0) al_l[r_] = (a); asm volatile("s_waitcnt lgkmcnt(0)" ::: "memory");              \
                     for (int d_ = 0; d_ < 4; ++d_) for (int r = 0; r < 16; ++r) o[d_][r] *= al_l[crow(r, h_)]; } } while (0)
#define KBASE(t) ((t) * KVBLK)
#define MASKT(P0_, P1_, t) do { const int kb_ = KBASE(t); if (kb_ + KVBLK - 1 > qlo) mask_tile(P0_, P1_, qm - kb_); } while (0)
    constexpr int NQL = FIRST ? 6 : 4;
#define SEAM_K0() do { VMWN(NQL); SWRITE_HK(0); SBAR(); } while (0)
    f32x16 pA0, pA1, pB0, pB1; float mnA, mnB, alA, alB; bf16x8 pa0, pa1, pa2, pa3;
    constexpr float C2 = 1.4426950408889634f * SCALE;
#define KFL_(dd) do { int kb_ = kbase; asm volatile("" : "+v"(kb_));     \
            const char* a_ = K_lds + (KB_) * SHM_K + (kb_ ^ ((dd) << 5));                                                          \
            kf_[2 * (dd)] = *reinterpret_cast<const bf16x8*>(a_); kf_[2 * (dd) + 1] = *reinterpret_cast<const bf16x8*>(a_ + 32 * 256); } while (0)
#define G1_PRE(KB) do { constexpr int KB_ = (KB); KFL_(0); KFL_(1); } while (0)
#define G1(PX0, PX1, PY0, PY1, alY, KB, VB) do {                                                                                   \
        constexpr int KB_ = (KB);                                                                                                 \
        float ps0_ = 0.f, ps1_ = 0.f; SBAR();                     \
        _Pragma("unroll") for (int g_ = 0; g_ < 8; ++g_) {                                                                        \
            if (g_ == 0)            PX0 = __builtin_amdgcn_mfma_f32_32x32x16_bf16(kf_[g_], S.qr[g_ >> 1], PX1, 0, 0, 0);           \
            else if ((g_ & 1) == 0) PX0 = __builtin_amdgcn_mfma_f32_32x32x16_bf16(kf_[g_], S.qr[g_ >> 1], PX0, 0, 0, 0);           \
            else                    PX1 = __builtin_amdgcn_mfma_f32_32x32x16_bf16(kf_[g_], S.qr[g_ >> 1], PX1, 0, 0, 0);           \
            SBAR();                                                                                                               \
            if (g_ == 1) KFL_(2); if (g_ == 3) KFL_(3);         \
            PY1[8 + g_] = __builtin_amdgcn_exp2f(PY1[8 + g_]);                                                                     \
            ps0_ += PY0[2 * g_]; ps1_ += PY0[2 * g_ + 1]; ps0_ += PY1[g_]; SBAR(); }                                               \
        _Pragma("unroll") for (int r_ = 8; r_ < 16; r_ += 2) { ps0_ += PY1[r_]; ps1_ += PY1[r_ + 1]; }                              \
        float ps_ = ps0_ + ps1_;                                                                                                  \
        { auto rr_ = __builtin_amdgcn_permlane32_swap(__float_as_uint(ps_), __float_as_uint(ps_), false, false);                   \
          ps_ = __uint_as_float(rr_[0]) + __uint_as_float(rr_[1]); }                                                               \
        l_reg = l_reg * (alY) + ps_;                                                                                              \
        SBAR(); PV_RD(VB, a, 0); SBAR();                       \
        PK4_(PY0, 0, pa0); PK4_(PY0, 8, pa1); PK4_(PY1, 0, pa2); PK4_(PY1, 8, pa3); SBAR(); } while (0)
#define PK4_(P, B_, OUT) do { u32x4 w = {cvtpk(P[B_+0], P[B_+1]), cvtpk(P[B_+2], P[B_+3]), cvtpk(P[B_+4], P[B_+5]), cvtpk(P[B_+6], P[B_+7])};     \
        OUT = *reinterpret_cast<bf16x8*>(&w); } while (0)
#define TRRD(dst, off) asm volatile("ds_read_b64_tr_b16 %0, %1 offset:%2" : "=&v"(dst) : "v"(vb0), "i"(off) : "memory")
#define PV_RD(VB, S_, d0) do { constexpr int b_ = (VB) * SHM_V + v_rd_off(d0, 0, 0); \
        TRRD(S_##l0, b_); TRRD(S_##h0, b_ + 2048); TRRD(S_##l1, b_ + 4096); TRRD(S_##h1, b_ + 6144); TRRD(S_##l2, b_ + 8192); TRRD(S_##h2, b_ + 10240); TRRD(S_##l3, b_ + 12288); TRRD(S_##h3, b_ + 14336); } while (0)
#define PV_M(S_, d0, k, PA) o[d0] = __builtin_amdgcn_mfma_f32_32x32x16_bf16(PA, (bf16x8){S_##l##k[0], S_##l##k[1], S_##l##k[2], S_##l##k[3], S_##h##k[0], S_##h##k[1], S_##h##k[2], S_##h##k[3]}, o[d0], 0, 0, 0)
#define MX4(c) do { pmA_ = fmaxf(fmaxf(pmA_, PX0_[4 * (c)]), PX0_[4 * (c) + 1]); pmA_ = fmaxf(fmaxf(pmA_, PX0_[4 * (c) + 2]), PX0_[4 * (c) + 3]);   \
                    pmB_ = fmaxf(fmaxf(pmB_, PX1_[4 * (c)]), PX1_[4 * (c) + 1]); pmB_ = fmaxf(fmaxf(pmB_, PX1_[4 * (c) + 2]), PX1_[4 * (c) + 3]); } while (0)
#define EX0(i) PX0_[i] = __builtin_amdgcn_exp2f(PX0_[i])
#define EX1(i) PX1_[i] = __builtin_amdgcn_exp2f(PX1_[i])
#define SP_(i) PN1_[i] = nm_
#define G2(PX0, PX1, mnX, alX, VB, PN1) do {                                                                                       \
        f32x16& PX0_ = PX0; f32x16& PX1_ = PX1; f32x16& PN1_ = PN1;                                                                \
        float pmA_ = -__builtin_inff(), pmB_ = -__builtin_inff();                                                                 \
        PV_RD(VB, b, 1); asm volatile("s_waitcnt lgkmcnt(8)" ::: "memory"); SBAR();                                                \
        PV_M(a, 0, 0, pa0); SBAR(); MX4(0); SBAR();                                                                               \
        PV_M(a, 0, 1, pa1); SBAR(); MX4(1); SBAR();                                                                               \
        PV_M(a, 0, 2, pa2); SBAR(); MX4(2); SBAR();                                                                               \
        PV_M(a, 0, 3, pa3); SBAR(); MX4(3); SBAR();                                                                               \
        PV_RD(VB, a, 2); asm volatile("s_waitcnt lgkmcnt(8)" ::: "memory"); SBAR();                                                \
        PV_M(b, 1, 0, pa0); SBAR();                                                                                               \
        float pmax_ = fmaxf(pmA_, pmB_);                        \
        { auto rr_ = __builtin_amdgcn_permlane32_swap(__float_as_uint(pmax_), __float_as_uint(pmax_), false, false);               \
          pmax_ = fmaxf(__uint_as_float(rr_[0]), __uint_as_float(rr_[1])); }                                                       \
        if (__builtin_expect(__all(pmax_ <= THR * 1.4426950408889634f), 1)) { alX = 1.f; }     \
        else { const float d_ = fmaxf(pmax_, 0.f); alX = __builtin_amdgcn_exp2f(-d_); m_reg += d_;                                  \
               _Pragma("unroll") for (int r_ = 0; r_ < 16; ++r_) { PX0_[r_] -= d_; PX1_[r_] -= d_; } }                              \
        mnX = m_reg; const float nm_ = -m_reg; SBAR();                                                                            \
        PV_M(b, 1, 1, pa1); SBAR(); EX0(0); EX0(1); EX0(2); SBAR();                                                                \
        PV_M(b, 1, 2, pa2); SBAR(); EX0(3); EX0(4); EX0(5); SBAR();                                                                \
        PV_M(b, 1, 3, pa3); SBAR(); EX0(6); EX0(7); EX0(8); SBAR();                                                                \
        PV_RD(VB, b, 3); asm volatile("s_waitcnt lgkmcnt(8)" ::: "memory"); SBAR();                                                \
        PV_M(a, 2, 0, pa0); SBAR(); EX0(9); EX0(10); EX0(11); SBAR();                                                              \
        PV_M(a, 2, 1, pa1); SBAR(); EX0(12); EX0(13); EX0(14); SBAR();                                                             \
        PV_M(a, 2, 2, pa2); SBAR(); EX0(15); EX1(0); EX1(1); SBAR();                                                               \
        PV_M(a, 2, 3, pa3); SBAR(); EX1(2); EX1(3); EX1(4); SBAR();                                                                \
        asm volatile("s_waitcnt lgkmcnt(0)" ::: "memory"); SBAR();                                                                \
        PV_M(b, 3, 0, pa0); SBAR(); EX1(5); EX1(6); EX1(7); SBAR();                                                                \
        PV_M(b, 3, 1, pa1); SBAR(); SP_(0); SP_(1); SP_(2); SP_(3); SP_(4); SP_(5); SBAR();     \
        PV_M(b, 3, 2, pa2); SBAR(); SP_(6); SP_(7); SP_(8); SP_(9); SP_(10); SP_(11); SBAR();                                       \
        PV_M(b, 3, 3, pa3); SBAR(); SP_(12); SP_(13); SP_(14); SP_(15); SBAR(); } while (0)
    const int kbase = KSWZ(r32, hi * 16) + mp * 128;
    s16x4 al0, al1, al2, al3, ah0, ah1, ah2, ah3, bl0, bl1, bl2, bl3, bh0, bh1, bh2, bh3; bf16x8 kf_[8];
    {
        int tp_ = threadIdx.x; asm volatile("" : "+v"(tp_));
        const int sr = tp_ >> 4, sc = (tp_ & 15) * 8, vst0 = v_st(sr, sc), vst1 = v_st(32 + sr, sc), kws = KSWZ(sr, sc * 2);
        if constexpr (FIRST) { DMA_K(1, 1); }
        SWRITE_HV(0); SBAR();
        SBAR(); qkt<0>(pA0, pA1, K_lds, r32, hi, mp, S.qr);
        MASKT(pA0, pA1, 0); partialSM(pA0, pA1, m_reg, mnA, alA);
        { const float nm0_ = -m_reg; _Pragma("unroll") for (int r_ = 0; r_ < 16; ++r_) pB1[r_] = nm0_; }
        if constexpr (FIRST) VMW(); else VMWN(4);
    }
    __syncthreads();
#define HALF_STEP(PX0, PX1, mnX, alX, PY0, PY1, mnY, alY, t, KB, VB, SB) do {                                                 \
        SBAR(); G1_PRE(KB); SBAR();                                                                                           \
        if ((t) + 1 < NT) DMA_K(SB, (t) + 1);                    \
        DMA_V(KB, (t));                                         \
        SBAR(); G1(PX0, PX1, PY0, PY1, alY, KB, VB);                                                                           \
        MASKT(PX0, PX1, (t));                                                                                                  \
        G2(PX0, PX1, mnX, alX, VB, PY1);                                                                                       \
        RESC(alX);                                                                                                            \
        VMW();                                                                    \
        __syncthreads(); } while (0)
    for (int t = 1; t + 1 < NT; t += 2) {
        HALF_STEP(pB0, pB1, mnB, alB, pA0, pA1, mnA, alA, t, 1, 0, 0);
        HALF_STEP(pA0, pA1, mnA, alA, pB0, pB1, mnB, alB, t + 1, 0, 1, 1);
    }
    const bool even = (NT & 1) == 0;
    if (even) { G1_PRE(1); SBAR(); DMA_V(1, NT - 1); SBAR(); G1(pB0, pB1, pA0, pA1, alA, 1, 0); }
    else finishSM(pA0, pA1, alA, l_reg, pa0, pa1, pa2, pa3);
    int tt_ = threadIdx.x; asm volatile("" : "+v"(tt_));
    const int sr = tt_ >> 4, sc = (tt_ & 15) * 8, kws = KSWZ(sr, sc * 2);
    SBAR(); SLOAD_H(B.K + nxt.koff, B.V + nxt.koff, 0); SBAR();
    { const int r32q = tt_ & 31, hiq = (tt_ >> 5) & 1;
#pragma unroll
      for (int d0 = 0; d0 < 4; ++d0) S.qr[d0] = load8(B.Q + nxt.qoff + (size_t)(wq * QBLK + r32q) * LD + mp * 64 + d0 * 16 + hiq * 8); }
    SBAR();
    if (even) { MASKT(pB0, pB1, NT - 1); G2(pB0, pB1, mnB, alB, 0, pA1);
        asm volatile("s_waitcnt vmcnt(8)" ::: "memory"); __syncthreads(); RESC(alB);
        if constexpr (FIRST) DMA_K(1, 1);
        finishSM(pB0, pB1, alB, l_reg, pa0, pa1, pa2, pa3); SBAR(); pv_tile<1>(o, vb0, pa0, pa1, pa2, pa3); }
    else pv_tile<0>(o, vb0, pa0, pa1, pa2, pa3);
#undef G1
#undef G1_PRE
#undef KFL_
#undef G2
#undef PK4_
#undef TRRD
#undef PV_RD
#undef PV_M
#undef MX4
#undef EX1
#undef SP_
#undef EX0
    SBAR(); SEAM_K0();
    int r32e = lane & 31, hie = lane >> 5; asm volatile("" : "+v"(r32e), "+v"(hie));
    float gq[4];
#pragma unroll
    for (int d0 = 0; d0 < 4; ++d0) gq[d0] = subln_g[d0 * 32 + r32e];
    if (hie == 0) li_l[r32e] = l_reg; asm volatile("s_waitcnt lgkmcnt(0)" ::: "memory");
    float* xch = (float*)(lds + LDS_XCH) + wq * 4096;
#define EP_SEND(R0) do { float rlv[8]; _Pragma("unroll") for (int r8 = 0; r8 < 8; ++r8) rlv[r8] = __builtin_amdgcn_rcpf(li_l[crow((R0) + r8, hie)]);                   \
        _Pragma("unroll") for (int r8 = 0; r8 < 8; ++r8) { const int r = (R0) + r8; const int orow = crow(r, hie);                                             \
            _Pragma("unroll") for (int d0 = 0; d0 < 4; ++d0) xch[orow * 128 + d0 * 32 + r32e] = o[d0][r] * rlv[r8]; } } while (0)
#define EP_PROC(R0, OWN1) do { float dd[8][4], ssv[8];                                                                                                       \
        _Pragma("unroll") for (int r8 = 0; r8 < 8; ++r8) { const int r = (R0) + r8; const int orow = crow(r, hie); const float rl = __builtin_amdgcn_rcpf(li_l[orow]); float ss = 0.f; \
            _Pragma("unroll") for (int d0 = 0; d0 < 4; ++d0) { const float own = o[d0][r] * rl, oth = xch[orow * 128 + d0 * 32 + r32e]; const float dv = (OWN1) ? own - lam * oth : oth - lam * own; dd[r8][d0] = dv; ss += dv * dv; } \
            ssv[r8] = ss; }                                                                                                                                    \
          \
        _Pragma("unroll") for (int r8 = 0; r8 < 8; ++r8) { float t = ssv[r8]; t += dppf<0xB1>(t); t += dppf<0x4E>(t); t += dppf<0x141>(t); t += dppf<0x140>(t); ssv[r8] = t; } \
        float sx[8]; _Pragma("unroll") for (int r8 = 0; r8 < 8; ++r8) sx[r8] = __shfl_xor(ssv[r8], 16);                                                         \
          \
        _Pragma("unroll") for (int r8 = 0; r8 < 8; ++r8) { const float rs = rsqrtf((ssv[r8] + sx[r8]) * (1.f / 128.f) + EPS);                                      \
            _Pragma("unroll") for (int d0 = 0; d0 < 4; ++d0) { const float v = dd[r8][d0] * rs * gv[d0];                                                          \
                stg[(hie * 8 + r8) * 128 + d0 * 32 + r32e] = (unsigned short)cvtpk(v, 0.f); } }                                                                   \
        asm volatile("s_waitcnt lgkmcnt(0)" ::: "memory");                                                                                                       \
        _Pragma("unroll") for (int i_ = 0; i_ < 4; ++i_) { const int srow = i_ * 4 + (lne >> 4); const int rr_ = (R0) + (srow & 7);                                \
            const int grow = (rr_ & 3) + 8 * (rr_ >> 2) + 4 * (srow >> 3);                                                                                        \
            const u32x4 w_ = *(const u32x4*)((const char*)stg + srow * 256 + (lne & 15) * 16);                                                                     \
            __builtin_amdgcn_raw_buffer_store_b128(w_, orsrc, (cur.ooff + (wq * QBLK + grow) * LDO + (lne & 15) * 8) * 2, 0, 16  ); } } while (0)
    if (mp == 0) { asm volatile("" ::: "memory"); EP_SEND(8); } else EP_SEND(0);
    __syncthreads();
    {
        float gv[4];
#pragma unroll
        for (int d0 = 0; d0 < 4; ++d0) gv[d0] = gq[d0] * (1.f - LAMBDA_INIT);
        const int lne = r32e + 32 * hie;
        unsigned short* stg = (unsigned short*)((char*)xch + mp * 8192);
        const __amdgpu_buffer_rsrc_t orsrc = __builtin_amdgcn_make_buffer_rsrc((void*)B.O, 0, 32 * 1024 * 1024, 0x00020000);
        if (mp == 0) EP_PROC(0, true); else EP_PROC(8, false);
    }
    __syncthreads();
#undef EP_SEND
#undef EP_PROC
#undef RESC
#undef DMA_K
#undef DMA_V
#undef KBASE
#undef MASKT
#undef SEAM_K0
#undef HALF_STEP
}
#undef ROW
#undef VMW
#undef VMWN
#undef SLOAD_H
#undef SWRITE_HK
#undef SWRITE_HV
#undef SWRITE_H
#undef KSWZ
#undef SBAR
}

DEV void p3_attn_conv(Frame& F, const Args& a, char* lds_generic) {
    const att::Bufs B{(const bf16_t*)(F.ws + WS_Q), (const bf16_t*)(F.ws + WS_K), (const bf16_t*)(F.ws + WS_V), (bf16_t*)(F.ws + WS_ATT)};
    float lam;
    { const float* q1 = (const float*)a.in[7]; const float* k1 = (const float*)a.in[8]; const float* q2 = (const float*)a.in[9]; const float* k2 = (const float*)a.in[10];
      const float s1 = wave_sum(q1[F.lane] * k1[F.lane]), s2 = wave_sum(q2[F.lane] * k2[F.lane]);
      lam = __uint_as_float(__builtin_amdgcn_readfirstlane(__float_as_uint(expf(s1) - expf(s2) + LAMBDA_INIT))); }
    const float* subln_g = (const float*)a.in[11];
    for (int L = F.vcu; L < 256; L += F.G) {
        const int bh = L >> 4, y = L & 15, b = bh >> 2, h = bh & 3;
        const int hb = b * SEQ * att::LD + h * 128;
        const int ob = b * SEQ * att::LDO + h * 128;
        const att::BlockRef b0{hb + y * att::QB * att::LD, hb, y * att::QB, ob + y * att::QB * att::LDO}, b1{hb + (att::NQB - 1 - y) * att::QB * att::LD, hb, (att::NQB - 1 - y) * att::QB, ob + (att::NQB - 1 - y) * att::QB * att::LDO};
        att::Seam S;
        att::attn_prime(B, b0, lds_generic, S);
        att::attn_block<true>(B, b0, b1, lds_generic, F.lds, S, lam, subln_g);
        att::attn_block<false>(B, b1, b1, lds_generic, F.lds, S, lam, subln_g);
    }
    int ctid = threadIdx.x; asm volatile("" : "+v"(ctid));
    const bf16_t* CB = (const bf16_t*)(F.ws + WS_CB); const bf16_t* CCU = (const bf16_t*)(F.ws + WS_CCU); bf16_t* CONV = (bf16_t*)(F.ws + WS_ATT);
    const float* cw = (const float*)a.in[12]; (void)CONV;
    const __amdgpu_buffer_rsrc_t crsrc = __builtin_amdgcn_make_buffer_rsrc((void*)(F.ws + WS_ATT), 0, 32 * 1024 * 1024, 0x00020000);
    const int gt = F.vcu * NTHR + ctid, NGT = F.G * NTHR;
    const int chc = (gt & 63) * 8;
    float cwv[3][8];
#pragma unroll
    for (int j = 0; j < 3; ++j)
#pragma unroll
        for (int i = 0; i < 8; ++i) cwv[j][i] = cw[j * 512 + chc + i];
    for (int idx0 = gt; idx0 < M * 64; idx0 += 4 * NGT) {
        v4u cbv[4], u0[4], u1[4], u2[4];
#pragma unroll
        for (int p = 0; p < 4; ++p) { const int idx = idx0 + p * NGT; const int row = idx >> 6, t = row & (SEQ - 1);
            const size_t off = (size_t)row * 512 + chc;
            cbv[p] = __builtin_nontemporal_load((const v4u*)(CB + off)); u0[p] = *(const v4u*)(CCU + off);
            u1[p] = (v4u){0u, 0u, 0u, 0u}; u2[p] = (v4u){0u, 0u, 0u, 0u};
            if (t >= 1) u1[p] = *(const v4u*)(CCU + off - 512);
            if (t >= 2) u2[p] = *(const v4u*)(CCU + off - 1024); }
#pragma unroll
        for (int p = 0; p < 4; ++p) { const int idx = idx0 + p * NGT; const int row = idx >> 6;
            v4u o;
#pragma unroll
            for (int i = 0; i < 4; ++i) {
                const float y0 = cwv[0][2 * i] * __uint_as_float(u0[p][i] << 16) + cwv[1][2 * i] * __uint_as_float(u1[p][i] << 16) + cwv[2][2 * i] * __uint_as_float(u2[p][i] << 16);
                const float y1 = cwv[0][2 * i + 1] * __uint_as_float(u0[p][i] & 0xffff0000u) + cwv[1][2 * i + 1] * __uint_as_float(u1[p][i] & 0xffff0000u) + cwv[2][2 * i + 1] * __uint_as_float(u2[p][i] & 0xffff0000u);
                o[i] = pk2(__uint_as_float(cbv[p][i] << 16) * y0, __uint_as_float(cbv[p][i] & 0xffff0000u) * y1);
            }
            __builtin_amdgcn_raw_buffer_store_b128(o, crsrc, (row * 1024 + 512 + chc) * 2, 0, 16  ); }
    }
}

constexpr size_t WS_X1B = 72 * MiB;
constexpr size_t WS_ELT = 250 * MiB;
constexpr size_t WS_ELW = 252 * MiB;
constexpr size_t WS_TOKP = 254 * MiB;
constexpr size_t WS_ACT = 104 * MiB;
constexpr size_t WS_Y = 168 * MiB;
constexpr int CW_CNT = 32768;
constexpr int CW_DONE = 40960;
constexpr int CW_PC4 = 50176, CW_PC5 = 51200;
constexpr int CW_WDC = 49152;
constexpr int LDS_TAB = 131072;

DEV void p6_route(Frame& F, const Args& a, const bool wait5) {
    typedef float f32x4v __attribute__((ext_vector_type(4)));
    const bf16_t* X1 = (const bf16_t*)(F.ws + WS_X1B); const float* SSQ = (const float*)(F.ws + WS_SSQ); const float* MOD = (const float*)(F.ws + WS_MOD);
    const float* gN = (const float*)a.in[16]; const float* bg = (const float*)a.in[18]; const float* be = (const float*)a.in[20];
    const bf16_t* RH = (const bf16_t*)(F.ws + WS_WT_R); const bf16_t* RL = RH + 48 * DM;
    const __amdgpu_buffer_rsrc_t hrsrc = __builtin_amdgcn_make_buffer_rsrc((void*)(F.ws + WS_H2), 0, 32 * 1024 * 1024, 0x00020000);
    int* ELT = (int*)(F.ws + WS_ELT); float* ELW = (float*)(F.ws + WS_ELW); int* TOKP = (int*)(F.ws + WS_TOKP);
    LAS float* GS = (LAS float*)F.lds; LAS float* SH = GS + DM; LAS float* PL = SH + DM;
    LAS float* LG = PL + 8 * 64 * 48;
    LAS int* lcnt = (LAS int*)(LG + 64 * 48); LAS int* gbase = lcnt + 32;
    const int r = F.lane & 15, q = F.lane >> 4, w = F.wave;
    for (int ch = F.vcu; ch < M / 64; ch += F.G) {
        const int R0 = ch * 64, b = R0 / SEQ; const float* md = MOD + b * 6144;
        for (int k = F.tid; k < DM; k += NTHR) { GS[k] = gN[k] * (1.f + md[4096 + k]); SH[k] = md[3072 + k]; }
        if (F.tid < 32) lcnt[F.tid] = 0;
        if (wait5 && F.tid == 64) {
            unsigned sp = 0; while (__hip_atomic_load(F.ctl + CW_PC5 + (ch >> 2) * 16, __ATOMIC_RELAXED, __HIP_MEMORY_SCOPE_AGENT) < (unsigned)(DM / pg8::BM)) { __builtin_amdgcn_s_sleep(2); if (++sp > (1u << 22)) break; }
            __builtin_amdgcn_fence(__ATOMIC_ACQUIRE, "agent"); asm volatile("s_waitcnt vmcnt(0)" ::: "memory"); }
        __syncthreads();
        float rstd[4];
#pragma unroll
        for (int rg = 0; rg < 4; ++rg) { const f32x4v* sp = (const f32x4v*)(SSQ + (size_t)(R0 + rg * 16 + r) * 16); const f32x4v s0 = sp[0], s1 = sp[1], s2 = sp[2], s3 = sp[3];
            const float ss = ((s0[0] + s0[1]) + (s0[2] + s0[3])) + ((s1[0] + s1[1]) + (s1[2] + s1[3])) + ((s2[0] + s2[1]) + (s2[2] + s2[3])) + ((s3[0] + s3[1]) + (s3[2] + s3[3]));
            rstd[rg] = rsqrtf(ss * (1.f / DM) + EPS); }
        pg8::f32x4 acc[4][3];
#pragma unroll
        for (int rg = 0; rg < 4; ++rg)
#pragma unroll
            for (int n = 0; n < 3; ++n) acc[rg][n] = (pg8::f32x4){0.f, 0.f, 0.f, 0.f};
#pragma unroll
        for (int s = 0; s < 4; ++s) {
            const int k0 = w * 128 + s * 32 + 8 * q;
            bf16x8 bh[3], bl[3];
#pragma unroll
            for (int n = 0; n < 3; ++n) { bh[n] = *(const bf16x8*)(RH + (size_t)(n * 16 + r) * DM + k0); bl[n] = *(const bf16x8*)(RL + (size_t)(n * 16 + r) * DM + k0); }
            v4u xq[4];
#pragma unroll
            for (int rg = 0; rg < 4; ++rg) xq[rg] = *(const v4u*)(X1 + (size_t)(R0 + rg * 16 + r) * DM + k0);
            const f32x4v ga = *(const LAS f32x4v*)(GS + k0), gb = *(const LAS f32x4v*)(GS + k0 + 4), sa = *(const LAS f32x4v*)(SH + k0), sb = *(const LAS f32x4v*)(SH + k0 + 4);
#pragma unroll
            for (int rg = 0; rg < 4; ++rg) {
                const v4u xr_ = xq[rg];
                const f32x4v xa = {__uint_as_float(xr_.x << 16), __uint_as_float(xr_.x & 0xffff0000u), __uint_as_float(xr_.y << 16), __uint_as_float(xr_.y & 0xffff0000u)}, xb = {__uint_as_float(xr_.z << 16), __uint_as_float(xr_.z & 0xffff0000u), __uint_as_float(xr_.w << 16), __uint_as_float(xr_.w & 0xffff0000u)};
                const f32x4v ha = xa * rstd[rg] * ga + sa, hb = xb * rstd[rg] * gb + sb;
                v4u hi, lo;
                hi.x = pg8::cvt_pk_bf16(ha[0], ha[1]); hi.y = pg8::cvt_pk_bf16(ha[2], ha[3]); hi.z = pg8::cvt_pk_bf16(hb[0], hb[1]); hi.w = pg8::cvt_pk_bf16(hb[2], hb[3]);
                lo.x = pg8::cvt_pk_bf16(ha[0] - __uint_as_float(hi.x << 16), ha[1] - __uint_as_float(hi.x & 0xffff0000u)); lo.y = pg8::cvt_pk_bf16(ha[2] - __uint_as_float(hi.y << 16), ha[3] - __uint_as_float(hi.y & 0xffff0000u));
                lo.z = pg8::cvt_pk_bf16(hb[0] - __uint_as_float(hi.z << 16), hb[1] - __uint_as_float(hi.z & 0xffff0000u)); lo.w = pg8::cvt_pk_bf16(hb[2] - __uint_as_float(hi.w << 16), hb[3] - __uint_as_float(hi.w & 0xffff0000u));
                __builtin_amdgcn_raw_buffer_store_b128(hi, hrsrc, ((R0 + rg * 16 + r) * DM + k0) * 2, 0, 16  );
                const bf16x8 ahi = __builtin_bit_cast(bf16x8, hi), alo = __builtin_bit_cast(bf16x8, lo);
#pragma unroll
                for (int n = 0; n < 3; ++n) {
                    acc[rg][n] = __builtin_amdgcn_mfma_f32_16x16x32_bf16(ahi, bh[n], acc[rg][n], 0, 0, 0);
                    acc[rg][n] = __builtin_amdgcn_mfma_f32_16x16x32_bf16(ahi, bl[n], acc[rg][n], 0, 0, 0);
                    acc[rg][n] = __builtin_amdgcn_mfma_f32_16x16x32_bf16(alo, bh[n], acc[rg][n], 0, 0, 0);
                }
            }
        }
#pragma unroll
        for (int rg = 0; rg < 4; ++rg)
#pragma unroll
            for (int n = 0; n < 3; ++n)
#pragma unroll
                for (int j = 0; j < 4; ++j) PL[(w * 64 + rg * 16 + 4 * q + j) * 48 + n * 16 + r] = acc[rg][n][j];
        __syncthreads();
        for (int i = F.tid; i < 64 * 48; i += NTHR) { float sacc = 0.f;
#pragma unroll
            for (int ww = 0; ww < 8; ++ww) sacc += PL[ww * 64 * 48 + i];
            LG[i] = sacc; }
        __syncthreads();
        int e0 = 0, e1 = 0, p0 = 0, p1 = 0; float w0 = 0.f, w1 = 0.f;
        if (F.tid < 64) {
            const LAS float* l0 = LG + (size_t)F.tid * 48;
            int gi = 0; float gmax = l0[0] + bg[0];
            for (int i = 1; i < 4; ++i) { const float v = l0[i] + bg[i]; if (v > gmax) { gmax = v; gi = i; } }
            float se = 0.f; for (int i = 0; i < 4; ++i) se += expf(l0[i] + bg[i] - gmax);
            const float gw = 1.f / se;
            int i0 = 0; float m0 = -1e30f; int i1 = 0; float m1 = -1e30f;
            for (int i = 0; i < 8; ++i) { const float v = l0[4 + gi * 8 + i] + be[gi * 8 + i];
                if (v > m0) { m1 = m0; i1 = i0; m0 = v; i0 = i; } else if (v > m1) { m1 = v; i1 = i; } }
            const float ex = expf(m1 - m0); w0 = gw / (1.f + ex); w1 = gw * ex / (1.f + ex);
            e0 = gi * 8 + i0; e1 = gi * 8 + i1;
            p0 = atomicAdd((int*)(lcnt + e0), 1); p1 = atomicAdd((int*)(lcnt + e1), 1);
        }
        __syncthreads();
        if (F.tid < 32) { const int c = lcnt[F.tid]; gbase[F.tid] = c ? (int)atomicAdd(F.ctl + CW_CNT + F.tid * 64, (unsigned)c) : 0; }
        __syncthreads();
        if (F.tid < 64) { const int tok = R0 + F.tid; const int g0 = gbase[e0] + p0, g1 = gbase[e1] + p1;
            __hip_atomic_store(ELT + e0 * M + g0, tok, __ATOMIC_RELAXED, __HIP_MEMORY_SCOPE_AGENT); __hip_atomic_store(ELW + e0 * M + g0, w0, __ATOMIC_RELAXED, __HIP_MEMORY_SCOPE_AGENT);
            __hip_atomic_store(ELT + e1 * M + g1, tok, __ATOMIC_RELAXED, __HIP_MEMORY_SCOPE_AGENT); __hip_atomic_store(ELW + e1 * M + g1, w1, __ATOMIC_RELAXED, __HIP_MEMORY_SCOPE_AGENT);
            __hip_atomic_store((unsigned long long*)(TOKP + tok * 2), (unsigned long long)(unsigned)(e0 * M + g0) | ((unsigned long long)(unsigned)(e1 * M + g1) << 32), __ATOMIC_RELAXED, __HIP_MEMORY_SCOPE_AGENT); }
        __syncthreads();
    }
}
DEV pg8::MoeTiles moe_build_tiles(Frame& F) {
    pg8::MoeTiles mt; mt.te = (LAS int*)(F.lds + LDS_TAB); mt.tm = mt.te + 192; mt.tv = mt.tm + 192; LAS int* Tp = mt.tv + 192; LAS int* BASE = Tp + 4;
    if (F.tid < 64) {
        const int e = F.tid;
        const int c = e < NE ? (int)__hip_atomic_load(F.ctl + CW_CNT + e * 64, __ATOMIC_RELAXED, __HIP_MEMORY_SCOPE_AGENT) : 0;
        const int nt_ = (c + 255) >> 8;
        int incl = nt_;
#pragma unroll
        for (int o = 1; o < 32; o <<= 1) { const int v = __shfl_up(incl, o); if (e >= o) incl += v; }
        const int base = incl - nt_;
        if (e < NE) { BASE[e] = base * 256;
            for (int m = 0; m < nt_; ++m) { mt.te[base + m] = e; mt.tm[base + m] = m; mt.tv[base + m] = (c - m * 256) < 256 ? (c - m * 256) : 256; } }
        if (e == NE - 1) Tp[0] = incl;
    }
    __syncthreads();
    mt.T = Tp[0];
    return mt;
}
DEV pg8::MoeTiles moe_tiles_view(Frame& F) {
    pg8::MoeTiles mt; mt.te = (LAS int*)(F.lds + LDS_TAB); mt.tm = mt.te + 192; mt.tv = mt.tm + 192; mt.T = (mt.tv + 192)[0]; return mt;
}
DEV void p9_final(Frame& F, const Args& a, const int tok_pre, const bool have_pre) {
    const LAS int* BASE = (const LAS int*)(F.lds + LDS_TAB) + 3 * 192 + 4;
    const float* MOD = (const float*)(F.ws + WS_MOD); const float* fg = (const float*)a.in[24]; const int* TOKP = (const int*)(F.ws + WS_TOKP); const bf16_t* Y = (const bf16_t*)(F.ws + WS_Y); const bf16_t* X1 = (const bf16_t*)(F.ws + WS_X1B);
    const int gw = F.vcu * NWAVES + F.wave, NGW = F.G * NWAVES;
    f32x4 fgv[4];
#pragma unroll
    for (int j = 0; j < 4; ++j) fgv[j] = *(const f32x4*)(fg + 4 * F.lane + 256 * j);
    for (int mb = gw; mb < M; mb += 32 * NGW) {
    int slotv = 0;
    { const int row = mb + (F.lane >> 1) * NGW; if (row < M) { const int t = (have_pre && mb == gw) ? tok_pre : TOKP[row * 2 + (F.lane & 1)]; slotv = BASE[t / M] + (t % M); } }
    for (int m0 = mb, itl = 0; m0 < M && itl < 16; m0 += 2 * NGW, ++itl) {
        int mm[2] = {m0, m0 + NGW}; int sl[2][2];
#pragma unroll
        for (int p = 0; p < 2; ++p) { sl[p][0] = __shfl(slotv, itl * 4 + p * 2); sl[p][1] = __shfl(slotv, itl * 4 + p * 2 + 1); }
        unsigned long long xq[2][4], ya[2][4], yb[2][4];
#pragma unroll
        for (int p = 0; p < 2; ++p) {
            const GAS unsigned long long* xr = (const GAS unsigned long long*)(X1 + (size_t)mm[p] * DM) + F.lane;
            const GAS unsigned long long* y0 = (const GAS unsigned long long*)(Y + (size_t)sl[p][0] * DM) + F.lane; const GAS unsigned long long* y1 = (const GAS unsigned long long*)(Y + (size_t)sl[p][1] * DM) + F.lane;
#pragma unroll
            for (int j = 0; j < 4; ++j) { xq[p][j] = __builtin_nontemporal_load(xr + 64 * j); ya[p][j] = __builtin_nontemporal_load(y0 + 64 * j); yb[p][j] = __builtin_nontemporal_load(y1 + 64 * j); }
        }
#pragma unroll
        for (int p = 0; p < 2; ++p) {
            const float* gf = MOD + (mm[p] / SEQ) * 6144 + 5120; float s = 0.f; f32x4 v[4];
#pragma unroll
            for (int j = 0; j < 4; ++j) { const int k = 4 * F.lane + 256 * j; const unsigned long long a0 = ya[p][j], a1 = yb[p][j]; const f32x4 g4 = *(const f32x4*)(gf + k);
                f32x4 yy; yy.x = __uint_as_float((unsigned)a0 << 16) + __uint_as_float((unsigned)a1 << 16); yy.y = __uint_as_float((unsigned)a0 & 0xffff0000u) + __uint_as_float((unsigned)a1 & 0xffff0000u);
                yy.z = __uint_as_float((unsigned)(a0 >> 32) << 16) + __uint_as_float((unsigned)(a1 >> 32) << 16); yy.w = __uint_as_float((unsigned)(a0 >> 32) & 0xffff0000u) + __uint_as_float((unsigned)(a1 >> 32) & 0xffff0000u);
                const unsigned long long xx = xq[p][j]; f32x4 x4; x4.x = __uint_as_float((unsigned)xx << 16); x4.y = __uint_as_float((unsigned)xx & 0xffff0000u); x4.z = __uint_as_float((unsigned)(xx >> 32) << 16); x4.w = __uint_as_float((unsigned)(xx >> 32) & 0xffff0000u);
                v[j] = x4 + g4 * yy; s += (v[j].x * v[j].x + v[j].y * v[j].y) + (v[j].z * v[j].z + v[j].w * v[j].w); }
            const float rstd = rsqrtf(wave_sum(s) * (1.f / DM) + EPS);
            GAS f32x4* xw = (GAS f32x4*)(F.out + (size_t)mm[p] * DM) + F.lane;
#pragma unroll
            for (int j = 0; j < 4; ++j) __builtin_nontemporal_store(v[j] * rstd * fgv[j], xw + 64 * j);
        }
    }
    }
}

__global__ void __launch_bounds__(NTHR, 2) mk(Args args) {
    __shared__ __attribute__((aligned(16))) unsigned char lds_raw[LDS_BYTES];
    Frame F;
    F.lds = (LAS unsigned char*)lds_raw; F.MISC = (volatile LAS unsigned*)(F.lds + MISC_OFF);
    F.tid = threadIdx.x; F.lane = F.tid & 63; F.wave = __builtin_amdgcn_readfirstlane(F.tid >> 6);
    F.G = gridDim.x; { const int bx = blockIdx.x; F.vcu = (F.G % 8 == 0) ? (bx % 8) * (F.G / 8) + bx / 8 : bx; }
    F.ws = args.ws; F.out = args.out; F.ctl = (unsigned*)(args.ws + WS_CTL);
    for (int u = F.tid; u < (LDS_BYTES - LDSCTL_OFF) / 4; u += NTHR) ((LAS unsigned*)(F.lds + LDSCTL_OFF))[u] = 0u;
    __syncthreads();
    XcdBarrier bar = xcd_barrier_post(F.ctl + CW_BAR + args.li * XCD_BAR_WORDS, F.MISC + 8);
    const int lo = args.ph_lo, hi = args.ph_hi;
#define REFRESH() do { int t_ = threadIdx.x; asm volatile("" : "+v"(t_)); F.tid = t_; F.lane = t_ & 63; F.wave = __builtin_amdgcn_readfirstlane(t_ >> 6); } while (0)
#define IN(k) (lo <= (k) && (k) < hi)
#define BOTH(k) (IN(k) && IN((k) + 1))
    int tok9 = 0;
    if (IN(0)) { REFRESH(); p0_prologue(F, args); }
    if (IN(1)) { REFRESH(); p1_h(F, args); }
    if (IN(2)) { REFRESH();
        pg8::Gemm g{(const bf16_t*)(F.ws + WS_H), (const bf16_t*)(F.ws + WS_WT_IN), M, INW, DM}; pg8::StaticOrder S; S.init(M, INW, F.G, (int)blockIdx.x);
        pg8::EpiIn E{(bf16_t*)(F.ws + WS_Q), (bf16_t*)(F.ws + WS_K), (bf16_t*)(F.ws + WS_V), (bf16_t*)(F.ws + WS_CB), (bf16_t*)(F.ws + WS_CCU), (bf16_t*)(F.ws + WS_GA), (bf16_t*)(F.ws + WS_GC), (const float*)(F.ws + WS_ROPE), __builtin_amdgcn_make_buffer_rsrc((void*)(F.ws + WS_Q), 0, 144 * 1024 * 1024, 0x00020000)};
        if (IN(1)) {
            if (F.wave == 0) {
                const unsigned* pa = F.ctl + CW_P0C; unsigned need = (unsigned)F.G; bool act = F.lane == 0;
                if (F.lane >= 1 && F.lane < 32) { pg8::Unit u; if (S.next(F.lane - 1, u)) { pa = F.ctl + CW_PC1 + u.pm * 16; need = 4u; act = true; } }
                unsigned sp = 0;
                for (;;) { const unsigned v = act ? __hip_atomic_load(pa, __ATOMIC_RELAXED, __HIP_MEMORY_SCOPE_AGENT) : need; if (__all(v >= need)) break; __builtin_amdgcn_s_sleep(2); if (++sp > (1u << 22)) break; } }
            __syncthreads(); }
        pg8::gemm_phase<pg8::EpiIn, pg8::StaticOrder, true, true>(F.lds, g, S, E);
        if (BOTH(2)) xcd_barrier(bar);
    }
    if (IN(3)) { REFRESH(); p3_attn_conv(F, args, (char*)lds_raw); if (BOTH(3)) xcd_barrier(bar); }
    if (IN(4)) { REFRESH();
        pg8::StaticOrder S; S.init(M, DM, F.G, (int)blockIdx.x);
        pg8::Gemm g{(const bf16_t*)(F.ws + WS_ATT), (const bf16_t*)(F.ws + WS_WT_A), M, DM, DM};
        pg8::EpiG E{(const bf16_t*)(F.ws + WS_GA), (const bf16_t*)(F.ws + WS_GC), (bf16_t*)(F.ws + WS_MERGED), __builtin_amdgcn_make_buffer_rsrc((void*)(F.ws + WS_MERGED), 0, M * DM * 2, 0x00020000)};
        pg8::gemm_phase<pg8::EpiG, pg8::StaticOrder, false, true>(F.lds, g, S, E);
        if (BOTH(4) && F.tid == 0) { pg8::Unit u; if (S.next(0, u)) __hip_atomic_fetch_add(F.ctl + CW_PC4 + u.pm * 16, 1u, __ATOMIC_RELAXED, __HIP_MEMORY_SCOPE_AGENT); }
    }
    if (IN(5)) { REFRESH();
        pg8::StaticOrder S; S.init(M, DM, F.G, (int)blockIdx.x);
        pg8::Gemm g{(const bf16_t*)(F.ws + WS_MERGED), (const bf16_t*)(F.ws + WS_WT_O), M, DM, DM};
        pg8::EpiX1 E{(const float*)args.in[0], (const float*)(F.ws + WS_MOD) + 2048, (bf16_t*)(F.ws + WS_X1B), (float*)(F.ws + WS_SSQ), __builtin_amdgcn_make_buffer_rsrc((void*)(F.ws + WS_X1B), 0, M * DM * 2, 0x00020000)};
        if (IN(4)) {
            if (F.tid == 0) { pg8::Unit u; if (S.next(0, u)) { unsigned sp = 0; while (__hip_atomic_load(F.ctl + CW_PC4 + u.pm * 16, __ATOMIC_RELAXED, __HIP_MEMORY_SCOPE_AGENT) < (unsigned)(DM / pg8::BM)) { __builtin_amdgcn_s_sleep(2); if (++sp > (1u << 22)) break; } } }
            __syncthreads(); }
        pg8::gemm_phase<pg8::EpiX1, pg8::StaticOrder, false, true>(F.lds, g, S, E);
        if (BOTH(5) && F.tid == 0) { pg8::Unit u; if (S.next(0, u)) __hip_atomic_fetch_add(F.ctl + CW_PC5 + u.pm * 16, 1u, __ATOMIC_RELAXED, __HIP_MEMORY_SCOPE_AGENT); }
    }
    if (IN(6)) { REFRESH(); p6_route(F, args, IN(5)); if (BOTH(6)) xcd_barrier(bar); }
    if (IN(7)) { REFRESH();
        { const pg8::MoeTiles mt = moe_build_tiles(F);
          volatile LAS unsigned* lflag = (volatile LAS unsigned*)(F.lds + LDSCTL_OFF + 512);
          if (F.tid == 0) *lflag = 0u;
          __syncthreads();
          const int nbusy = 2 * mt.T - F.G;
          const int first = nbusy > 0 ? (nbusy < F.G - 32 ? nbusy : 0) : 0;
          if (F.vcu >= first) p7_wdown_transposes(F, args, F.vcu - first, F.G - first, F.ctl + CW_WDC); }
        { REFRESH(); const pg8::MoeTiles mt = moe_tiles_view(F);
          pg8::Gemm g{(const bf16_t*)(F.ws + WS_H2), (const bf16_t*)(F.ws + WS_WT_GU), 0, 0, DM};
          pg8::SchedMoeA S{mt, (const int*)(F.ws + WS_ELT), (const float*)(F.ws + WS_ELW), F.vcu, F.G, F.ctl + CW_DONE};
          pg8::EpiAct E{(bf16_t*)(F.ws + WS_ACT), __builtin_amdgcn_make_buffer_rsrc((void*)(F.ws + WS_ACT), 0, 40960 * 256 * 2, 0x00020000)};
          pg8::gemm_phase_x<pg8::EpiAct, pg8::SchedMoeA, true, 1>(F.lds, g, S, E); }
        { REFRESH(); const pg8::MoeTiles mt = moe_tiles_view(F);
          const int nbusy = 2 * mt.T - F.G; const int first = nbusy > 0 ? (nbusy < F.G - 32 ? nbusy : 0) : 0;
          pg8::Gemm g{(const bf16_t*)(F.ws + WS_ACT), (const bf16_t*)(F.ws + WS_WT_D), 0, 0, FF};
          pg8::SchedMoeB S{mt, F.vcu, F.G, F.ctl + CW_DONE};
          pg8::EpiY E{(bf16_t*)(F.ws + WS_Y), __builtin_amdgcn_make_buffer_rsrc((void*)(F.ws + WS_Y), 0, 40960 * 1024 * 2, 0x00020000)};
          pg8::gemm_phase_x<pg8::EpiY, pg8::SchedMoeB, false, 2>(F.lds, g, S, E, (volatile LAS unsigned*)(F.lds + LDSCTL_OFF + 512), F.ctl + CW_WDC, (unsigned)(F.G - first)); }
        if (BOTH(7)) { REFRESH();
            const int gw9 = F.vcu * NWAVES + F.wave, row9 = gw9 + (F.lane >> 1) * (F.G * NWAVES);
            tok9 = row9 < M ? ((const int*)(F.ws + WS_TOKP))[row9 * 2 + (F.lane & 1)] : 0;
            xcd_barrier(bar); }
    }
    if (IN(9)) { const int tk = tok9; REFRESH(); if (!IN(7)) (void)moe_build_tiles(F); p9_final(F, args, tk, IN(7)); }
#undef IN
#undef BOTH
}


static int g_grid = 0;
static void mk_launch(const Args& base, int lo, int hi, int li, hipStream_t stream) {
    Args a = base; a.ph_lo = lo; a.ph_hi = hi; a.li = li; a.pad = 0;
    hipLaunchKernelGGL(mk, dim3(g_grid), dim3(NTHR), 0, stream, a);
}

extern "C" void kernel_launch(void* const* d_in, const int* in_sizes, int n_in, void* d_out, int out_size, void* d_ws, size_t ws_size, hipStream_t stream) {
    (void)in_sizes; (void)n_in; (void)out_size; (void)ws_size;
    if (g_grid == 0) {
        int dev = 0, cus = 0; (void)hipGetDevice(&dev); (void)hipDeviceGetAttribute(&cus, hipDeviceAttributeMultiprocessorCount, dev);
        g_grid = cus > 0 ? cus : 256;
    }
    (void)hipMemsetAsync((char*)d_ws + WS_CTL, 0, CTL_ZERO_BYTES, stream);
    Args base{}; for (int i = 0; i < 25; ++i) base.in[i] = d_in[i]; base.out = (float*)d_out; base.ws = (unsigned char*)d_ws;
    mk_launch(base, 0, 10, 0, stream);
}
```
